# Optimizing an MI355X kernel written in HIP

```python
import jax, jax.numpy as jnp
from jax import lax
import numpy as np

D_MODEL = 1024
BATCH = 8
SEQ = 2048
DEPTH = 1
DEC_BATCH = 128
DEC_SEQ = 1
PAST_LEN = 16384
PAGE_SIZE = 128

D_MIX = 2 * D_MODEL
SSD_WIDTH = D_MIX // 2
SC_WIDTH = D_MIX - SSD_WIDTH
SSD_HEAD_DIM = 64
SSD_HEADS = SSD_WIDTH // SSD_HEAD_DIM
SSD_GROUPS = 2
D_STATE = 128
SSD_CONV_W = 4
SSD_CONV_DIM = SSD_WIDTH + 2 * SSD_GROUPS * D_STATE
SSD_CHUNK = 256
SC_CONV_W = 3
SC_GROUP_DIM = 64
SC_GROUPS = SC_WIDTH // SC_GROUP_DIM
D_FF = 2816
D_IN_PROJ = SSD_WIDTH + SSD_CONV_DIM + SSD_HEADS + 3 * SC_WIDTH
NORM_EPS = 1e-6

kernel_name = 'hymba_ssd_shortconv_macaron_step'


def rmsnorm(x, w):
    xf = x.astype(jnp.float32)
    y = xf * lax.rsqrt(jnp.mean(xf * xf, axis=-1, keepdims=True) + NORM_EPS)
    return (y * w.astype(jnp.float32)).astype(x.dtype)


def swiglu(x, w_gate, w_up, w_down):
    return (jax.nn.silu(x @ w_gate) * (x @ w_up)) @ w_down


def causal_dwconv(u, buf, w):
    K = w.shape[0]
    T = u.shape[1]
    up = jnp.concatenate([buf.astype(u.dtype), u], axis=1)
    y = up[:, 0:T] * w[0]
    for k in range(1, K):
        y = y + up[:, k:k + T] * w[k]
    return y, up[:, T:]


def ssd_scan(x, dt, A, B, C, s0):
    b, T, h, p = x.shape
    g, n = B.shape[2], B.shape[3]
    r = h // g
    l = min(SSD_CHUNK, T)
    pad = (-T) % l
    Tp = T + pad
    c = Tp // l
    f32 = jnp.float32
    padt = lambda a: jnp.pad(a.astype(f32), [(0, 0), (0, pad)] + [(0, 0)] * (a.ndim - 2))
    xc = padt(x).reshape(b, c, l, g, r, p)
    dtc = padt(dt).reshape(b, c, l, g, r)
    Bc = padt(B).reshape(b, c, l, g, n)
    Cc = padt(C).reshape(b, c, l, g, n)
    a = dtc * A.astype(f32).reshape(g, r)
    acum = jnp.cumsum(a, axis=2)
    xdt = xc * dtc[..., None]
    seg = acum[:, :, :, None] - acum[:, :, None, :]
    mask = jnp.tril(jnp.ones((l, l), dtype=bool))[None, None, :, :, None, None]
    Lm = jnp.exp(jnp.where(mask, seg, -jnp.inf))
    CB = jnp.einsum('bclgn,bcsgn->bclsg', Cc, Bc)
    y_diag = jnp.einsum('bclsg,bclsgr,bcsgrp->bclgrp', CB, Lm, xdt)
    decay_end = jnp.exp(acum[:, :, -1:] - acum)
    states = jnp.einsum('bclgn,bclgr,bclgrp->bcgrpn', Bc, decay_end, xdt)
    chunk_decay = jnp.exp(acum[:, :, -1])

    def step(S, inp):
        st, dc = inp
        return S * dc[..., None, None] + st, S

    S_final, S_enter = lax.scan(
        step, s0.astype(f32).reshape(b, g, r, p, n),
        (jnp.moveaxis(states, 1, 0), jnp.moveaxis(chunk_decay, 1, 0)))
    S_enter = jnp.moveaxis(S_enter, 0, 1)
    y_off = jnp.einsum('bclgn,bcgrpn,bclgr->bclgrp', Cc, S_enter, jnp.exp(acum))
    y = (y_diag + y_off).reshape(b, Tp, h, p)[:, :T]
    return y, S_final.reshape(b, h, p, n)


def token_mix(h, ssm0, conv0, sconv0, w_in, ssd_conv_w, ssd_conv_b, dt_bias, a_log,
              d_skip, ssd_norm_w, sconv_w, w_out):
    b, T, _ = h.shape
    proj = h @ w_in
    o1 = SSD_WIDTH
    o2 = o1 + SSD_CONV_DIM
    o3 = o2 + SSD_HEADS
    o4 = o3 + SC_WIDTH
    o5 = o4 + SC_WIDTH
    z = proj[..., :o1]
    xbc = proj[..., o1:o2]
    dt_raw = proj[..., o2:o3]
    sc_b = proj[..., o3:o4]
    sc_c = proj[..., o4:o5]
    sc_h = proj[..., o5:]
    xbc_c, conv_new = causal_dwconv(xbc, conv0, ssd_conv_w)
    xbc_c = jax.nn.silu(xbc_c + ssd_conv_b)
    xs = xbc_c[..., :SSD_WIDTH].reshape(b, T, SSD_HEADS, SSD_HEAD_DIM)
    Bm = xbc_c[..., SSD_WIDTH:SSD_WIDTH + SSD_GROUPS * D_STATE].reshape(b, T, SSD_GROUPS, D_STATE)
    Cm = xbc_c[..., SSD_WIDTH + SSD_GROUPS * D_STATE:].reshape(b, T, SSD_GROUPS, D_STATE)
    dt = jax.nn.softplus(dt_raw.astype(jnp.float32) + dt_bias.astype(jnp.float32))
    A = -jnp.exp(a_log.astype(jnp.float32))
    y_ssd, S_new = ssd_scan(xs, dt, A, Bm, Cm, ssm0)
    y_ssd = (y_ssd + d_skip.astype(jnp.float32)[:, None] * xs.astype(jnp.float32)).astype(h.dtype)
    y_ssd = y_ssd.reshape(b, T, SSD_WIDTH) * jax.nn.silu(z)
    y_ssd = rmsnorm(y_ssd.reshape(b, T, SSD_GROUPS, SSD_WIDTH // SSD_GROUPS),
                    ssd_norm_w.reshape(SSD_GROUPS, SSD_WIDTH // SSD_GROUPS)).reshape(b, T, SSD_WIDTH)
    u = sc_c * sc_h
    v, sconv_new = causal_dwconv(u, sconv0, sconv_w)
    y_sc = sc_b * v
    out = jnp.concatenate([y_ssd, y_sc], axis=-1) @ w_out
    return out, S_new.astype(ssm0.dtype), conv_new.astype(conv0.dtype), sconv_new.astype(sconv0.dtype)


def layer(x, ssm0, conv0, sconv0, norm_ffn1_w, ffn1_w_gate, ffn1_w_up, ffn1_w_down,
          norm_mix_w, w_in, ssd_conv_w, ssd_conv_b, dt_bias, a_log, d_skip, ssd_norm_w,
          sconv_w, w_out, norm_ffn2_w, ffn2_w_gate, ffn2_w_up, ffn2_w_down):
    x = x + 0.5 * swiglu(rmsnorm(x, norm_ffn1_w), ffn1_w_gate, ffn1_w_up, ffn1_w_down)
    mix, S, cb, sb = token_mix(rmsnorm(x, norm_mix_w), ssm0, conv0, sconv0, w_in, ssd_conv_w,
                               ssd_conv_b, dt_bias, a_log, d_skip, ssd_norm_w, sconv_w, w_out)
    x = x + mix
    x = x + 0.5 * swiglu(rmsnorm(x, norm_ffn2_w), ffn2_w_gate, ffn2_w_up, ffn2_w_down)
    return x, S, cb, sb


def setup_inputs(seed: int = 0) -> dict:
    key = jax.random.key(seed)
    ks = jax.random.split(key, 32)
    f32 = jnp.float32
    nrm = lambda k, shape, scale: jax.random.normal(k, shape, f32) * scale
    Ld = DEPTH
    dt0 = jnp.exp(jax.random.uniform(ks[10], (Ld, SSD_HEADS), f32, np.log(1e-3), np.log(1e-1)))
    return {
        'x_prompt': nrm(ks[0], (BATCH, SEQ, D_MODEL), 1.0),
        'x_sample': nrm(ks[1], (DEC_BATCH, DEC_SEQ, D_MODEL), 1.0),
        'state_ssm': nrm(ks[2], (Ld, DEC_BATCH, SSD_HEADS, SSD_HEAD_DIM, D_STATE), 0.1),
        'state_ssd_conv': nrm(ks[3], (Ld, DEC_BATCH, SSD_CONV_W - 1, SSD_CONV_DIM), 1.0),
        'state_sconv': nrm(ks[4], (Ld, DEC_BATCH, SC_CONV_W - 1, SC_WIDTH), 1.0),
        'norm_ffn1_w': 1.0 + nrm(ks[5], (Ld, D_MODEL), 0.02),
        'ffn1_w_gate': nrm(ks[6], (Ld, D_MODEL, D_FF), D_MODEL ** -0.5),
        'ffn1_w_up': nrm(ks[7], (Ld, D_MODEL, D_FF), D_MODEL ** -0.5),
        'ffn1_w_down': nrm(ks[8], (Ld, D_FF, D_MODEL), D_FF ** -0.5),
        'norm_mix_w': 1.0 + nrm(ks[9], (Ld, D_MODEL), 0.02),
        'w_in': nrm(ks[11], (Ld, D_MODEL, D_IN_PROJ), D_MODEL ** -0.5),
        'ssd_conv_w': nrm(ks[12], (Ld, SSD_CONV_W, SSD_CONV_DIM), SSD_CONV_W ** -0.5),
        'ssd_conv_b': nrm(ks[13], (Ld, SSD_CONV_DIM), 0.02),
        'dt_bias': dt0 + jnp.log(-jnp.expm1(-dt0)),
        'a_log': jnp.log(jax.random.uniform(ks[14], (Ld, SSD_HEADS), f32, 1.0, 16.0)),
        'd_skip': 1.0 + nrm(ks[15], (Ld, SSD_HEADS), 0.1),
        'ssd_norm_w': 1.0 + nrm(ks[16], (Ld, SSD_WIDTH), 0.02),
        'sconv_w': nrm(ks[17], (Ld, SC_CONV_W, SC_WIDTH), SC_CONV_W ** -0.5),
        'w_out': nrm(ks[18], (Ld, D_MIX, D_MODEL), D_MIX ** -0.5),
        'norm_ffn2_w': 1.0 + nrm(ks[19], (Ld, D_MODEL), 0.02),
        'ffn2_w_gate': nrm(ks[20], (Ld, D_MODEL, D_FF), D_MODEL ** -0.5),
        'ffn2_w_up': nrm(ks[21], (Ld, D_MODEL, D_FF), D_MODEL ** -0.5),
        'ffn2_w_down': nrm(ks[22], (Ld, D_FF, D_MODEL), D_FF ** -0.5),
        'final_norm_w': 1.0 + nrm(ks[23], (D_MODEL,), 0.02),
    }


def reference(x_prompt, x_sample, state_ssm, state_ssd_conv, state_sconv,
              norm_ffn1_w, ffn1_w_gate, ffn1_w_up, ffn1_w_down, norm_mix_w, w_in,
              ssd_conv_w, ssd_conv_b, dt_bias, a_log, d_skip, ssd_norm_w, sconv_w, w_out,
              norm_ffn2_w, ffn2_w_gate, ffn2_w_up, ffn2_w_down, final_norm_w):
    xp = x_prompt
    xs = x_sample
    bp = x_prompt.shape[0]
    sp_list, cp_list, scp_list = [], [], []
    ss_list, cs_list, scs_list = [], [], []
    for i in range(DEPTH):
        w = (norm_ffn1_w[i], ffn1_w_gate[i], ffn1_w_up[i], ffn1_w_down[i], norm_mix_w[i],
             w_in[i], ssd_conv_w[i], ssd_conv_b[i], dt_bias[i], a_log[i], d_skip[i],
             ssd_norm_w[i], sconv_w[i], w_out[i], norm_ffn2_w[i], ffn2_w_gate[i],
             ffn2_w_up[i], ffn2_w_down[i])
        ssm0 = jnp.zeros((bp,) + state_ssm.shape[2:], state_ssm.dtype)
        conv0 = jnp.zeros((bp,) + state_ssd_conv.shape[2:], state_ssd_conv.dtype)
        sconv0 = jnp.zeros((bp,) + state_sconv.shape[2:], state_sconv.dtype)
        xp, S_p, c_p, sc_p = layer(xp, ssm0, conv0, sconv0, *w)
        xs, S_s, c_s, sc_s = layer(xs, state_ssm[i], state_ssd_conv[i], state_sconv[i], *w)
        sp_list.append(S_p); cp_list.append(c_p); scp_list.append(sc_p)
        ss_list.append(S_s); cs_list.append(c_s); scs_list.append(sc_s)
    y_prompt = rmsnorm(xp, final_norm_w)
    y_sample = rmsnorm(xs, final_norm_w)
    return (y_prompt, y_sample,
            jnp.stack(sp_list), jnp.stack(cp_list), jnp.stack(scp_list),
            jnp.stack(ss_list), jnp.stack(cs_list), jnp.stack(scs_list))
```

```cpp
#include <hip/hip_runtime.h>
#include <hip/hip_cooperative_groups.h>
#include <cstdio>
#include <cstdint>
namespace cg = cooperative_groups;
namespace pg8 {
#define PG8_LAS __attribute__((address_space(3)))
typedef unsigned short bf16_t;
typedef short bf16x8 __attribute__((ext_vector_type(8)));
typedef float f32x4 __attribute__((ext_vector_type(4)));
typedef unsigned u32x4 __attribute__((ext_vector_type(4)));
constexpr int BM = 256, BK = 64, HALF = 128, HTB = HALF * BK * 2  , STAGE_BYTES = 8 * HTB, NXCD = 8, WGM = 8;

__host__ __device__ __forceinline__ int lds_byte(int r, int c) { const int st = (r >> 4) * 2 + (c >> 5), rr = r & 15, cc = c & 31, ob = rr * 64 + cc * 2; return st * 1024 + (ob ^ (((ob >> 9) & 1) << 5)); }
__host__ __device__ __forceinline__ void stage_rc(int b, int& R, int& C) { const int st = b / 1024, sb = b % 1024, swz = sb ^ (((sb >> 9) & 1) << 5); R = (st >> 1) * 16 + swz / 64; C = (st & 1) * 32 + (swz % 64) / 2; }
__host__ __device__ __forceinline__ int perm32(int rho) { const int n = rho >> 4, i = rho & 15; return 8 * (i >> 2) + 4 * n + (i & 3); }

struct Unit { int pm, pn; };
struct Gemm { const bf16_t* A; const bf16_t* Bt; int M, N, K, lda; };

struct StaticOrder {
    int nM, nN, nwg, G, c;
    __host__ __device__ void init(int M, int N, int G_, int c_) { nM = M / BM; nN = N / BM; nwg = nM * nN; G = G_; c = c_; }
    __host__ __device__ bool next(int i, Unit& u) const {
        const long L = (long)i * G + c; if (L >= nwg) return false;
        int wgid = (int)L; { const int q = nwg / NXCD, r = nwg % NXCD, xcd = wgid % NXCD, off = wgid / NXCD; wgid = (xcd < r ? xcd * (q + 1) : r * (q + 1) + (xcd - r) * q) + off; }
        const int nig = WGM * nN, gid = wgid / nig, fm = gid * WGM, gsz = (nM - fm) < WGM ? (nM - fm) : WGM;
        u.pm = fm + ((wgid % nig) % gsz); u.pn = (wgid % nig) / gsz; return true;
    }
    __device__ __forceinline__ void a_ready(const Unit&) const {}
    __device__ __forceinline__ void done(const Unit&) const {}
};


__device__ __forceinline__ unsigned cvt_pk_bf16(float lo, float hi) { unsigned r; asm volatile("v_cvt_pk_bf16_f32 %0, %1, %2" : "=v"(r) : "v"(lo), "v"(hi)); return r; }
__device__ __forceinline__ float silu_f(float v) { return v * __builtin_amdgcn_rcpf(1.0f + __expf(-v)); }
typedef unsigned u32x2 __attribute__((ext_vector_type(2)));

typedef float f32x2 __attribute__((ext_vector_type(2)));
__device__ __forceinline__ f32x2 swiglu_pk(f32x2 g, f32x2 u) {
    const f32x2 t = g * (-1.44269504f); f32x2 e; e.x = __builtin_amdgcn_exp2f(t.x); e.y = __builtin_amdgcn_exp2f(t.y);
    const f32x2 d = e + 1.0f; f32x2 r; r.x = __builtin_amdgcn_rcpf(d.x); r.y = __builtin_amdgcn_rcpf(d.y);
    return (g * u) * r;
}
template <bool SCALE> struct EpiSwiGLU {
    static constexpr bool PERM = true, AFTER_DRAIN = false, KSCALE = false;
    bf16_t* H; int ldh; const float* ss;
    __device__ __forceinline__ void prefetch(const Unit& u, int wr, int fr, float (&rsv)[8]) const {
        const int row0 = u.pm * BM + wr * 64 + fr;
#pragma unroll
        for (int q = 0; q < 8; ++q) rsv[q] = SCALE ? ss[row0 + (q >> 2) * HALF + (q & 3) * 16] : 0.f;
    }
    __device__ __forceinline__ void operator()(const f32x4 (&acc)[2][2][4][2], const Unit& u, int wr, int wc, int fr, int fq, const float (&rsv)[8]) const {
        const int row0 = u.pm * BM + wr * 64 + fr, col0 = u.pn * HALF + wc * 32 + 8 * fq;
#pragma unroll
        for (int ai = 0; ai < 2; ++ai)
#pragma unroll
            for (int m = 0; m < 4; ++m) {
                const int row = row0 + ai * HALF + m * 16;
                f32x4 g0 = acc[ai][0][m][0], g1 = acc[ai][0][m][1], u0 = acc[ai][1][m][0], u1 = acc[ai][1][m][1];
                if (SCALE) { const float rs = rsqrtf(rsv[ai * 4 + m] * (1.0f / 1024.0f) + 1e-6f); g0 = g0 * rs; g1 = g1 * rs; u0 = u0 * rs; u1 = u1 * rs; }
                const f32x2 h0 = swiglu_pk((f32x2){g0[0], g0[1]}, (f32x2){u0[0], u0[1]}), h1 = swiglu_pk((f32x2){g0[2], g0[3]}, (f32x2){u0[2], u0[3]}),
                            h2 = swiglu_pk((f32x2){g1[0], g1[1]}, (f32x2){u1[0], u1[1]}), h3 = swiglu_pk((f32x2){g1[2], g1[3]}, (f32x2){u1[2], u1[3]});
                u32x4 w; w.x = cvt_pk_bf16(h0.x, h0.y); w.y = cvt_pk_bf16(h1.x, h1.y); w.z = cvt_pk_bf16(h2.x, h2.y); w.w = cvt_pk_bf16(h3.x, h3.y);
                *(u32x4*)(H + (size_t)row * ldh + col0) = w;
            }
    }
};
struct EpiProj {
    static constexpr bool PERM = true, AFTER_DRAIN = false, KSCALE = false;
    bf16_t* P; int ldp; const float* ss; float* dtb; int npn; int skip; int pn_u0;
    __device__ __forceinline__ void prefetch(const Unit& u, int wr, int fr, float (&rsv)[8]) const {
        const int row0 = u.pm * BM + wr * 64 + fr;
#pragma unroll
        for (int q = 0; q < 8; ++q) rsv[q] = ss[row0 + (q >> 2) * HALF + (q & 3) * 16];
    }
    __device__ __forceinline__ void operator()(const f32x4 (&acc)[2][2][4][2], const Unit& u, int wr, int wc, int fr, int fq, const float (&rsv)[8]) const {
        if (skip) return;
        const int row0 = u.pm * BM + wr * 64 + fr, col0 = u.pn * BM + wc * 32 + 8 * fq;
#pragma unroll
        for (int ai = 0; ai < 2; ++ai)
#pragma unroll
            for (int m = 0; m < 4; ++m) {
                const int row = row0 + ai * HALF + m * 16;
                const float rs = rsqrtf(rsv[ai * 4 + m] * (1.0f / 1024.0f) + 1e-6f);
                if (u.pn >= pn_u0 && u.pn < npn) {
                    const f32x4 c0 = acc[ai][0][m][0] * rs, c1 = acc[ai][0][m][1] * rs, h0 = acc[ai][1][m][0] * rs, h1 = acc[ai][1][m][1] * rs; u32x4 w;
                    w.x = cvt_pk_bf16(c0[0] * h0[0], c0[1] * h0[1]); w.y = cvt_pk_bf16(c0[2] * h0[2], c0[3] * h0[3]); w.z = cvt_pk_bf16(c1[0] * h1[0], c1[1] * h1[1]); w.w = cvt_pk_bf16(c1[2] * h1[2], c1[3] * h1[3]);
                    *(u32x4*)(P + (size_t)row * ldp + pn_u0 * BM + (u.pn - pn_u0) * HALF + wc * 32 + 8 * fq) = w;
                } else if (u.pn < npn) {
#pragma unroll
                    for (int bj = 0; bj < 2; ++bj) { f32x4 v0 = acc[ai][bj][m][0] * rs, v1 = acc[ai][bj][m][1] * rs; u32x4 w;
                        if (u.pn < 4) {
#pragma unroll
                            for (int e = 0; e < 4; ++e) { v0[e] = silu_f(v0[e]); v1[e] = silu_f(v1[e]); } }
                        w.x = cvt_pk_bf16(v0[0], v0[1]); w.y = cvt_pk_bf16(v0[2], v0[3]); w.z = cvt_pk_bf16(v1[0], v1[1]); w.w = cvt_pk_bf16(v1[2], v1[3]);
                        *(u32x4*)(P + (size_t)row * ldp + col0 + bj * HALF) = w; }
                } else if (wc == 0 && fq < 2) {
                    *(f32x4*)(dtb + (size_t)row * 16 + 8 * fq) = acc[ai][0][m][0] * rs; *(f32x4*)(dtb + (size_t)row * 16 + 8 * fq + 4) = acc[ai][0][m][1] * rs;
                }
            }
    }
};
template <bool KS> struct EpiResT {
    static constexpr bool PERM = false, AFTER_DRAIN = false, KSCALE = KS;
    const float* base; float* out; float scale; bf16_t* xw; const float* wn; float* ss; const float* ssgp; const bf16_t* bbase; const float* bw;
    __device__ __forceinline__ void unit_begin(const Unit& u, PG8_LAS unsigned char* lds) const {
        PG8_LAS float* R = (PG8_LAS float*)(lds + STAGE_BYTES); const int t = threadIdx.x, row = t >> 1, g = t & 1;
        const f32x4* pp = (const f32x4*)(ssgp + ((size_t)(u.pm * BM + row) * 2 + g) * 16); const f32x4 q4 = (pp[0] + pp[1]) + (pp[2] + pp[3]);
        R[row * 2 + g] = rsqrtf(((q4[0] + q4[1]) + (q4[2] + q4[3])) * (1.0f / 512.0f) + 1e-6f);
    }
    __device__ __forceinline__ void kscale(int t, f32x4 (&acc)[2][2][4][2], int wr, int fr, PG8_LAS unsigned char* lds) const {
        const PG8_LAS float* R = (const PG8_LAS float*)(lds + STAGE_BYTES);
#pragma unroll
        for (int ai = 0; ai < 2; ++ai)
#pragma unroll
            for (int m = 0; m < 4; ++m) { const int r = ai * HALF + wr * 64 + m * 16 + fr; const float r0 = R[r * 2], r1 = R[r * 2 + 1]; const float f = (t == 8) ? r0 * __builtin_amdgcn_rcpf(r1) : r1;
#pragma unroll
                for (int bj = 0; bj < 2; ++bj)
#pragma unroll
                    for (int n = 0; n < 2; ++n) acc[ai][bj][m][n] = acc[ai][bj][m][n] * f; }
    }
    __device__ __forceinline__ void prefetch(const Unit&, int, int, float (&rsv)[8]) const {
#pragma unroll
        for (int q = 0; q < 8; ++q) rsv[q] = 0.f;
    }
    __device__ __forceinline__ void operator()(const f32x4 (&acc)[2][2][4][2], const Unit& u, int wr, int wc, int fr, int fq, const float (&)[8]) const {
        const int row0 = u.pm * BM + wr * 64 + fr, col0 = u.pn * BM + wc * 32 + 4 * fq;
        f32x4 w4[2][2];
#pragma unroll
        for (int bj = 0; bj < 2; ++bj)
#pragma unroll
            for (int n = 0; n < 2; ++n) w4[bj][n] = (xw && wn) ? *(const f32x4*)(wn + col0 + bj * HALF + n * 16) : (f32x4){1.f, 1.f, 1.f, 1.f};
        f32x4 winv[2][2];
#pragma unroll
        for (int bj = 0; bj < 2; ++bj)
#pragma unroll
            for (int n = 0; n < 2; ++n) { f32x4 t_ = {1.f, 1.f, 1.f, 1.f}; if (bbase) { const f32x4 q_ = *(const f32x4*)(bw + col0 + bj * HALF + n * 16); t_ = (f32x4){1.f / q_[0], 1.f / q_[1], 1.f / q_[2], 1.f / q_[3]}; } winv[bj][n] = t_; }
#pragma unroll
        for (int ai = 0; ai < 2; ++ai) {
        u32x2 pk[1][4][2][2];
        if (bbase) {
#pragma unroll
                for (int m = 0; m < 4; ++m)
#pragma unroll
                    for (int bj = 0; bj < 2; ++bj)
#pragma unroll
                        for (int n = 0; n < 2; ++n) pk[0][m][bj][n] = *(const u32x2*)(bbase + (size_t)(row0 + ai * HALF + m * 16) * 1024 + col0 + bj * HALF + n * 16);
        }
#pragma unroll
        for (int mh = 0; mh < 2; ++mh) {
            f32x4 bv[2][2][2];
#pragma unroll
            for (int mm = 0; mm < 2; ++mm)
#pragma unroll
                for (int bj = 0; bj < 2; ++bj)
#pragma unroll
                    for (int n = 0; n < 2; ++n) { const size_t o_ = (size_t)(row0 + ai * HALF + (2 * mh + mm) * 16) * 1024 + col0 + bj * HALF + n * 16;
                        if (bbase) { const u32x2 r_ = pk[0][2 * mh + mm][bj][n]; bv[mm][bj][n] = (f32x4){__uint_as_float(r_.x << 16), __uint_as_float(r_.x & 0xffff0000u), __uint_as_float(r_.y << 16), __uint_as_float(r_.y & 0xffff0000u)} * winv[bj][n]; }
                        else bv[mm][bj][n] = *(const f32x4*)(base + o_); }
#pragma unroll
            for (int mm = 0; mm < 2; ++mm) {
                const int m = 2 * mh + mm, row = row0 + ai * HALF + m * 16; float s = 0.f;
#pragma unroll
                for (int bj = 0; bj < 2; ++bj)
#pragma unroll
                    for (int n = 0; n < 2; ++n) { const int col = col0 + bj * HALF + n * 16; const size_t off = (size_t)row * 1024 + col;
                        const f32x4 v = bv[mm][bj][n] + acc[ai][bj][m][n] * scale; if (out) *(f32x4*)(out + off) = v;
                        s += (v[0] * v[0] + v[1] * v[1]) + (v[2] * v[2] + v[3] * v[3]);
                        if (xw) { const f32x4 ww = w4[bj][n]; u32x2 p; p.x = cvt_pk_bf16(v[0] * ww[0], v[1] * ww[1]); p.y = cvt_pk_bf16(v[2] * ww[2], v[3] * ww[3]); *(u32x2*)(xw + off) = p; } }
                if (ss) { s += __shfl_xor(s, 16); s += __shfl_xor(s, 32); if (fq == 0) atomicAdd(ss + row, s); }
            }
        }
        }
    }
};
typedef EpiResT<false> EpiRes;

template <class Epi, class Sched, bool ALIGN_EPI = false, bool SP2 = false>
__device__ __forceinline__ void gemm_phase(PG8_LAS unsigned char* lds, const Gemm g, const Sched& S, const Epi& E) {
    const int tid = threadIdx.x, wid = __builtin_amdgcn_readfirstlane(tid >> 6), lane = tid & 63, wr = wid >> 2, wc = wid & 3, fr = lane & 15, fq = lane >> 4;
    const int K = g.K, nt = K / BK;
    unsigned voffA[2], voffB[2];
#pragma unroll
    for (int i = 0; i < 2; ++i) { int R, C; stage_rc(tid * 16 + i * 8192, R, C); const int Rb = Epi::PERM ? ((R & ~31) + perm32(R & 31)) : R;
        voffA[i] = (unsigned)(R * g.lda + C) * 2u; voffB[i] = (unsigned)(Rb * K + C) * 2u; }
    const size_t kstep = (size_t)(BK * 2);
    const size_t hstepA = (size_t)HALF * g.lda * 2, hstepB = (size_t)HALF * K * 2;
    const size_t tstepA = 2 * hstepA, tstepB = 2 * hstepB;
    const unsigned ldsw = (unsigned)wid * 1024u;
    const int aoff = lds_byte(wr * 64 + fr, fq * 8), boff = lds_byte(wc * 32 + fr, fq * 8);
#define PG8_SA(b, h) (((b) * 2 + (h)) * HTB)
#define PG8_SB(b, h) ((4 + (b) * 2 + (h)) * HTB)
#define PG8_STAGE(bufoff, gbase, voff) do { _Pragma("unroll") for (int _i = 0; _i < 2; ++_i) \
        __builtin_amdgcn_global_load_lds((const unsigned*)((const char*)(gbase) + (voff)[_i]), (PG8_LAS unsigned*)(lds + (bufoff) + ldsw + _i * 8192), 16, 0, 0); } while (0)
#define PG8_LDA(dst, b, h) do { _Pragma("unroll") for (int m = 0; m < 4; ++m) _Pragma("unroll") for (int k = 0; k < 2; ++k) dst[m][k] = *(const PG8_LAS bf16x8*)(lds + PG8_SA(b, h) + aoff + m * 2048 + k * 1024); } while (0)
#define PG8_LDB(dst, b, h) do { _Pragma("unroll") for (int n = 0; n < 2; ++n) _Pragma("unroll") for (int k = 0; k < 2; ++k) dst[n][k] = *(const PG8_LAS bf16x8*)(lds + PG8_SB(b, h) + boff + n * 2048 + k * 1024); } while (0)
#define PG8_MMA(ai, bj, At, Bt) do { __builtin_amdgcn_s_setprio(1); _Pragma("unroll") for (int m = 0; m < 4; ++m) _Pragma("unroll") for (int n = 0; n < 2; ++n) _Pragma("unroll") for (int k = 0; k < 2; ++k) \
        acc[ai][bj][m][n] = __builtin_amdgcn_mfma_f32_16x16x32_bf16(Bt[n][k], At[m][k], acc[ai][bj][m][n], 0, 0, 0); __builtin_amdgcn_s_setprio(0); } while (0)
#define PG8_WAIT_V(n) asm volatile("s_waitcnt vmcnt(" #n ")" ::: "memory")
#define PG8_WAIT_L(n) asm volatile("s_waitcnt lgkmcnt(" #n ")" ::: "memory")
#define PG8_BAR __builtin_amdgcn_s_barrier()
#define PG8_SCHED __builtin_amdgcn_sched_barrier(0)
    Unit cur, nxt; int ui = 0;
    if (!S.next(0, cur)) return;
    f32x4 acc[2][2][4][2];
#pragma unroll
    for (int a = 0; a < 2; ++a)
#pragma unroll
        for (int b = 0; b < 2; ++b)
#pragma unroll
            for (int m = 0; m < 4; ++m)
#pragma unroll
                for (int n = 0; n < 2; ++n) acc[a][b][m][n] = (f32x4){0.f, 0.f, 0.f, 0.f};
    bf16x8 At[4][2], B0[2][2], B1[2][2];
    const char* cA = (const char*)g.A + (size_t)cur.pm * tstepA; const char* cB = (const char*)g.Bt + (size_t)cur.pn * tstepB;
    S.a_ready(cur);
    if constexpr (SP2) {
        PG8_STAGE(PG8_SB(0, 0), cB, voffB); PG8_STAGE(PG8_SB(0, 1), cB + hstepB, voffB); PG8_STAGE(PG8_SA(0, 0), cA, voffA); PG8_STAGE(PG8_SA(0, 1), cA + hstepA, voffA);
        if (wr == 1) PG8_BAR;
        PG8_WAIT_V(2); PG8_BAR;
        PG8_STAGE(PG8_SB(1, 0), cB + kstep, voffB); PG8_STAGE(PG8_SA(1, 0), cA + kstep, voffA); PG8_STAGE(PG8_SB(1, 1), cB + hstepB + kstep, voffB);
        PG8_WAIT_V(6); PG8_BAR;
    } else {
        PG8_STAGE(PG8_SB(0, 0), cB, voffB); PG8_STAGE(PG8_SA(0, 0), cA, voffA); PG8_STAGE(PG8_SB(0, 1), cB + hstepB, voffB); PG8_STAGE(PG8_SA(0, 1), cA + hstepA, voffA);
        if (wr == 1) PG8_BAR;
        PG8_WAIT_V(4); PG8_BAR;
        PG8_STAGE(PG8_SB(1, 0), cB + kstep, voffB); PG8_STAGE(PG8_SA(1, 0), cA + kstep, voffA); PG8_STAGE(PG8_SB(1, 1), cB + hstepB + kstep, voffB);
        PG8_WAIT_V(6); PG8_BAR;
    }
    for (;;) {
        const bool has_next = S.next(ui + 1, nxt);
        const char* nA = has_next ? (const char*)g.A + (size_t)nxt.pm * tstepA : cA; const char* nB = has_next ? (const char*)g.Bt + (size_t)nxt.pn * tstepB : cB;
        float rsv[8]; E.prefetch(cur, wr, fr, rsv);
        if constexpr (Epi::KSCALE) E.unit_begin(cur, lds);
        for (int t = 0; t < nt; t += 2) {
            if constexpr (Epi::KSCALE) { if (t == 8 || t == 16) E.kscale(t, acc, wr, fr, lds); }
            const bool last = (t == nt - 2);
            const char* a1 = cA + (size_t)(t + 1) * kstep;
            const char* a2 = last ? nA : cA + (size_t)(t + 2) * kstep; const char* b2 = last ? nB : cB + (size_t)(t + 2) * kstep;
            const char* a3 = a2 + kstep; const char* b3 = b2 + kstep;
            if (last && has_next) S.a_ready(nxt);
            if constexpr (SP2) {
            PG8_LDB(B0, 0, 0); PG8_LDB(B1, 0, 1); PG8_SCHED; PG8_LDA(At, 0, 0); PG8_STAGE(PG8_SA(1, 1), a1 + hstepA, voffA);
            PG8_WAIT_V(8); PG8_WAIT_L(0); PG8_BAR; PG8_MMA(0, 0, At, B0); PG8_MMA(0, 1, At, B1); PG8_BAR; PG8_SCHED;
            PG8_LDA(At, 0, 1); PG8_STAGE(PG8_SB(0, 0), b2, voffB); PG8_STAGE(PG8_SB(0, 1), b2 + hstepB, voffB); PG8_STAGE(PG8_SA(0, 0), a2, voffA);
            PG8_WAIT_V(8); PG8_WAIT_L(0); PG8_BAR; PG8_MMA(1, 0, At, B0); PG8_MMA(1, 1, At, B1); PG8_BAR; PG8_SCHED;
            PG8_LDB(B0, 1, 0); PG8_LDB(B1, 1, 1); PG8_SCHED; PG8_LDA(At, 1, 0); PG8_STAGE(PG8_SA(0, 1), a2 + hstepA, voffA);
            PG8_WAIT_V(8); PG8_WAIT_L(0); PG8_BAR; PG8_MMA(0, 0, At, B0); PG8_MMA(0, 1, At, B1); PG8_BAR; PG8_SCHED;
            PG8_LDA(At, 1, 1); PG8_STAGE(PG8_SB(1, 0), b3, voffB); PG8_STAGE(PG8_SB(1, 1), b3 + hstepB, voffB); PG8_STAGE(PG8_SA(1, 0), a3, voffA);
            PG8_WAIT_V(8); PG8_WAIT_L(0); PG8_BAR; PG8_MMA(1, 0, At, B0); PG8_MMA(1, 1, At, B1); PG8_BAR; PG8_SCHED;
            } else {
            PG8_LDB(B0, 0, 0); PG8_SCHED; PG8_LDA(At, 0, 0); PG8_STAGE(PG8_SA(1, 1), a1 + hstepA, voffA);
            PG8_WAIT_L(8); PG8_BAR; PG8_WAIT_L(0); PG8_MMA(0, 0, At, B0); PG8_BAR; PG8_SCHED;
            PG8_LDB(B1, 0, 1); PG8_STAGE(PG8_SB(0, 0), b2, voffB);
            PG8_BAR; PG8_WAIT_L(0); PG8_MMA(0, 1, At, B1); PG8_BAR;
            PG8_LDA(At, 0, 1); PG8_STAGE(PG8_SA(0, 0), a2, voffA);
            PG8_BAR; PG8_WAIT_L(0); PG8_MMA(1, 0, At, B0); PG8_BAR; PG8_SCHED;
            PG8_STAGE(PG8_SB(0, 1), b2 + hstepB, voffB);
            PG8_WAIT_V(6); PG8_BAR; PG8_MMA(1, 1, At, B1); PG8_BAR;
            PG8_LDB(B0, 1, 0); PG8_SCHED; PG8_LDA(At, 1, 0); PG8_STAGE(PG8_SA(0, 1), a2 + hstepA, voffA);
            PG8_WAIT_L(8); PG8_BAR; PG8_WAIT_L(0); PG8_MMA(0, 0, At, B0); PG8_BAR; PG8_SCHED;
            PG8_LDB(B1, 1, 1); PG8_STAGE(PG8_SB(1, 0), b3, voffB);
            PG8_BAR; PG8_WAIT_L(0); PG8_MMA(0, 1, At, B1); PG8_BAR;
            PG8_LDA(At, 1, 1); PG8_STAGE(PG8_SA(1, 0), a3, voffA);
            PG8_BAR; PG8_WAIT_L(0); PG8_MMA(1, 0, At, B0); PG8_BAR; PG8_SCHED;
            PG8_STAGE(PG8_SB(1, 1), b3 + hstepB, voffB);
            PG8_WAIT_V(6); PG8_BAR; PG8_MMA(1, 1, At, B1); PG8_BAR;
            }
        }
        if constexpr (ALIGN_EPI) { if (wr == 0) PG8_BAR; }
        if constexpr (!Epi::AFTER_DRAIN) { E(acc, cur, wr, wc, fr, fq, rsv); S.done(cur); }
        if (!has_next) break;
#pragma unroll
        for (int a = 0; a < 2; ++a)
#pragma unroll
            for (int b = 0; b < 2; ++b)
#pragma unroll
                for (int m = 0; m < 4; ++m)
#pragma unroll
                    for (int n = 0; n < 2; ++n) acc[a][b][m][n] = (f32x4){0.f, 0.f, 0.f, 0.f};
        cur = nxt; cA = nA; cB = nB; ++ui;
        if constexpr (ALIGN_EPI) { if (wr == 1) PG8_BAR; }
    }
    PG8_WAIT_V(0);
    if constexpr (!ALIGN_EPI) { if (wr == 0) PG8_BAR; }
    PG8_BAR;
    if constexpr (Epi::AFTER_DRAIN) { E.fused(acc, cur, wr, wc, fr, fq, lds, wid, lane); S.done(cur); }
#undef PG8_SA
#undef PG8_SB
#undef PG8_STAGE
#undef PG8_LDA
#undef PG8_LDB
#undef PG8_MMA
#undef PG8_WAIT_V
#undef PG8_WAIT_L
#undef PG8_BAR
#undef PG8_SCHED
}
}
#define LAS __attribute__((address_space(3)))
typedef unsigned short bf16;
typedef short bf16x8 __attribute__((ext_vector_type(8)));
typedef float f32x4 __attribute__((ext_vector_type(4)));
typedef float f32x16 __attribute__((ext_vector_type(16)));
typedef unsigned v4u __attribute__((ext_vector_type(4)));
typedef unsigned v2u __attribute__((ext_vector_type(2)));
constexpr int NWAVES = 8, NTHR = 512;
constexpr int DM = 1024, NBATCH = 8, SEQ = 2048, MP = NBATCH * SEQ, NS = 128, MT = MP + NS, MPAD = 16640;
constexpr int DFF = 2816, NGU = 2 * DFF, DMIX = 2048, NINP = 5888, LDPJ = 5632, DINP = 5648, CONVD = 1536;
constexpr int PC_Z = 0, PC_SCB = 1024, PC_XBC = 2048, PC_SCC = 3584, PC_SCH = 4608;
constexpr float EPS = 1e-6f;
constexpr size_t MiB = 1u << 20;
constexpr size_t WS_W2GU = 0, WS_W2D = 11 * MiB, WS_WOUT = WS_W2D + 5632 * 1024, WS_WIN = WS_WOUT + 4 * MiB, WS_XW = 32 * MiB;
constexpr size_t WS_SMALL = WS_XW + (size_t)MPAD * DM * 2;
constexpr size_t SM_SS2 = 0, SM_SS3 = 128 * 1024, SM_SSG = 256 * 1024, SM_DT = 512 * 1024;
constexpr size_t WS_PROJ = WS_SMALL + 2 * MiB;
constexpr size_t WS_W1GU = WS_PROJ, WS_W1D = WS_W1GU + 11 * MiB, WS_H = WS_W1D + 5632 * 1024;
constexpr size_t WS_END = WS_PROJ + (size_t)MPAD * LDPJ * 2;
constexpr size_t WS_BAR = WS_END, WS_SSGP = WS_BAR + 64 * 1024, WS_END2 = WS_SSGP + (size_t)MPAD * 2 * 16 * 4;
constexpr size_t WS_BCB = WS_WIN, WS_BCC = WS_END2, WS_END3 = WS_BCC + (size_t)MP * 256 * 2;
constexpr long BC_CDELTA = (long)((WS_BCC - WS_BCB) / 2);
static_assert(WS_END3 <= 256 * MiB && (size_t)MP * 256 * 2 <= (size_t)NINP * DM * 2, "d_ws map 2");
static_assert(WS_WIN + (size_t)NINP * DM * 2 <= WS_XW && WS_H + (size_t)MPAD * DFF * 2 <= WS_END && SM_DT + (size_t)MPAD * 16 * 4 <= 2 * MiB && WS_END <= 256 * MiB, "d_ws map");
constexpr size_t O_Y = 0, O_SSMP = (size_t)MT * DM, O_CONVP = O_SSMP + (size_t)NBATCH * 16 * 64 * 128, O_SCP = O_CONVP + (size_t)NBATCH * 3 * CONVD,
                 O_SSMS = O_SCP + (size_t)NBATCH * 2 * 1024, O_CONVS = O_SSMS + (size_t)NS * 16 * 64 * 128, O_SCS = O_CONVS + (size_t)NS * 3 * CONVD, O_END = O_SCS + (size_t)NS * 2 * 1024;
constexpr int LDS_BYTES = 147456;
constexpr int LDP = 136;
constexpr int CL_OFF = 0, BL_OFF = 128 * LDP * 2, BT_OFF = 2 * BL_OFF, XDT_OFF = 3 * BL_OFF, XDD_OFF = XDT_OFF + 32 * LDP * 2, SENT_OFF = XDD_OFF + 32 * LDP * 2,
              XS_OFF = SENT_OFF + 32 * LDP * 2, ACUM_OFF = XS_OFF + 128 * 32 * 2, DTV_OFF = ACUM_OFF + 1024, WBC_OFF = DTV_OFF + 1024, WX_OFF = WBC_OFF + 5 * 256 * 4, SSD_LDS_END = WX_OFF + 5 * 32 * 4;
static_assert(SSD_LDS_END <= LDS_BYTES, "LDS map");

struct Args { const float* in[24]; float* out; unsigned char* ws; int ph_lo, ph_hi, flags, pad; };
enum { I_XP = 0, I_XS, I_SSM, I_SCONV0, I_SSCONV, I_N1W, I_F1G, I_F1U, I_F1D, I_NMW, I_WIN, I_CW, I_CB, I_DTB, I_ALOG, I_DSKIP, I_SNW, I_SCW, I_WOUT, I_N2W, I_F2G, I_F2U, I_F2D, I_FNW };

__device__ __forceinline__ float bf2f(unsigned short b) { return __uint_as_float((unsigned)b << 16); }
__device__ __forceinline__ unsigned pk2(float lo, float hi) { return pg8::cvt_pk_bf16(lo, hi); }
__device__ __forceinline__ unsigned short f2bf1(float f) { return (unsigned short)(pg8::cvt_pk_bf16(f, 0.f) & 0xffffu); }
__device__ __forceinline__ float silu(float v) { return pg8::silu_f(v); }
__device__ __forceinline__ float softplus(float x) { return x > 20.f ? x : log1pf(__expf(x)); }
__device__ __forceinline__ float softplus_fast(float x) { const float e = __expf(x); return x > 20.f ? x : (e < 0.03125f ? e * (1.f + e * (-0.5f + e * (0.33333333f - 0.25f * e))) : __logf(1.f + e)); }
__device__ __forceinline__ float wave_sum(float v) {
#pragma unroll
    for (int o = 1; o < 64; o <<= 1) v += __shfl_xor(v, o);
    return v;
}
__device__ __forceinline__ void unpack8(const v4u r, float (&f)[8]) {
#pragma unroll
    for (int i = 0; i < 4; ++i) { f[2 * i] = __uint_as_float(r[i] << 16); f[2 * i + 1] = __uint_as_float(r[i] & 0xffff0000u); }
}
#define LDS_WAIT() asm volatile("s_waitcnt lgkmcnt(0)" ::: "memory")
#define MFMA32(a, b, c) __builtin_amdgcn_mfma_f32_32x32x16_bf16((a), (b), (c), 0, 0, 0)

__device__ __forceinline__ void p0_item(const float* W, int K, int Nsrc, int src_col0, int nvalid, bf16* WT, int dst_row0, int kb, LAS float* scr, int lane, const float* rscale = nullptr) {
    const int k0 = 64 * kb, nl = lane & 31; const bool ok = nl < nvalid;
#pragma unroll
    for (int i = 0; i < 32; ++i) { const int kk = 2 * i + (lane >> 5); float v = ok ? W[(size_t)(k0 + kk) * Nsrc + src_col0 + nl] : 0.f; if (rscale && k0 + kk < 1024) v *= rscale[k0 + kk]; scr[kk * 33 + nl] = v; }
    LDS_WAIT();
    const int c = lane & 7;
#pragma unroll
    for (int j = 0; j < 4; ++j) { const int n = (lane >> 3) + 8 * j; const LAS float* s = scr + (8 * c) * 33 + n;
        v4u o; o.x = pk2(s[0 * 33], s[1 * 33]); o.y = pk2(s[2 * 33], s[3 * 33]); o.z = pk2(s[4 * 33], s[5 * 33]); o.w = pk2(s[6 * 33], s[7 * 33]);
        *(v4u*)(WT + (size_t)(dst_row0 + n) * K + k0 + 8 * c) = o; }
    LDS_WAIT();
}
constexpr int P0_I_GU = 176 * 16, P0_I_D = 32 * 44, P0_I_IN = 184 * 16, P0_I_O = 32 * 32, P0_NITEMS = 2 * P0_I_GU + 2 * P0_I_D + P0_I_IN + P0_I_O;
__device__ __forceinline__ void p0_do_item(const Args& a, int it, LAS float* scr, int lane) {
    unsigned char* ws = a.ws; int r = it;
    if (r < 2 * P0_I_GU) {
        const int which = r >= P0_I_GU; r -= which * P0_I_GU; const int kb = r / 176, nb = r % 176, tile = nb >> 3, sub = nb & 7, bj = sub >> 2, c0 = (sub & 3) * 32;
        const float* W = which ? (bj ? a.in[I_F2U] : a.in[I_F2G]) : (bj ? a.in[I_F1U] : a.in[I_F1G]);
        p0_item(W, DM, DFF, tile * 128 + c0, 32, (bf16*)(ws + (which ? WS_W2GU : WS_W1GU)), nb * 32, kb, scr, lane); return; }
    r -= 2 * P0_I_GU;
    if (r < 2 * P0_I_D) { const int which = r >= P0_I_D; r -= which * P0_I_D; const int kb = r / 32, nb = r % 32;
        p0_item(which ? a.in[I_F2D] : a.in[I_F1D], DFF, DM, nb * 32, 32, (bf16*)(ws + (which ? WS_W2D : WS_W1D)), nb * 32, kb, scr, lane); return; }
    r -= 2 * P0_I_D;
    if (r < P0_I_IN) { const int kb = r / 184, nb = r % 184, n = nb * 32; int src, nv = 32;
        if (n < 1024) src = n; else if (n < 2048) src = 2576 + (n - 1024); else if (n < 3584) src = 1024 + (n - 2048); else if (n < 5632) { const int tl_ = (n - 3584) >> 8, w_ = (n - 3584) & 255; src = w_ < 128 ? 3600 + 128 * tl_ + w_ : 4624 + 128 * tl_ + (w_ - 128); }
        else if (n == 5632) { src = 2560; nv = 16; } else { src = 0; nv = 0; }
        p0_item(a.in[I_WIN], DM, DINP, src, nv, (bf16*)(ws + WS_WIN), n, kb, scr, lane); return; }
    r -= P0_I_IN;
    { const int kb = r / 32, nb = r % 32; p0_item(a.in[I_WOUT], DMIX, DM, nb * 32, 32, (bf16*)(ws + WS_WOUT), nb * 32, kb, scr, lane, a.in[I_SNW]); }
}
__device__ __forceinline__ void p0_late_weights(const Args& a, LAS unsigned char* lds, int gw, int NGW, int wave, int lane) {
    LAS float* scr = (LAS float*)(lds + wave * 16384);
    constexpr int NL = P0_I_GU + P0_I_D + P0_I_O;
    for (int i = gw; i < NL; i += NGW) {
        const int it = i < P0_I_GU ? P0_I_GU + i : (i < P0_I_GU + P0_I_D ? 2 * P0_I_GU + P0_I_D + (i - P0_I_GU) : 2 * P0_I_GU + 2 * P0_I_D + P0_I_IN + (i - P0_I_GU - P0_I_D));
        p0_do_item(a, it, scr, lane); }
}
__device__ __forceinline__ void p0_prologue(const Args& a, LAS unsigned char* lds, int gw, int NGW, int wave, int lane) {
    LAS float* scr = (LAS float*)(lds + wave * 16384);
    unsigned char* ws = a.ws;
    constexpr int NE = P0_I_GU + P0_I_D + P0_I_IN;
    for (int i = gw; i < NE; i += NGW) {
        const int it = i < P0_I_GU ? i : (i < P0_I_GU + P0_I_D ? 2 * P0_I_GU + (i - P0_I_GU) : 2 * P0_I_GU + 2 * P0_I_D + (i - P0_I_GU - P0_I_D));
        p0_do_item(a, it, scr, lane); }
    bf16* XW = (bf16*)(ws + WS_XW);
    for (int m0 = gw; m0 < MPAD; m0 += 2 * NGW) {
        f32x4 v[2][4]; float sq[2] = {0.f, 0.f};
#pragma unroll
        for (int q = 0; q < 2; ++q) { const int m = m0 + q * NGW, mc = m < MT ? m : MT - 1;
            const float* xrow = mc < MP ? a.in[I_XP] + (size_t)mc * DM : a.in[I_XS] + (size_t)(mc - MP) * DM; const f32x4* xr = (const f32x4*)xrow + lane;
#pragma unroll
            for (int j = 0; j < 4; ++j) v[q][j] = xr[64 * j]; }
#pragma unroll
        for (int q = 0; q < 2; ++q) { const float keep = (m0 + q * NGW < MT) ? 1.f : 0.f;
#pragma unroll
            for (int j = 0; j < 4; ++j) v[q][j] = v[q][j] * keep; }
        const f32x4* wr = (const f32x4*)a.in[I_N1W] + lane;
#pragma unroll
        for (int q = 0; q < 2; ++q)
#pragma unroll
            for (int j = 0; j < 4; ++j) sq[q] += (v[q][j].x * v[q][j].x + v[q][j].y * v[q][j].y) + (v[q][j].z * v[q][j].z + v[q][j].w * v[q][j].w);
#pragma unroll
        for (int q = 0; q < 2; ++q) { const int m = m0 + q * NGW; if (m >= MPAD) continue;
            const float rstd = rsqrtf(wave_sum(sq[q]) * (1.f / DM) + EPS);
            unsigned long long* o8 = (unsigned long long*)(XW + (size_t)m * DM) + lane;
#pragma unroll
            for (int j = 0; j < 4; ++j) { const f32x4 w4 = wr[64 * j]; o8[64 * j] = (unsigned long long)pk2(v[q][j].x * rstd * w4.x, v[q][j].y * rstd * w4.y) | ((unsigned long long)pk2(v[q][j].z * rstd * w4.z, v[q][j].w * rstd * w4.w) << 32); } }
    }
    { f32x4* z = (f32x4*)(ws + WS_SMALL); const int n16 = (int)(SM_DT / 16); for (int i = gw * 64 + lane; i < n16; i += NGW * 64) z[i] = (f32x4){0.f, 0.f, 0.f, 0.f}; }
}

__device__ __forceinline__ void small_gemm(LAS unsigned char* lds, const bf16* A, int lda, const bf16* Bt, int K,
                                           const float* base, float* out, float scale, bf16* xw, const float* wn, float* ss, const float* ssgp_rows = nullptr, const bf16* bbase = nullptr, const float* bw = nullptr) {
    const int tid = threadIdx.x, wid = __builtin_amdgcn_readfirstlane(tid >> 6), lane = tid & 63, i = lane & 15, q = lane >> 4, ks = wid & 3, tl = wid >> 2;
    LAS f32x4* red = (LAS f32x4*)lds;
    const int kq = K >> 2;
    for (int t0 = blockIdx.x * 2; t0 < 512; t0 += gridDim.x * 2) {
        const int t = t0 + tl, tr = t >> 6, tc = t & 63;
        f32x4 acc = {0.f, 0.f, 0.f, 0.f};
        if (t < 512) {
            const bf16* ap = A + (size_t)(tr * 16 + i) * lda + ks * kq + 8 * q; const bf16* bp = Bt + (size_t)(tc * 16 + i) * K + ks * kq + 8 * q;
#pragma unroll 4
            for (int k = 0; k < kq; k += 32) { const bf16x8 av = *(const bf16x8*)(ap + k), bv = *(const bf16x8*)(bp + k); acc = __builtin_amdgcn_mfma_f32_16x16x32_bf16(bv, av, acc, 0, 0, 0); }
        }
        if (ssgp_rows && ks < 2 && t < 512) {
            const f32x4* pp = (const f32x4*)(ssgp_rows + ((size_t)(tr * 16 + i) * 2 + ks) * 16); const f32x4 q4 = (pp[0] + pp[1]) + (pp[2] + pp[3]);
            acc = acc * rsqrtf(((q4[0] + q4[1]) + (q4[2] + q4[3])) * (1.0f / 512.0f) + 1e-6f); }
        red[(tl * 4 + ks) * 64 + lane] = acc;
        __syncthreads();
        if (ks == 0 && t < 512) {
            const f32x4 sum = (red[(tl * 4 + 0) * 64 + lane] + red[(tl * 4 + 1) * 64 + lane]) + (red[(tl * 4 + 2) * 64 + lane] + red[(tl * 4 + 3) * 64 + lane]);
            const int row = tr * 16 + i, col = tc * 16 + 4 * q; const size_t off = (size_t)row * 1024 + col;
            f32x4 bs_;
            if (bbase) { const v2u r_ = *(const v2u*)(bbase + off); const f32x4 q_ = *(const f32x4*)(bw + col);
                bs_ = (f32x4){__uint_as_float(r_.x << 16) / q_[0], __uint_as_float(r_.x & 0xffff0000u) / q_[1], __uint_as_float(r_.y << 16) / q_[2], __uint_as_float(r_.y & 0xffff0000u) / q_[3]}; }
            else bs_ = *(const f32x4*)(base + off);
            const f32x4 v = bs_ + sum * scale; if (out) *(f32x4*)(out + off) = v;
            float s = (v[0] * v[0] + v[1] * v[1]) + (v[2] * v[2] + v[3] * v[3]);
            if (xw) { const f32x4 w4 = wn ? *(const f32x4*)(wn + col) : (f32x4){1.f, 1.f, 1.f, 1.f}; v2u p; p.x = pk2(v[0] * w4[0], v[1] * w4[1]); p.y = pk2(v[2] * w4[2], v[3] * w4[3]); *(v2u*)(xw + off) = p; }
            if (ss) { s += __shfl_xor(s, 16); s += __shfl_xor(s, 32); if (q == 0) atomicAdd(ss + row, s); }
        }
        __syncthreads();
    }
}

__device__ __forceinline__ void bc_conv_prepass(const Args& a, int gw, int NGW, int lane) {
    const bf16* proj = (const bf16*)(a.ws + WS_PROJ); bf16* BCB = (bf16*)(a.ws + WS_BCB);
    const float* cw = a.in[I_CW] + 1024 + 8 * lane; const float* cb = a.in[I_CB] + 1024 + 8 * lane;
    float w[4][8], bi[8];
#pragma unroll
    for (int k = 0; k < 4; ++k) { const f32x4 w0 = *(const f32x4*)(cw + k * CONVD), w1 = *(const f32x4*)(cw + k * CONVD + 4);
        w[k][0] = w0[0]; w[k][1] = w0[1]; w[k][2] = w0[2]; w[k][3] = w0[3]; w[k][4] = w1[0]; w[k][5] = w1[1]; w[k][6] = w1[2]; w[k][7] = w1[3]; }
    { const f32x4 b0 = *(const f32x4*)(cb), b1 = *(const f32x4*)(cb + 4); bi[0] = b0[0]; bi[1] = b0[1]; bi[2] = b0[2]; bi[3] = b0[3]; bi[4] = b1[0]; bi[5] = b1[1]; bi[6] = b1[2]; bi[7] = b1[3]; }
    for (int u = gw; u < MP / 8; u += NGW) {
        const int row0 = u * 8, l0 = row0 & (SEQ - 1);
        const bf16* src = proj + (size_t)(row0 - 3) * LDPJ + PC_XBC + 1024 + 8 * lane;
        v4u raw[11];
#pragma unroll
        for (int rr = 0; rr < 11; ++rr) raw[rr] = (l0 - 3 + rr >= 0) ? *(const v4u*)(src + (size_t)rr * LDPJ) : (v4u){0u, 0u, 0u, 0u};
#pragma unroll
        for (int t = 0; t < 8; ++t) {
            float x0[8], x1[8], x2[8], x3[8], o[8]; unpack8(raw[t], x0); unpack8(raw[t + 1], x1); unpack8(raw[t + 2], x2); unpack8(raw[t + 3], x3);
#pragma unroll
            for (int j = 0; j < 8; ++j) o[j] = silu(bi[j] + w[0][j] * x0[j] + w[1][j] * x1[j] + w[2][j] * x2[j] + w[3][j] * x3[j]);
            v4u p; p.x = pk2(o[0], o[1]); p.y = pk2(o[2], o[3]); p.z = pk2(o[4], o[5]); p.w = pk2(o[6], o[7]);
            *(v4u*)(BCB + (lane < 32 ? 0 : BC_CDELTA) + (size_t)(row0 + t) * 256 + 8 * (lane & 31)) = p;
        }
    }
}

__device__ __forceinline__ int crow(int i, int hh) { return (i & 3) + 8 * (i >> 2) + 4 * hh; }
__device__ __forceinline__ void ssd_prompt(const Args& a, LAS unsigned char* lds, int unit) {
    const int tid0 = threadIdx.x, wid = __builtin_amdgcn_readfirstlane(tid0 >> 6);
    const int b = unit >> 5, h = (unit >> 1) & 15, ph = unit & 1, g = h >> 3;
    const float A_h = -__expf(a.in[I_ALOG][h]), dtb = a.in[I_DTB][h], Dh = a.in[I_DSKIP][h];
    bf16* proj = (bf16*)(a.ws + WS_PROJ); const float* dtbuf = (const float*)(a.ws + WS_SMALL + SM_DT); float* ssgp = (float*)(a.ws + WS_SSGP);
    LAS bf16* Cl = (LAS bf16*)(lds + CL_OFF); LAS bf16* Bl = (LAS bf16*)(lds + BL_OFF); LAS bf16* BT = (LAS bf16*)(lds + BT_OFF);
    LAS bf16* XDT = (LAS bf16*)(lds + XDT_OFF); LAS bf16* XDD = (LAS bf16*)(lds + XDD_OFF); LAS bf16* SENT = (LAS bf16*)(lds + SENT_OFF); LAS bf16* XS = (LAS bf16*)(lds + XS_OFF);
    LAS float* acum2 = (LAS float*)(lds + ACUM_OFF); LAS float* dtv2 = (LAS float*)(lds + DTV_OFF); LAS float* eac2 = (LAS float*)(lds + WBC_OFF); LAS float* WX = (LAS float*)(lds + WX_OFF);
    for (int i = tid0; i < 32 * LDP / 2; i += NTHR) ((LAS unsigned*)SENT)[i] = 0u;
    {
        const float* cw = a.in[I_CW]; const float* cb = a.in[I_CB];
        if (tid0 < 160) { const int k = tid0 >> 5, ch = h * 64 + 32 * ph + (tid0 & 31); WX[tid0] = k < 4 ? cw[k * CONVD + ch] : cb[ch]; }
    }
    const bf16* BCB = (const bf16*)(a.ws + WS_BCB);
    f32x16 st;
#pragma unroll
    for (int i = 0; i < 16; ++i) st[i] = 0.f;
    v4u nraw[8], nxraw[4]; float ndt0 = 0.f, ndt1 = 0.f;
    {
        const int tcol = tid0 & 15, tg = tid0 >> 4, xl = (tid0 & 15) | ((tid0 >> 6) << 4), xc = (tid0 >> 4) & 3;
        const bf16* src = BCB + (size_t)(b * SEQ + 4 * tg) * 256 + g * 128 + 8 * tcol;
#pragma unroll
        for (int rr = 0; rr < 4; ++rr) { nraw[rr] = *(const v4u*)(src + (size_t)rr * 256); nraw[4 + rr] = *(const v4u*)(src + BC_CDELTA + (size_t)rr * 256); }
        const bf16* srx = proj + (size_t)(b * SEQ + xl - 3) * LDPJ + PC_XBC + h * 64 + 32 * ph + 8 * xc;
#pragma unroll
        for (int rr = 0; rr < 4; ++rr) nxraw[rr] = (xl - 3 + rr >= 0) ? *(const v4u*)(srx + (size_t)rr * LDPJ) : (v4u){0u, 0u, 0u, 0u};
        if (wid == 4) { const int l0 = 2 * (tid0 & 63); ndt0 = dtbuf[(size_t)(b * SEQ + l0) * 16 + h]; ndt1 = dtbuf[(size_t)(b * SEQ + l0 + 1) * 16 + h]; }
    }
#define SSD_STAGE_D(buf) do { const int ln_ = tid0 & 63, l0_ = 2 * ln_; const float d0_ = softplus_fast(ndt0 + dtb), d1_ = softplus_fast(ndt1 + dtb), a0_ = d0_ * A_h, a1_ = d1_ * A_h, s_ = a0_ + a1_; float incl_ = s_; \
        _Pragma("unroll") for (int o_ = 1; o_ < 64; o_ <<= 1) { const float t_ = __shfl_up(incl_, o_); if (ln_ >= o_) incl_ += t_; } \
        const float c0_ = (incl_ - s_ + a0_) * 1.44269504f, c1_ = incl_ * 1.44269504f; acum2[(buf) * 128 + l0_] = c0_; acum2[(buf) * 128 + l0_ + 1] = c1_; eac2[(buf) * 128 + l0_] = __builtin_amdgcn_exp2f(c0_); eac2[(buf) * 128 + l0_ + 1] = __builtin_amdgcn_exp2f(c1_); dtv2[(buf) * 128 + l0_] = d0_; dtv2[(buf) * 128 + l0_ + 1] = d1_; } while (0)
    if (wid == 4) SSD_STAGE_D(0);
    __syncthreads();
    const bf16* p_bc; const bf16* p_x; bf16* p_z; const float* p_dt; float* p_sq;
    {   const int tcol = tid0 & 15, tg = tid0 >> 4, xl = (tid0 & 15) | ((tid0 >> 6) << 4), xc = (tid0 >> 4) & 3;
        p_bc = BCB + (size_t)(b * SEQ + 128 + 4 * tg) * 256 + g * 128 + 8 * tcol;
        p_x = proj + (size_t)(b * SEQ + 128 + xl - 3) * LDPJ + PC_XBC + h * 64 + 32 * ph + 8 * xc;
        p_z = proj + (size_t)(b * SEQ + xl) * LDPJ + PC_Z + h * 64 + 32 * ph + 8 * xc;
        p_dt = dtbuf + (size_t)(b * SEQ + 128 + 2 * (tid0 & 63)) * 16 + h;
        p_sq = ssgp + ((size_t)(b * SEQ + xl) * 2 + g) * 16 + (h & 7) * 2 + ph; }
#define SSD_BAR() do { asm volatile("s_waitcnt lgkmcnt(0)" ::: "memory"); __builtin_amdgcn_s_barrier(); asm volatile("" ::: "memory"); } while (0)
#pragma unroll 1
    for (int c = 0; c < 16; ++c) {
        int tid = tid0; asm volatile("" : "+v"(tid));
        const int lane = tid & 63, r = lane & 31, hh = lane >> 5;
        const int tcol = tid & 15, tg = tid >> 4;
        const int xl = (tid & 15) | ((tid >> 6) << 4), xc = (tid >> 4) & 3;
        const int tok0 = b * SEQ + c * 128;
        LAS float* acum = acum2 + (c & 1) * 128; LAS float* dtv = dtv2 + (c & 1) * 128; LAS float* eac = eac2 + (c & 1) * 128;
        {
#pragma unroll
            for (int t = 0; t < 4; ++t) { *(LAS v4u*)(Bl + (4 * tg + t) * LDP + 8 * tcol) = nraw[t]; *(LAS v4u*)(Cl + (4 * tg + t) * LDP + 8 * tcol) = nraw[4 + t]; }
            const int boff = 8 * ((tg >> 1) ^ tcol) + 4 * (tg & 1);
#pragma unroll
            for (int i = 0; i < 4; ++i) { v2u lo, hi;
#pragma unroll
                for (int u = 0; u < 2; ++u) { const unsigned e0 = nraw[2 * u][i], e1 = nraw[2 * u + 1][i]; lo[u] = (e0 & 0xffffu) | (e1 << 16); hi[u] = (e0 >> 16) | (e1 & 0xffff0000u); }
                *(LAS v2u*)(BT + (8 * tcol + 2 * i) * LDP + boff) = lo; *(LAS v2u*)(BT + (8 * tcol + 2 * i + 1) * LDP + boff) = hi; }
        }
        {
            float x0[8], x1[8], x2[8], x3[8]; unpack8(nxraw[0], x0); unpack8(nxraw[1], x1); unpack8(nxraw[2], x2); unpack8(nxraw[3], x3);
            float xo[8];
#pragma unroll
            for (int hf = 0; hf < 2; ++hf) { const f32x4 w0 = *(const LAS f32x4*)(WX + 0 * 32 + 8 * xc + 4 * hf), w1 = *(const LAS f32x4*)(WX + 1 * 32 + 8 * xc + 4 * hf), w2 = *(const LAS f32x4*)(WX + 2 * 32 + 8 * xc + 4 * hf),
                                                     w3 = *(const LAS f32x4*)(WX + 3 * 32 + 8 * xc + 4 * hf), bb = *(const LAS f32x4*)(WX + 4 * 32 + 8 * xc + 4 * hf);
#pragma unroll
                for (int e = 0; e < 4; ++e) { const int j = 4 * hf + e; xo[j] = silu(bb[e] + w0[e] * x0[j] + w1[e] * x1[j] + w2[e] * x2[j] + w3[e] * x3[j]); } }
            const float dl = dtv[xl], de = dl * __builtin_amdgcn_exp2f(acum[127] - acum[xl]);
            { v4u p; p.x = pk2(xo[0], xo[1]); p.y = pk2(xo[2], xo[3]); p.z = pk2(xo[4], xo[5]); p.w = pk2(xo[6], xo[7]); *(LAS v4u*)(XS + xl * 32 + 8 * xc) = p; }
#pragma unroll
            for (int j = 0; j < 8; ++j) { const unsigned pk = pk2(xo[j] * dl, xo[j] * de); XDT[(8 * xc + j) * LDP + xl] = (unsigned short)pk; XDD[(8 * xc + j) * LDP + xl] = (unsigned short)(pk >> 16); }
        }
        SSD_BAR();
        if (c < 15) {
#pragma unroll
            for (int rr = 0; rr < 4; ++rr) { nraw[rr] = *(const v4u*)(p_bc + (size_t)rr * 256); nraw[4 + rr] = *(const v4u*)(p_bc + BC_CDELTA + (size_t)rr * 256); }
#pragma unroll
            for (int rr = 0; rr < 4; ++rr) nxraw[rr] = *(const v4u*)(p_x + (size_t)rr * LDPJ);
            if (wid == 4) { ndt0 = p_dt[0]; ndt1 = p_dt[16]; }
        }
        const v4u zraw = *(const v4u*)p_z;
        const int lb = wid >> 1, sh = wid & 1;
        f32x16 sacc[2];
        {
            bf16x8 cf[8];
#pragma unroll
            for (int ks = 0; ks < 8; ++ks) cf[ks] = *(const LAS bf16x8*)(Cl + (32 * lb + r) * LDP + 16 * ks + 8 * hh);
#pragma unroll
            for (int tt = 0; tt < 2; ++tt) { const int sb = 2 * sh + tt;
#pragma unroll
                for (int i = 0; i < 16; ++i) sacc[tt][i] = 0.f;
                if (sb <= lb) {
#pragma unroll
                    for (int ks = 0; ks < 8; ++ks) { const bf16x8 af = *(const LAS bf16x8*)(Bl + (32 * sb + r) * LDP + 16 * ks + 8 * hh); sacc[tt] = MFMA32(af, cf[ks], sacc[tt]); } } }
        }
        SSD_BAR();
        {
            LAS bf16* P = Bl; const int l = 32 * lb + r; const float al = acum[l];
#pragma unroll
            for (int tt = 0; tt < 2; ++tt) { const int sb = 2 * sh + tt;
                if (sb < lb) {
#pragma unroll
                    for (int gq = 0; gq < 4; ++gq) { const int s0 = 32 * sb + 8 * gq + 4 * hh; const f32x4 as4 = *(const LAS f32x4*)(acum + s0); float v[4];
#pragma unroll
                        for (int e = 0; e < 4; ++e) v[e] = sacc[tt][4 * gq + e] * __builtin_amdgcn_exp2f(al - as4[e]);
                        v2u p; p.x = pk2(v[0], v[1]); p.y = pk2(v[2], v[3]); *(LAS v2u*)(P + l * LDP + s0) = p; }
                } else if (sb == lb) {
#pragma unroll
                    for (int gq = 0; gq < 4; ++gq) { const int s0 = 32 * sb + 8 * gq + 4 * hh; const f32x4 as4 = *(const LAS f32x4*)(acum + s0); float v[4];
#pragma unroll
                        for (int e = 0; e < 4; ++e) v[e] = (s0 + e <= l) ? sacc[tt][4 * gq + e] * __builtin_amdgcn_exp2f(al - as4[e]) : 0.f;
                        v2u p; p.x = pk2(v[0], v[1]); p.y = pk2(v[2], v[3]); *(LAS v2u*)(P + l * LDP + s0) = p; } } }
        }
        SSD_BAR();
        asm volatile("" : "+v"(nraw[0]), "+v"(nraw[1]), "+v"(nraw[2]), "+v"(nraw[3]), "+v"(nraw[4]), "+v"(nraw[5]), "+v"(nraw[6]), "+v"(nraw[7]), "+v"(nxraw[0]), "+v"(nxraw[1]), "+v"(nxraw[2]), "+v"(nxraw[3]), "+v"(ndt0), "+v"(ndt1));
        if (wid < 4) {
            const int lb2 = wid; const LAS bf16* P = Bl;
            f32x16 yd, yo;
#pragma unroll
            for (int i = 0; i < 16; ++i) { yd[i] = 0.f; yo[i] = 0.f; }
            for (int sb = 0; sb <= lb2; ++sb) {
                const bf16x8 af0 = *(const LAS bf16x8*)(P + (32 * lb2 + r) * LDP + 32 * sb + 8 * hh), bf0 = *(const LAS bf16x8*)(XDT + r * LDP + 32 * sb + 8 * hh),
                             af1 = *(const LAS bf16x8*)(P + (32 * lb2 + r) * LDP + 32 * sb + 16 + 8 * hh), bf1 = *(const LAS bf16x8*)(XDT + r * LDP + 32 * sb + 16 + 8 * hh);
                yd = MFMA32(af0, bf0, yd); yd = MFMA32(af1, bf1, yd); }
#pragma unroll
            for (int ks = 0; ks < 8; ++ks) { const bf16x8 af = *(const LAS bf16x8*)(Cl + (32 * lb2 + r) * LDP + 16 * ks + 8 * hh), bfv = *(const LAS bf16x8*)(SENT + r * LDP + 16 * ks + 8 * hh); yo = MFMA32(af, bfv, yo); }
#pragma unroll
            for (int g4 = 0; g4 < 4; ++g4) { const f32x4 ea = *(const LAS f32x4*)(eac + 32 * lb2 + 8 * g4 + 4 * hh);
#pragma unroll
                for (int e = 0; e < 4; ++e) { const int i = 4 * g4 + e, l = 32 * lb2 + 8 * g4 + 4 * hh + e;
                    XS[l * 32 + r] = f2bf1(yd[i] + ea[e] * yo[i] + Dh * bf2f(XS[l * 32 + r])); } }
        } else {
            const int nb = wid - 4; const float cd = eac[127];
#pragma unroll
            for (int i = 0; i < 16; ++i) st[i] *= cd;
#pragma unroll
            for (int ks = 0; ks < 8; ++ks) { const bf16x8 af = *(const LAS bf16x8*)(BT + (32 * nb + r) * LDP + 8 * ((2 * ks + hh) ^ ((4 * nb + (r >> 3)) & 15))), bfv = *(const LAS bf16x8*)(XDD + r * LDP + 16 * ks + 8 * hh); st = MFMA32(af, bfv, st); }
            if (wid == 4 && c < 15) SSD_STAGE_D((c + 1) & 1);
        }
        SSD_BAR();
        if (wid >= 4) { const int nb = wid - 4;
#pragma unroll
            for (int gq = 0; gq < 4; ++gq) { v2u p; p.x = pk2(st[4 * gq], st[4 * gq + 1]); p.y = pk2(st[4 * gq + 2], st[4 * gq + 3]); *(LAS v2u*)(SENT + r * LDP + 32 * nb + 8 * gq + 4 * hh) = p; } }
        {
            float yv[8], zf[8]; unpack8(*(const LAS v4u*)(XS + xl * 32 + 8 * xc), yv); unpack8(zraw, zf);
            float sq = 0.f;
#pragma unroll
            for (int j = 0; j < 8; ++j) { yv[j] *= zf[j]; sq += yv[j] * yv[j]; }
            v4u o; o.x = pk2(yv[0], yv[1]); o.y = pk2(yv[2], yv[3]); o.z = pk2(yv[4], yv[5]); o.w = pk2(yv[6], yv[7]);
            *(v4u*)p_z = o;
            sq += __shfl_xor(sq, 16); sq += __shfl_xor(sq, 32);
            if (xc == 0) *p_sq = sq;
        }
        p_bc += 128 * 256; p_x += (size_t)128 * LDPJ; p_z += (size_t)128 * LDPJ; p_dt += 128 * 16; p_sq += 128 * 2 * 16;
    }
#undef SSD_STAGE_D
#undef SSD_BAR
    const int r = tid0 & 31, hh = (tid0 >> 5) & 1;
    if (wid >= 4) { const int nb = wid - 4; float* o = a.out + O_SSMP + ((size_t)(b * 16 + h) * 64 + 32 * ph + r) * 128 + 32 * nb + 4 * hh;
#pragma unroll
        for (int gq = 0; gq < 4; ++gq) *(f32x4*)(o + 8 * gq) = (f32x4){st[4 * gq], st[4 * gq + 1], st[4 * gq + 2], st[4 * gq + 3]}; }
    __syncthreads();
}
constexpr int SMP_SCR = 11264;
__device__ __forceinline__ void ssd_sample(const Args& a, LAS float* scr, int wu, int lane) {
    const int j = wu >> 4, h = wu & 15, g = h >> 3; const size_t row = (size_t)(MP + j);
    bf16* prow = (bf16*)(a.ws + WS_PROJ) + row * LDPJ; const float* dtbuf = (const float*)(a.ws + WS_SMALL + SM_DT); float* ssgp = (float*)(a.ws + WS_SSGP);
    const float* cw = a.in[I_CW]; const float* cb = a.in[I_CB]; const float* cst = a.in[I_SCONV0] + (size_t)j * 3 * CONVD;
    const float A_h = -__expf(a.in[I_ALOG][h]), Dh = a.in[I_DSKIP][h];
    const float dt = softplus(dtbuf[row * 16 + h] + a.in[I_DTB][h]), dA = __expf(dt * A_h);
    LAS float* sx = scr; LAS float* sxs = scr + 64; LAS float* sB = scr + 128; LAS float* sC = scr + 256; LAS float* sp = scr + 384;
#pragma unroll
    for (int t = 0; t < 5; ++t) {
        const int ch = t == 0 ? (h * 64 + lane) : (t < 3 ? (1024 + g * 128 + lane + 64 * (t - 1)) : (1280 + g * 128 + lane + 64 * (t - 3)));
        float v = cb[ch] + cw[0 * CONVD + ch] * cst[0 * CONVD + ch] + cw[1 * CONVD + ch] * cst[1 * CONVD + ch] + cw[2 * CONVD + ch] * cst[2 * CONVD + ch] + cw[3 * CONVD + ch] * bf2f(prow[PC_XBC + ch]);
        v = silu(v);
        if (t == 0) { sx[lane] = v * dt; sxs[lane] = v; } else if (t < 3) sB[lane + 64 * (t - 1)] = v; else sC[lane + 64 * (t - 3)] = v;
    }
    const float zf = bf2f(prow[PC_Z + h * 64 + lane]);
    LDS_WAIT();
    const int rs = lane >> 5, n4 = lane & 31;
    const f32x4 Br = *(const LAS f32x4*)(sB + 4 * n4), Cr = *(const LAS f32x4*)(sC + 4 * n4);
    const f32x4* __restrict__ S0 = (const f32x4*)(a.in[I_SSM] + ((size_t)(j * 16 + h) * 64) * 128) + lane; f32x4* __restrict__ S1 = (f32x4*)(a.out + O_SSMS + ((size_t)(j * 16 + h) * 64) * 128) + lane;
#pragma unroll 1
    for (int it0 = 0; it0 < 32; it0 += 16) {
        f32x4 s4[16];
#pragma unroll
        for (int k = 0; k < 16; ++k) s4[k] = __builtin_nontemporal_load(S0 + 64 * (it0 + k));
#pragma unroll
        for (int k = 0; k < 16; ++k) { const int p = 2 * (it0 + k) + rs; const float xd = sx[p];
            const f32x4 nv = s4[k] * dA + Br * xd; __builtin_nontemporal_store(nv, S1 + 64 * (it0 + k));
            sp[p * 36 + n4] = (nv[0] * Cr[0] + nv[1] * Cr[1]) + (nv[2] * Cr[2] + nv[3] * Cr[3]); }
    }
    LDS_WAIT();
    float y = 0.f;
#pragma unroll
    for (int k = 0; k < 8; ++k) { const f32x4 v = *(const LAS f32x4*)(sp + lane * 36 + 4 * k); y += (v[0] + v[1]) + (v[2] + v[3]); }
    y = (y + Dh * sxs[lane]) * zf;
    prow[PC_Z + h * 64 + lane] = f2bf1(y);
    const float sq = wave_sum(y * y);
    if (lane < 2) ssgp[(row * 2 + g) * 16 + (h & 7) * 2 + lane] = lane == 0 ? sq : 0.f;
    LDS_WAIT();
}

__device__ __forceinline__ void p5_fix(const Args& a, int gw, int NGW, int lane) {
    bf16* proj = (bf16*)(a.ws + WS_PROJ); const float* ssgp = (const float*)(a.ws + WS_SSGP);
    const float* snw = a.in[I_SNW]; const float* scw = a.in[I_SCW];
    for (int u = gw; u < 2048 + 256; u += NGW) {
        const bool smp = u >= 2048; const int uu = smp ? u - 2048 : u, tgp = uu >> 1, kind = 2 + (uu & 1);
        const size_t row0 = smp ? (size_t)(MP + tgp) : (size_t)tgp * 16;
        if (kind < 2) continue;
        if (false) {
            const int ch = 512 * kind + 8 * lane; const f32x4 w0 = *(const f32x4*)(snw + ch), w1 = *(const f32x4*)(snw + ch + 4);
            if (smp) {
                const f32x4* pp = (const f32x4*)(ssgp + (row0 * 2 + kind) * 16); const f32x4 q4 = (pp[0] + pp[1]) + (pp[2] + pp[3]); const float rs = rsqrtf(((q4[0] + q4[1]) + (q4[2] + q4[3])) * (1.f / 512.f) + EPS);
                v4u* p = (v4u*)(proj + row0 * LDPJ + PC_Z + ch); float f[8]; unpack8(*p, f);
                v4u o; o.x = pk2(f[0] * rs * w0[0], f[1] * rs * w0[1]); o.y = pk2(f[2] * rs * w0[2], f[3] * rs * w0[3]); o.z = pk2(f[4] * rs * w1[0], f[5] * rs * w1[1]); o.w = pk2(f[6] * rs * w1[2], f[7] * rs * w1[3]); *p = o;
            } else {
                v4u raw[16]; float qs[16];
#pragma unroll
                for (int t = 0; t < 16; ++t) raw[t] = *(const v4u*)(proj + (row0 + t) * LDPJ + PC_Z + ch);
#pragma unroll
                for (int t = 0; t < 16; ++t) { const f32x4* pp = (const f32x4*)(ssgp + ((row0 + t) * 2 + kind) * 16); const f32x4 q4 = (pp[0] + pp[1]) + (pp[2] + pp[3]); qs[t] = (q4[0] + q4[1]) + (q4[2] + q4[3]); }
#pragma unroll
                for (int t = 0; t < 16; ++t) { const float rs = rsqrtf(qs[t] * (1.f / 512.f) + EPS); float f[8]; unpack8(raw[t], f);
                    v4u o; o.x = pk2(f[0] * rs * w0[0], f[1] * rs * w0[1]); o.y = pk2(f[2] * rs * w0[2], f[3] * rs * w0[3]); o.z = pk2(f[4] * rs * w1[0], f[5] * rs * w1[1]); o.w = pk2(f[6] * rs * w1[2], f[7] * rs * w1[3]);
                    *(v4u*)(proj + (row0 + t) * LDPJ + PC_Z + ch) = o; }
            }
        } else {
            const int ch = 512 * (kind - 2) + 8 * lane; float w[3][8];
#pragma unroll
            for (int k = 0; k < 3; ++k) { const f32x4 a0 = *(const f32x4*)(scw + k * 1024 + ch), a1 = *(const f32x4*)(scw + k * 1024 + ch + 4);
                w[k][0] = a0[0]; w[k][1] = a0[1]; w[k][2] = a0[2]; w[k][3] = a0[3]; w[k][4] = a1[0]; w[k][5] = a1[1]; w[k][6] = a1[2]; w[k][7] = a1[3]; }
            float u2[8], u1[8];
            if (smp) { const float* sp_ = a.in[I_SSCONV] + (size_t)tgp * 2 * 1024 + ch; float cc[8], hv[8], bb[8], uc[8], y[8];
#pragma unroll
                for (int e = 0; e < 8; ++e) { u2[e] = sp_[e]; u1[e] = sp_[1024 + e]; }
                unpack8(*(const v4u*)(proj + row0 * LDPJ + PC_SCC + ch), cc); v4u* pb = (v4u*)(proj + row0 * LDPJ + PC_SCB + ch); unpack8(*pb, bb); (void)hv;
#pragma unroll
                for (int e = 0; e < 8; ++e) { uc[e] = cc[e]; y[e] = bb[e] * (w[0][e] * u2[e] + w[1][e] * u1[e] + w[2][e] * uc[e]); }
                v4u o; o.x = pk2(y[0], y[1]); o.y = pk2(y[2], y[3]); o.z = pk2(y[4], y[5]); o.w = pk2(y[6], y[7]); *pb = o;
                float* d = a.out + O_SCS + (size_t)tgp * 2 * 1024 + ch;
#pragma unroll
                for (int e = 0; e < 8; ++e) { d[e] = u1[e]; d[1024 + e] = uc[e]; }
            } else {
                const int l0 = (tgp & 127) * 16;
                v4u hc[2];
#pragma unroll
                for (int q = 0; q < 2; ++q) { const bool ok = l0 > 0; hc[q] = ok ? *(const v4u*)(proj + (row0 - 2 + q) * LDPJ + PC_SCC + ch) : (v4u){0u, 0u, 0u, 0u}; }
                unpack8(hc[0], u2); unpack8(hc[1], u1);
#pragma unroll
                for (int half = 0; half < 2; ++half) {
                    v4u rc[8], rb[8];
#pragma unroll
                    for (int t = 0; t < 8; ++t) { const size_t row = row0 + 8 * half + t; rc[t] = *(const v4u*)(proj + row * LDPJ + PC_SCC + ch); rb[t] = *(const v4u*)(proj + row * LDPJ + PC_SCB + ch); }
#pragma unroll
                    for (int t = 0; t < 8; ++t) { const size_t row = row0 + 8 * half + t; float bb[8], uc[8], y[8]; unpack8(rc[t], uc); unpack8(rb[t], bb);
#pragma unroll
                        for (int e = 0; e < 8; ++e) { y[e] = bb[e] * (w[0][e] * u2[e] + w[1][e] * u1[e] + w[2][e] * uc[e]); }
                        v4u o; o.x = pk2(y[0], y[1]); o.y = pk2(y[2], y[3]); o.z = pk2(y[4], y[5]); o.w = pk2(y[6], y[7]); *(v4u*)(proj + row * LDPJ + PC_SCB + ch) = o;
                        const int l = l0 + 8 * half + t;
                        if (l >= SEQ - 2) { float* d = a.out + O_SCP + ((size_t)(tgp >> 7) * 2 + (l - (SEQ - 2))) * 1024 + ch;
#pragma unroll
                            for (int e = 0; e < 8; ++e) d[e] = uc[e]; }
#pragma unroll
                        for (int e = 0; e < 8; ++e) { u2[e] = u1[e]; u1[e] = uc[e]; } }
                }
            }
        }
    }
    const int gt = gw * 64 + lane, NT = NGW * 64;
    for (int i4 = gt; i4 < NBATCH * 3 * CONVD / 4; i4 += NT) { const int i = 4 * i4, c = i % CONVD, k = (i / CONVD) % 3, b = i / (3 * CONVD);
        const v2u r2 = *(const v2u*)(proj + (size_t)(b * SEQ + SEQ - 3 + k) * LDPJ + PC_XBC + c);
        *(f32x4*)(a.out + O_CONVP + i) = (f32x4){__uint_as_float(r2.x << 16), __uint_as_float(r2.x & 0xffff0000u), __uint_as_float(r2.y << 16), __uint_as_float(r2.y & 0xffff0000u)}; }
    for (int i4 = gt; i4 < NS * 3 * CONVD / 4; i4 += NT) { const int i = 4 * i4, c = i % CONVD, k = (i / CONVD) % 3, j = i / (3 * CONVD);
        f32x4 o;
        if (k < 2) o = *(const f32x4*)(a.in[I_SCONV0] + (size_t)j * 3 * CONVD + (k + 1) * CONVD + c);
        else { const v2u r2 = *(const v2u*)(proj + (size_t)(MP + j) * LDPJ + PC_XBC + c); o = (f32x4){__uint_as_float(r2.x << 16), __uint_as_float(r2.x & 0xffff0000u), __uint_as_float(r2.y << 16), __uint_as_float(r2.y & 0xffff0000u)}; }
        *(f32x4*)(a.out + O_CONVS + i) = o; }
}

#define XB_TMO      128
#define XB_XCNT(j)  (256  + 64 * (j))
#define XB_XSUB(j)  (1280 + 64 * (j))
#define XB_XGEN(j)  (2304 + 64 * (j))
#define XB_TOP      3328
#define XB_TOPGEN   3392
#define XCD_BAR_WORDS 3456
#define XB_SPIN_CAP (1u << 18)

__device__ __forceinline__ unsigned xb_ld(unsigned* p)              { return __hip_atomic_load(p, __ATOMIC_RELAXED, __HIP_MEMORY_SCOPE_AGENT); }
__device__ __forceinline__ unsigned xb_add(unsigned* p, unsigned v) { return __hip_atomic_fetch_add(p, v, __ATOMIC_RELAXED, __HIP_MEMORY_SCOPE_AGENT); }
__device__ __forceinline__ unsigned xb_xcc_id() { return (unsigned)__builtin_amdgcn_s_getreg((3 << 11) | 20) & 0xFu; }
#define XB_SPIN(cond, bar) do { unsigned _sp = 0; while (cond) { __builtin_amdgcn_s_sleep(1); \
    if ((++_sp & 255u) == 0u) { if (xb_ld(&(bar)[XB_TMO])) break; if (_sp > XB_SPIN_CAP) { atomicAdd(&(bar)[XB_TMO], 1u); break; } } } } while (0)

struct XcdBarrier {
    unsigned* bar; unsigned x;
    volatile LAS unsigned* st;
};

__device__ __forceinline__ XcdBarrier xcd_barrier_post(unsigned* bar, volatile LAS unsigned* st) {
    XcdBarrier b; b.bar = bar; b.x = xb_xcc_id(); b.st = st;
    if (threadIdx.x == 0) (void)xb_add(&bar[XB_XCNT(b.x)], 1u);
    return b;
}
__device__ __forceinline__ void xcd_barrier_complete(unsigned* bar, unsigned x, unsigned& nloc, unsigned& nx) {
    const unsigned G = gridDim.x * gridDim.y * gridDim.z;
    unsigned sum, cnt, mine, sp = 0u;
    for (;;) {
        sum = 0u; cnt = 0u; mine = 0u;
#pragma unroll
        for (unsigned j = 0; j < 16; ++j) { const unsigned c = xb_ld(&bar[XB_XCNT(j)]); sum += c; cnt += (c > 0u) ? 1u : 0u; mine = (j == x) ? c : mine; }
        if (sum == G) break;
        __builtin_amdgcn_s_sleep(1);
        if ((++sp & 255u) == 0u) { if (xb_ld(&bar[XB_TMO])) break; if (sp > XB_SPIN_CAP) { atomicAdd(&bar[XB_TMO], 1u); break; } }
    }
    nloc = mine > 0u ? mine : 1u; nx = cnt > 0u ? cnt : 1u;
}

__device__ __forceinline__ void xcd_barrier(const XcdBarrier& b) {
    asm volatile("s_waitcnt vmcnt(0)" ::: "memory");
    __syncthreads();
    if (threadIdx.x == 0) {
        unsigned* bar = b.bar;
        __builtin_amdgcn_s_waitcnt(0);
        unsigned nloc = b.st[0], nx = b.st[1];
        if (nloc == 0u) { xcd_barrier_complete(bar, b.x, nloc, nx); b.st[0] = nloc; b.st[1] = nx; }
        const unsigned old = xb_add(&bar[XB_XSUB(b.x)], 1u);
        const unsigned gen = old / nloc;
        if (old + 1u == (gen + 1u) * nloc) {
            __builtin_amdgcn_fence(__ATOMIC_RELEASE, "agent");
            asm volatile("s_waitcnt vmcnt(0)" ::: "memory");
            const unsigned og = xb_add(&bar[XB_TOP], 1u);
            const unsigned tg = og / nx;
            if (og + 1u == (tg + 1u) * nx) xb_add(&bar[XB_TOPGEN], 1u);
            else XB_SPIN(xb_ld(&bar[XB_TOPGEN]) == tg, bar);
            __builtin_amdgcn_fence(__ATOMIC_ACQUIRE, "agent");
            xb_add(&bar[XB_XGEN(b.x)], 1u);
            asm volatile("s_waitcnt vmcnt(0)" ::: "memory");
        } else {
            XB_SPIN(xb_ld(&bar[XB_XGEN(b.x)]) == gen, bar);
            __builtin_amdgcn_fence(__ATOMIC_ACQUIRE, "agent");
            asm volatile("s_waitcnt vmcnt(0)" ::: "memory");
        }
    }
    __syncthreads();
}

__global__ void __launch_bounds__(NTHR, 2) hymba_fwd(Args a) {
    extern __shared__ __attribute__((aligned(16))) unsigned char lds_raw[];
    cg::grid_group grid = cg::this_grid();
    LAS unsigned char* lds = (LAS unsigned char*)lds_raw;
    const int tid = threadIdx.x, lane = tid & 63, wave = __builtin_amdgcn_readfirstlane(tid >> 6);
    const int G = gridDim.x, gw = blockIdx.x * NWAVES + wave, NGW = G * NWAVES;
    unsigned char* ws = a.ws;
    bf16* XW = (bf16*)(ws + WS_XW); bf16* H = (bf16*)(ws + WS_H); bf16* PROJ = (bf16*)(ws + WS_PROJ);
    float* ss2 = (float*)(ws + WS_SMALL + SM_SS2); float* ss3 = (float*)(ws + WS_SMALL + SM_SS3); float* dtbuf = (float*)(ws + WS_SMALL + SM_DT);
    float* xres = a.out + O_Y;
    volatile LAS unsigned* MISC = (volatile LAS unsigned*)(lds + LDS_BYTES - 64);
    if (tid < 16) MISC[tid] = 0u;
    __syncthreads();
    XcdBarrier bar = xcd_barrier_post((unsigned*)(ws + WS_BAR), MISC);
    const int lo = a.ph_lo, hi = a.ph_hi;
#ifndef PH_MASK
#define PH_MASK 0x7ff
#endif
#define IN(k) (((PH_MASK >> (k)) & 1) && lo <= (k) && (k) < hi)
#define SEAM(k) do { if (IN(k) && IN((k) + 1)) xcd_barrier(bar); } while (0)
    if (a.ph_hi > 1000) grid.sync();
    if (IN(0)) p0_prologue(a, lds, gw, NGW, wave, lane);
    SEAM(0);
    if (IN(1)) {
        pg8::Gemm g{XW, (const bf16*)(ws + WS_W1GU), MPAD, NGU, DM, DM}; pg8::StaticOrder S; S.init(MPAD, NGU, G, (int)blockIdx.x);
        pg8::EpiSwiGLU<false> E{H, DFF, nullptr};
        pg8::gemm_phase<pg8::EpiSwiGLU<false>, pg8::StaticOrder, true, true>(lds, g, S, E);
    }
    SEAM(1);
    if (IN(2)) {
        pg8::Gemm g{H, (const bf16*)(ws + WS_W1D), MP, DM, DFF, DFF}; pg8::StaticOrder S; S.init(MP, DM, G, (int)blockIdx.x);
        pg8::EpiRes E{a.in[I_XP], nullptr, 0.5f, XW, a.in[I_NMW], ss2, nullptr, nullptr, nullptr};
        pg8::gemm_phase<pg8::EpiRes, pg8::StaticOrder, true, true>(lds, g, S, E);
        if (!(a.flags & 4)) small_gemm(lds, H + (size_t)MP * DFF, DFF, (const bf16*)(ws + WS_W1D), DFF, a.in[I_XS], nullptr, 0.5f, XW + (size_t)MP * DM, a.in[I_NMW], ss2 + MP);
    }
    SEAM(2);
    if (IN(3)) {
        pg8::Gemm g{XW, (const bf16*)(ws + WS_WIN), MPAD, NINP, DM, DM}; pg8::StaticOrder S; S.init(MPAD, NINP, G, (int)blockIdx.x);
        pg8::EpiProj E{PROJ, LDPJ, ss2, dtbuf, LDPJ / 256, a.flags & 8, PC_SCC / 256};
        pg8::gemm_phase<pg8::EpiProj, pg8::StaticOrder, true, true>(lds, g, S, E);
    }
    SEAM(3);
    if (IN(4)) { bc_conv_prepass(a, gw, NGW, lane); p5_fix(a, gw, NGW, lane); p0_late_weights(a, lds, gw, NGW, wave, lane); }
    SEAM(4);
    if (IN(5)) {
        if (!(a.flags & 2)) for (int u = blockIdx.x; u < NBATCH * 32; u += G) ssd_prompt(a, lds, (G == NBATCH * 32) ? ((u & 7) * 32 + (u >> 3)) : u);
        if (!(a.flags & 1)) for (int wu = gw; wu < NS * 16; wu += NGW) ssd_sample(a, (LAS float*)(lds + wave * SMP_SCR), wu, lane);
    }
    do { if (IN(5) && IN(7)) xcd_barrier(bar); } while (0);
    if (IN(7)) {
        pg8::Gemm g{PROJ, (const bf16*)(ws + WS_WOUT), MP, DM, DMIX, LDPJ}; pg8::StaticOrder S; S.init(MP, DM, G, (int)blockIdx.x);
        pg8::EpiResT<true> E{nullptr, nullptr, 1.0f, XW, a.in[I_N2W], ss3, (const float*)(ws + WS_SSGP), XW, a.in[I_NMW]};
        pg8::gemm_phase<pg8::EpiResT<true>, pg8::StaticOrder, true, true>(lds, g, S, E);
        if (!(a.flags & 4)) small_gemm(lds, PROJ + (size_t)MP * LDPJ, LDPJ, (const bf16*)(ws + WS_WOUT), DMIX, nullptr, nullptr, 1.0f, XW + (size_t)MP * DM, a.in[I_N2W], ss3 + MP, (const float*)(ws + WS_SSGP) + (size_t)MP * 2 * 16, XW + (size_t)MP * DM, a.in[I_NMW]);
    }
    SEAM(7);
    if (IN(8)) {
        pg8::Gemm g{XW, (const bf16*)(ws + WS_W2GU), MPAD, NGU, DM, DM}; pg8::StaticOrder S; S.init(MPAD, NGU, G, (int)blockIdx.x);
        pg8::EpiSwiGLU<true> E{H, DFF, ss3};
        pg8::gemm_phase<pg8::EpiSwiGLU<true>, pg8::StaticOrder, true, true>(lds, g, S, E);
    }
    SEAM(8);
    if (IN(9)) {
        pg8::Gemm g{H, (const bf16*)(ws + WS_W2D), MP, DM, DFF, DFF}; pg8::StaticOrder S; S.init(MP, DM, G, (int)blockIdx.x);
        pg8::EpiRes E{nullptr, nullptr, 0.5f, XW, nullptr, nullptr, nullptr, XW, a.in[I_N2W]};
        pg8::gemm_phase<pg8::EpiRes, pg8::StaticOrder, true, true>(lds, g, S, E);
        if (!(a.flags & 4)) small_gemm(lds, H + (size_t)MP * DFF, DFF, (const bf16*)(ws + WS_W2D), DFF, nullptr, nullptr, 0.5f, XW + (size_t)MP * DM, nullptr, nullptr, nullptr, XW + (size_t)MP * DM, a.in[I_N2W]);
    }
    SEAM(9);
    if (IN(10)) {
        const f32x4* wr = (const f32x4*)a.in[I_FNW] + lane;
        f32x4 w4[4];
#pragma unroll
        for (int j = 0; j < 4; ++j) w4[j] = wr[64 * j];
        for (int m = gw; m < MT; m += 2 * NGW) { const int m2 = m + NGW; const bool two = m2 < MT;
            const unsigned long long* xb = (const unsigned long long*)(XW + (size_t)m * DM) + lane; const unsigned long long* xb2 = (const unsigned long long*)(XW + (size_t)(two ? m2 : m) * DM) + lane;
            f32x4* xr = (f32x4*)(xres + (size_t)m * DM) + lane; f32x4* xr2 = (f32x4*)(xres + (size_t)(two ? m2 : m) * DM) + lane; unsigned long long r[4], r2[4]; f32x4 v[4], v2[4]; float s = 0.f, s2 = 0.f;
#pragma unroll
            for (int j = 0; j < 4; ++j) { r[j] = xb[64 * j]; r2[j] = xb2[64 * j]; }
#pragma unroll
            for (int j = 0; j < 4; ++j) { const unsigned lo = (unsigned)r[j], hi = (unsigned)(r[j] >> 32), lo2 = (unsigned)r2[j], hi2 = (unsigned)(r2[j] >> 32);
                v[j] = (f32x4){__uint_as_float(lo << 16), __uint_as_float(lo & 0xffff0000u), __uint_as_float(hi << 16), __uint_as_float(hi & 0xffff0000u)};
                v2[j] = (f32x4){__uint_as_float(lo2 << 16), __uint_as_float(lo2 & 0xffff0000u), __uint_as_float(hi2 << 16), __uint_as_float(hi2 & 0xffff0000u)}; }
#pragma unroll
            for (int j = 0; j < 4; ++j) { s += (v[j].x * v[j].x + v[j].y * v[j].y) + (v[j].z * v[j].z + v[j].w * v[j].w); s2 += (v2[j].x * v2[j].x + v2[j].y * v2[j].y) + (v2[j].z * v2[j].z + v2[j].w * v2[j].w); }
            const float rstd = rsqrtf(wave_sum(s) * (1.f / DM) + EPS), rstd2 = rsqrtf(wave_sum(s2) * (1.f / DM) + EPS);
#pragma unroll
            for (int j = 0; j < 4; ++j) xr[64 * j] = v[j] * rstd * w4[j];
            if (two) {
#pragma unroll
                for (int j = 0; j < 4; ++j) xr2[64 * j] = v2[j] * rstd2 * w4[j]; } }
    }
#ifdef EXTRA_SYNCS
    for (int i = 0; i < EXTRA_SYNCS; ++i) grid.sync();
#endif
#undef IN
#undef SEAM
}

extern "C" void kernel_launch(void* const* d_in, const int* in_sizes, int n_in, void* d_out, int out_size, void* d_ws, size_t ws_size, hipStream_t stream) {
    static int grid = 0;
    if (grid == 0) {
        if (n_in != 24 || (size_t)out_size != O_END || ws_size < WS_END3) { fprintf(stderr, "kernel_launch: unexpected sizes: n_in %d out %d (want %zu) ws %zu (need %zu)\n", n_in, out_size, (size_t)O_END, ws_size, (size_t)WS_END3); grid = -1; return; }
        int dev = 0, cus = 0, per_cu = 0;
        hipGetDevice(&dev); hipDeviceGetAttribute(&cus, hipDeviceAttributeMultiprocessorCount, dev);
        if (hipFuncSetAttribute((const void*)hymba_fwd, hipFuncAttributeMaxDynamicSharedMemorySize, LDS_BYTES) != hipSuccess) { fprintf(stderr, "kernel_launch: hipFuncSetAttribute failed\n"); grid = -1; return; }
        if (hipOccupancyMaxActiveBlocksPerMultiprocessor(&per_cu, (const void*)hymba_fwd, NTHR, LDS_BYTES) != hipSuccess || per_cu < 1) { fprintf(stderr, "kernel_launch: occupancy query says %d blocks per CU\n", per_cu); grid = -1; (void)hipGetLastError(); return; }
        grid = cus * per_cu;
    }
    if (grid < 0) return;
    if (hipMemsetAsync((unsigned char*)d_ws + WS_BAR, 0, 16384, stream) != hipSuccess) { fprintf(stderr, "kernel_launch: memset of the barrier words failed\n"); return; }
    Args a{};
    for (int i = 0; i < 24; ++i) a.in[i] = (const float*)d_in[i];
    a.out = (float*)d_out; a.ws = (unsigned char*)d_ws; a.ph_lo = 0; a.ph_hi = 11;
    void* args[] = {&a};
#ifndef PRE_PASS
#define PRE_PASS 0
#endif
#ifndef PRE_FLAGS
#define PRE_FLAGS 0
#endif
    if (PRE_PASS > 0) {
        a.ph_hi = PRE_PASS; a.flags = PRE_FLAGS; (void)hipLaunchCooperativeKernel((const void*)hymba_fwd, dim3(grid), dim3(NTHR), args, LDS_BYTES, stream); a.ph_hi = 11; a.flags = 0; (void)hipMemsetAsync((unsigned char*)d_ws + WS_BAR, 0, 16384, stream); }
    hipError_t e = hipLaunchCooperativeKernel((const void*)hymba_fwd, dim3(grid), dim3(NTHR), args, LDS_BYTES, stream);
    if (e != hipSuccess) fprintf(stderr, "kernel_launch: cooperative launch failed: %s (grid %d)\n", hipGetErrorString(e), grid);
}
```

```cpp
#include <hip/hip_runtime.h>
#include <hip/hip_cooperative_groups.h>
#include <cstdio>
#include <cstdint>
namespace cg = cooperative_groups;
namespace pg8 {
#define PG8_LAS __attribute__((address_space(3)))
typedef unsigned short bf16_t;
typedef short bf16x8 __attribute__((ext_vector_type(8)));
typedef float f32x4 __attribute__((ext_vector_type(4)));
typedef unsigned u32x4 __attribute__((ext_vector_type(4)));
constexpr int BM = 256, BK = 64, HALF = 128, HTB = HALF * BK * 2  , STAGE_BYTES = 8 * HTB, NXCD = 8, WGM = 8;

__host__ __device__ __forceinline__ int lds_byte(int r, int c) { const int st = (r >> 4) * 2 + (c >> 5), rr = r & 15, cc = c & 31, ob = rr * 64 + cc * 2; return st * 1024 + (ob ^ (((ob >> 9) & 1) << 5)); }
__host__ __device__ __forceinline__ void stage_rc(int b, int& R, int& C) { const int st = b / 1024, sb = b % 1024, swz = sb ^ (((sb >> 9) & 1) << 5); R = (st >> 1) * 16 + swz / 64; C = (st & 1) * 32 + (swz % 64) / 2; }
__host__ __device__ __forceinline__ int perm32(int rho) { const int n = rho >> 4, i = rho & 15; return 8 * (i >> 2) + 4 * n + (i & 3); }

struct Unit { int pm, pn; };
struct Gemm { const bf16_t* A; const bf16_t* Bt; int M, N, K, lda; };

struct StaticOrder {
    int nM, nN, nwg, G, c;
    __host__ __device__ void init(int M, int N, int G_, int c_) { nM = M / BM; nN = N / BM; nwg = nM * nN; G = G_; c = c_; }
    __host__ __device__ bool next(int i, Unit& u) const {
        const long L = (long)i * G + c; if (L >= nwg) return false;
        int wgid = (int)L; { const int q = nwg / NXCD, r = nwg % NXCD, xcd = wgid % NXCD, off = wgid / NXCD; wgid = (xcd < r ? xcd * (q + 1) : r * (q + 1) + (xcd - r) * q) + off; }
        const int nig = WGM * nN, gid = wgid / nig, fm = gid * WGM, gsz = (nM - fm) < WGM ? (nM - fm) : WGM;
        u.pm = fm + ((wgid % nig) % gsz); u.pn = (wgid % nig) / gsz; return true;
    }
    __device__ __forceinline__ void a_ready(const Unit&) const {}
    __device__ __forceinline__ void done(const Unit&) const {}
};


__device__ __forceinline__ unsigned cvt_pk_bf16(float lo, float hi) { unsigned r; asm volatile("v_cvt_pk_bf16_f32 %0, %1, %2" : "=v"(r) : "v"(lo), "v"(hi)); return r; }
__device__ __forceinline__ float silu_f(float v) { return v * __builtin_amdgcn_rcpf(1.0f + __expf(-v)); }
typedef unsigned u32x2 __attribute__((ext_vector_type(2)));

typedef float f32x2 __attribute__((ext_vector_type(2)));
__device__ __forceinline__ f32x2 swiglu_pk(f32x2 g, f32x2 u) {
    const f32x2 t = g * (-1.44269504f); f32x2 e; e.x = __builtin_amdgcn_exp2f(t.x); e.y = __builtin_amdgcn_exp2f(t.y);
    const f32x2 d = e + 1.0f; f32x2 r; r.x = __builtin_amdgcn_rcpf(d.x); r.y = __builtin_amdgcn_rcpf(d.y);
    return (g * u) * r;
}
template <bool SCALE> struct EpiSwiGLU {
    static constexpr bool PERM = true, AFTER_DRAIN = false, KSCALE = false;
    bf16_t* H; int ldh; const float* ss;
    __device__ __forceinline__ void prefetch(const Unit& u, int wr, int fr, float (&rsv)[8]) const {
        const int row0 = u.pm * BM + wr * 64 + fr;
#pragma unroll
        for (int q = 0; q < 8; ++q) rsv[q] = SCALE ? ss[row0 + (q >> 2) * HALF + (q & 3) * 16] : 0.f;
    }
    __device__ __forceinline__ void operator()(const f32x4 (&acc)[2][2][4][2], const Unit& u, int wr, int wc, int fr, int fq, const float (&rsv)[8]) const {
        const int row0 = u.pm * BM + wr * 64 + fr, col0 = u.pn * HALF + wc * 32 + 8 * fq;
#pragma unroll
        for (int ai = 0; ai < 2; ++ai)
#pragma unroll
            for (int m = 0; m < 4; ++m) {
                const int row = row0 + ai * HALF + m * 16;
                f32x4 g0 = acc[ai][0][m][0], g1 = acc[ai][0][m][1], u0 = acc[ai][1][m][0], u1 = acc[ai][1][m][1];
                if (SCALE) { const float rs = rsqrtf(rsv[ai * 4 + m] * (1.0f / 1024.0f) + 1e-6f); g0 = g0 * rs; g1 = g1 * rs; u0 = u0 * rs; u1 = u1 * rs; }
                const f32x2 h0 = swiglu_pk((f32x2){g0[0], g0[1]}, (f32x2){u0[0], u0[1]}), h1 = swiglu_pk((f32x2){g0[2], g0[3]}, (f32x2){u0[2], u0[3]}),
                            h2 = swiglu_pk((f32x2){g1[0], g1[1]}, (f32x2){u1[0], u1[1]}), h3 = swiglu_pk((f32x2){g1[2], g1[3]}, (f32x2){u1[2], u1[3]});
                u32x4 w; w.x = cvt_pk_bf16(h0.x, h0.y); w.y = cvt_pk_bf16(h1.x, h1.y); w.z = cvt_pk_bf16(h2.x, h2.y); w.w = cvt_pk_bf16(h3.x, h3.y);
                *(u32x4*)(H + (size_t)row * ldh + col0) = w;
            }
    }
};
struct EpiProj {
    static constexpr bool PERM = true, AFTER_DRAIN = false, KSCALE = false;
    bf16_t* P; int ldp; const float* ss; float* dtb; int npn; int skip; int pn_u0;
    __device__ __forceinline__ void prefetch(const Unit& u, int wr, int fr, float (&rsv)[8]) const {
        const int row0 = u.pm * BM + wr * 64 + fr;
#pragma unroll
        for (int q = 0; q < 8; ++q) rsv[q] = ss[row0 + (q >> 2) * HALF + (q & 3) * 16];
    }
    __device__ __forceinline__ void operator()(const f32x4 (&acc)[2][2][4][2], const Unit& u, int wr, int wc, int fr, int fq, const float (&rsv)[8]) const {
        if (skip) return;
        const int row0 = u.pm * BM + wr * 64 + fr, col0 = u.pn * BM + wc * 32 + 8 * fq;
#pragma unroll
        for (int ai = 0; ai < 2; ++ai)
#pragma unroll
            for (int m = 0; m < 4; ++m) {
                const int row = row0 + ai * HALF + m * 16;
                const float rs = rsqrtf(rsv[ai * 4 + m] * (1.0f / 1024.0f) + 1e-6f);
                if (u.pn >= pn_u0 && u.pn < npn) {
                    const f32x4 c0 = acc[ai][0][m][0] * rs, c1 = acc[ai][0][m][1] * rs, h0 = acc[ai][1][m][0] * rs, h1 = acc[ai][1][m][1] * rs; u32x4 w;
                    w.x = cvt_pk_bf16(c0[0] * h0[0], c0[1] * h0[1]); w.y = cvt_pk_bf16(c0[2] * h0[2], c0[3] * h0[3]); w.z = cvt_pk_bf16(c1[0] * h1[0], c1[1] * h1[1]); w.w = cvt_pk_bf16(c1[2] * h1[2], c1[3] * h1[3]);
                    *(u32x4*)(P + (size_t)row * ldp + pn_u0 * BM + (u.pn - pn_u0) * HALF + wc * 32 + 8 * fq) = w;
                } else if (u.pn < npn) {
#pragma unroll
                    for (int bj = 0; bj < 2; ++bj) { f32x4 v0 = acc[ai][bj][m][0] * rs, v1 = acc[ai][bj][m][1] * rs; u32x4 w;
                        if (u.pn < 4) {
#pragma unroll
                            for (int e = 0; e < 4; ++e) { v0[e] = silu_f(v0[e]); v1[e] = silu_f(v1[e]); } }
                        w.x = cvt_pk_bf16(v0[0], v0[1]); w.y = cvt_pk_bf16(v0[2], v0[3]); w.z = cvt_pk_bf16(v1[0], v1[1]); w.w = cvt_pk_bf16(v1[2], v1[3]);
                        *(u32x4*)(P + (size_t)row * ldp + col0 + bj * HALF) = w; }
                } else if (wc == 0 && fq < 2) {
                    *(f32x4*)(dtb + (size_t)row * 16 + 8 * fq) = acc[ai][0][m][0] * rs; *(f32x4*)(dtb + (size_t)row * 16 + 8 * fq + 4) = acc[ai][0][m][1] * rs;
                }
            }
    }
};
template <bool KS> struct EpiResT {
    static constexpr bool PERM = false, AFTER_DRAIN = false, KSCALE = KS;
    const float* base; float* out; float scale; bf16_t* xw; const float* wn; float* ss; const float* ssgp; const bf16_t* bbase; const float* bw;
    __device__ __forceinline__ void unit_begin(const Unit& u, PG8_LAS unsigned char* lds) const {
        PG8_LAS float* R = (PG8_LAS float*)(lds + STAGE_BYTES); const int t = threadIdx.x, row = t >> 1, g = t & 1;
        const f32x4* pp = (const f32x4*)(ssgp + ((size_t)(u.pm * BM + row) * 2 + g) * 16); const f32x4 q4 = (pp[0] + pp[1]) + (pp[2] + pp[3]);
        R[row * 2 + g] = rsqrtf(((q4[0] + q4[1]) + (q4[2] + q4[3])) * (1.0f / 512.0f) + 1e-6f);
    }
    __device__ __forceinline__ void kscale(int t, f32x4 (&acc)[2][2][4][2], int wr, int fr, PG8_LAS unsigned char* lds) const {
        const PG8_LAS float* R = (const PG8_LAS float*)(lds + STAGE_BYTES);
#pragma unroll
        for (int ai = 0; ai < 2; ++ai)
#pragma unroll
            for (int m = 0; m < 4; ++m) { const int r = ai * HALF + wr * 64 + m * 16 + fr; const float r0 = R[r * 2], r1 = R[r * 2 + 1]; const float f = (t == 8) ? r0 * __builtin_amdgcn_rcpf(r1) : r1;
#pragma unroll
                for (int bj = 0; bj < 2; ++bj)
#pragma unroll
                    for (int n = 0; n < 2; ++n) acc[ai][bj][m][n] = acc[ai][bj][m][n] * f; }
    }
    __device__ __forceinline__ void prefetch(const Unit&, int, int, float (&rsv)[8]) const {
#pragma unroll
        for (int q = 0; q < 8; ++q) rsv[q] = 0.f;
    }
    __device__ __forceinline__ void operator()(const f32x4 (&acc)[2][2][4][2], const Unit& u, int wr, int wc, int fr, int fq, const float (&)[8]) const {
        const int row0 = u.pm * BM + wr * 64 + fr, col0 = u.pn * BM + wc * 32 + 4 * fq;
        f32x4 w4[2][2];
#pragma unroll
        for (int bj = 0; bj < 2; ++bj)
#pragma unroll
            for (int n = 0; n < 2; ++n) w4[bj][n] = (xw && wn) ? *(const f32x4*)(wn + col0 + bj * HALF + n * 16) : (f32x4){1.f, 1.f, 1.f, 1.f};
        f32x4 winv[2][2];
#pragma unroll
        for (int bj = 0; bj < 2; ++bj)
#pragma unroll
            for (int n = 0; n < 2; ++n) { f32x4 t_ = {1.f, 1.f, 1.f, 1.f}; if (bbase) { const f32x4 q_ = *(const f32x4*)(bw + col0 + bj * HALF + n * 16); t_ = (f32x4){1.f / q_[0], 1.f / q_[1], 1.f / q_[2], 1.f / q_[3]}; } winv[bj][n] = t_; }
#pragma unroll
        for (int ai = 0; ai < 2; ++ai)
#pragma unroll
        for (int mh = 0; mh < 2; ++mh) {
            f32x4 bv[2][2][2];
#pragma unroll
            for (int mm = 0; mm < 2; ++mm)
#pragma unroll
                for (int bj = 0; bj < 2; ++bj)
#pragma unroll
                    for (int n = 0; n < 2; ++n) { const size_t o_ = (size_t)(row0 + ai * HALF + (2 * mh + mm) * 16) * 1024 + col0 + bj * HALF + n * 16;
                        if (bbase) { const u32x2 r_ = *(const u32x2*)(bbase + o_); bv[mm][bj][n] = (f32x4){__uint_as_float(r_.x << 16), __uint_as_float(r_.x & 0xffff0000u), __uint_as_float(r_.y << 16), __uint_as_float(r_.y & 0xffff0000u)} * winv[bj][n]; }
                        else bv[mm][bj][n] = *(const f32x4*)(base + o_); }
#pragma unroll
            for (int mm = 0; mm < 2; ++mm) {
                const int m = 2 * mh + mm, row = row0 + ai * HALF + m * 16; float s = 0.f;
#pragma unroll
                for (int bj = 0; bj < 2; ++bj)
#pragma unroll
                    for (int n = 0; n < 2; ++n) { const int col = col0 + bj * HALF + n * 16; const size_t off = (size_t)row * 1024 + col;
                        const f32x4 v = bv[mm][bj][n] + acc[ai][bj][m][n] * scale; if (out) *(f32x4*)(out + off) = v;
                        s += (v[0] * v[0] + v[1] * v[1]) + (v[2] * v[2] + v[3] * v[3]);
                        if (xw) { const f32x4 ww = w4[bj][n]; u32x2 p; p.x = cvt_pk_bf16(v[0] * ww[0], v[1] * ww[1]); p.y = cvt_pk_bf16(v[2] * ww[2], v[3] * ww[3]); *(u32x2*)(xw + off) = p; } }
                if (ss) { s += __shfl_xor(s, 16); s += __shfl_xor(s, 32); if (fq == 0) atomicAdd(ss + row, s); }
            }
        }
    }
};
typedef EpiResT<false> EpiRes;

template <class Epi, class Sched, bool ALIGN_EPI = false, bool SP2 = false>
__device__ __forceinline__ void gemm_phase(PG8_LAS unsigned char* lds, const Gemm g, const Sched& S, const Epi& E) {
    const int tid = threadIdx.x, wid = __builtin_amdgcn_readfirstlane(tid >> 6), lane = tid & 63, wr = wid >> 2, wc = wid & 3, fr = lane & 15, fq = lane >> 4;
    const int K = g.K, nt = K / BK;
    unsigned voffA[2], voffB[2];
#pragma unroll
    for (int i = 0; i < 2; ++i) { int R, C; stage_rc(tid * 16 + i * 8192, R, C); const int Rb = Epi::PERM ? ((R & ~31) + perm32(R & 31)) : R;
        voffA[i] = (unsigned)(R * g.lda + C) * 2u; voffB[i] = (unsigned)(Rb * K + C) * 2u; }
    const size_t kstep = (size_t)(BK * 2);
    const size_t hstepA = (size_t)HALF * g.lda * 2, hstepB = (size_t)HALF * K * 2;
    const size_t tstepA = 2 * hstepA, tstepB = 2 * hstepB;
    const unsigned ldsw = (unsigned)wid * 1024u;
    const int aoff = lds_byte(wr * 64 + fr, fq * 8), boff = lds_byte(wc * 32 + fr, fq * 8);
#define PG8_SA(b, h) (((b) * 2 + (h)) * HTB)
#define PG8_SB(b, h) ((4 + (b) * 2 + (h)) * HTB)
#define PG8_STAGE(bufoff, gbase, voff) do { _Pragma("unroll") for (int _i = 0; _i < 2; ++_i) \
        __builtin_amdgcn_global_load_lds((const unsigned*)((const char*)(gbase) + (voff)[_i]), (PG8_LAS unsigned*)(lds + (bufoff) + ldsw + _i * 8192), 16, 0, 0); } while (0)
#define PG8_LDA(dst, b, h) do { _Pragma("unroll") for (int m = 0; m < 4; ++m) _Pragma("unroll") for (int k = 0; k < 2; ++k) dst[m][k] = *(const PG8_LAS bf16x8*)(lds + PG8_SA(b, h) + aoff + m * 2048 + k * 1024); } while (0)
#define PG8_LDB(dst, b, h) do { _Pragma("unroll") for (int n = 0; n < 2; ++n) _Pragma("unroll") for (int k = 0; k < 2; ++k) dst[n][k] = *(const PG8_LAS bf16x8*)(lds + PG8_SB(b, h) + boff + n * 2048 + k * 1024); } while (0)
#define PG8_MMA(ai, bj, At, Bt) do { __builtin_amdgcn_s_setprio(1); _Pragma("unroll") for (int m = 0; m < 4; ++m) _Pragma("unroll") for (int n = 0; n < 2; ++n) _Pragma("unroll") for (int k = 0; k < 2; ++k) \
        acc[ai][bj][m][n] = __builtin_amdgcn_mfma_f32_16x16x32_bf16(Bt[n][k], At[m][k], acc[ai][bj][m][n], 0, 0, 0); __builtin_amdgcn_s_setprio(0); } while (0)
#define PG8_WAIT_V(n) asm volatile("s_waitcnt vmcnt(" #n ")" ::: "memory")
#define PG8_WAIT_L(n) asm volatile("s_waitcnt lgkmcnt(" #n ")" ::: "memory")
#define PG8_BAR __builtin_amdgcn_s_barrier()
#define PG8_SCHED __builtin_amdgcn_sched_barrier(0)
    Unit cur, nxt; int ui = 0;
    if (!S.next(0, cur)) return;
    f32x4 acc[2][2][4][2];
#pragma unroll
    for (int a = 0; a < 2; ++a)
#pragma unroll
        for (int b = 0; b < 2; ++b)
#pragma unroll
            for (int m = 0; m < 4; ++m)
#pragma unroll
                for (int n = 0; n < 2; ++n) acc[a][b][m][n] = (f32x4){0.f, 0.f, 0.f, 0.f};
    bf16x8 At[4][2], B0[2][2], B1[2][2];
    const char* cA = (const char*)g.A + (size_t)cur.pm * tstepA; const char* cB = (const char*)g.Bt + (size_t)cur.pn * tstepB;
    S.a_ready(cur);
    if constexpr (SP2) {
        PG8_STAGE(PG8_SB(0, 0), cB, voffB); PG8_STAGE(PG8_SB(0, 1), cB + hstepB, voffB); PG8_STAGE(PG8_SA(0, 0), cA, voffA); PG8_STAGE(PG8_SA(0, 1), cA + hstepA, voffA);
        if (wr == 1) PG8_BAR;
        PG8_WAIT_V(2); PG8_BAR;
        PG8_STAGE(PG8_SB(1, 0), cB + kstep, voffB); PG8_STAGE(PG8_SA(1, 0), cA + kstep, voffA); PG8_STAGE(PG8_SB(1, 1), cB + hstepB + kstep, voffB);
        PG8_WAIT_V(6); PG8_BAR;
    } else {
        PG8_STAGE(PG8_SB(0, 0), cB, voffB); PG8_STAGE(PG8_SA(0, 0), cA, voffA); PG8_STAGE(PG8_SB(0, 1), cB + hstepB, voffB); PG8_STAGE(PG8_SA(0, 1), cA + hstepA, voffA);
        if (wr == 1) PG8_BAR;
        PG8_WAIT_V(4); PG8_BAR;
        PG8_STAGE(PG8_SB(1, 0), cB + kstep, voffB); PG8_STAGE(PG8_SA(1, 0), cA + kstep, voffA); PG8_STAGE(PG8_SB(1, 1), cB + hstepB + kstep, voffB);
        PG8_WAIT_V(6); PG8_BAR;
    }
    for (;;) {
        const bool has_next = S.next(ui + 1, nxt);
        const char* nA = has_next ? (const char*)g.A + (size_t)nxt.pm * tstepA : cA; const char* nB = has_next ? (const char*)g.Bt + (size_t)nxt.pn * tstepB : cB;
        float rsv[8]; E.prefetch(cur, wr, fr, rsv);
        if constexpr (Epi::KSCALE) E.unit_begin(cur, lds);
        for (int t = 0; t < nt; t += 2) {
            if constexpr (Epi::KSCALE) { if (t == 8 || t == 16) E.kscale(t, acc, wr, fr, lds); }
            const bool last = (t == nt - 2);
            const char* a1 = cA + (size_t)(t + 1) * kstep;
            const char* a2 = last ? nA : cA + (size_t)(t + 2) * kstep; const char* b2 = last ? nB : cB + (size_t)(t + 2) * kstep;
            const char* a3 = a2 + kstep; const char* b3 = b2 + kstep;
            if (last && has_next) S.a_ready(nxt);
            if constexpr (SP2) {
            PG8_LDB(B0, 0, 0); PG8_LDB(B1, 0, 1); PG8_SCHED; PG8_LDA(At, 0, 0); PG8_STAGE(PG8_SA(1, 1), a1 + hstepA, voffA);
            PG8_WAIT_V(8); PG8_WAIT_L(0); PG8_BAR; PG8_MMA(0, 0, At, B0); PG8_MMA(0, 1, At, B1); PG8_BAR; PG8_SCHED;
            PG8_LDA(At, 0, 1); PG8_STAGE(PG8_SB(0, 0), b2, voffB); PG8_STAGE(PG8_SB(0, 1), b2 + hstepB, voffB); PG8_STAGE(PG8_SA(0, 0), a2, voffA);
            PG8_WAIT_V(8); PG8_WAIT_L(0); PG8_BAR; PG8_MMA(1, 0, At, B0); PG8_MMA(1, 1, At, B1); PG8_BAR; PG8_SCHED;
            PG8_LDB(B0, 1, 0); PG8_LDB(B1, 1, 1); PG8_SCHED; PG8_LDA(At, 1, 0); PG8_STAGE(PG8_SA(0, 1), a2 + hstepA, voffA);
            PG8_WAIT_V(8); PG8_WAIT_L(0); PG8_BAR; PG8_MMA(0, 0, At, B0); PG8_MMA(0, 1, At, B1); PG8_BAR; PG8_SCHED;
            PG8_LDA(At, 1, 1); PG8_STAGE(PG8_SB(1, 0), b3, voffB); PG8_STAGE(PG8_SB(1, 1), b3 + hstepB, voffB); PG8_STAGE(PG8_SA(1, 0), a3, voffA);
            PG8_WAIT_V(8); PG8_WAIT_L(0); PG8_BAR; PG8_MMA(1, 0, At, B0); PG8_MMA(1, 1, At, B1); PG8_BAR; PG8_SCHED;
            } else {
            PG8_LDB(B0, 0, 0); PG8_SCHED; PG8_LDA(At, 0, 0); PG8_STAGE(PG8_SA(1, 1), a1 + hstepA, voffA);
            PG8_WAIT_L(8); PG8_BAR; PG8_WAIT_L(0); PG8_MMA(0, 0, At, B0); PG8_BAR; PG8_SCHED;
            PG8_LDB(B1, 0, 1); PG8_STAGE(PG8_SB(0, 0), b2, voffB);
            PG8_BAR; PG8_WAIT_L(0); PG8_MMA(0, 1, At, B1); PG8_BAR;
            PG8_LDA(At, 0, 1); PG8_STAGE(PG8_SA(0, 0), a2, voffA);
            PG8_BAR; PG8_WAIT_L(0); PG8_MMA(1, 0, At, B0); PG8_BAR; PG8_SCHED;
            PG8_STAGE(PG8_SB(0, 1), b2 + hstepB, voffB);
            PG8_WAIT_V(6); PG8_BAR; PG8_MMA(1, 1, At, B1); PG8_BAR;
            PG8_LDB(B0, 1, 0); PG8_SCHED; PG8_LDA(At, 1, 0); PG8_STAGE(PG8_SA(0, 1), a2 + hstepA, voffA);
            PG8_WAIT_L(8); PG8_BAR; PG8_WAIT_L(0); PG8_MMA(0, 0, At, B0); PG8_BAR; PG8_SCHED;
            PG8_LDB(B1, 1, 1); PG8_STAGE(PG8_SB(1, 0), b3, voffB);
            PG8_BAR; PG8_WAIT_L(0); PG8_MMA(0, 1, At, B1); PG8_BAR;
            PG8_LDA(At, 1, 1); PG8_STAGE(PG8_SA(1, 0), a3, voffA);
            PG8_BAR; PG8_WAIT_L(0); PG8_MMA(1, 0, At, B0); PG8_BAR; PG8_SCHED;
            PG8_STAGE(PG8_SB(1, 1), b3 + hstepB, voffB);
            PG8_WAIT_V(6); PG8_BAR; PG8_MMA(1, 1, At, B1); PG8_BAR;
            }
        }
        if constexpr (ALIGN_EPI) { if (wr == 0) PG8_BAR; }
        if constexpr (!Epi::AFTER_DRAIN) { E(acc, cur, wr, wc, fr, fq, rsv); S.done(cur); }
        if (!has_next) break;
#pragma unroll
        for (int a = 0; a < 2; ++a)
#pragma unroll
            for (int b = 0; b < 2; ++b)
#pragma unroll
                for (int m = 0; m < 4; ++m)
#pragma unroll
                    for (int n = 0; n < 2; ++n) acc[a][b][m][n] = (f32x4){0.f, 0.f, 0.f, 0.f};
        cur = nxt; cA = nA; cB = nB; ++ui;
        if constexpr (ALIGN_EPI) { if (wr == 1) PG8_BAR; }
    }
    PG8_WAIT_V(0);
    if constexpr (!ALIGN_EPI) { if (wr == 0) PG8_BAR; }
    PG8_BAR;
    if constexpr (Epi::AFTER_DRAIN) { E.fused(acc, cur, wr, wc, fr, fq, lds, wid, lane); S.done(cur); }
#undef PG8_SA
#undef PG8_SB
#undef PG8_STAGE
#undef PG8_LDA
#undef PG8_LDB
#undef PG8_MMA
#undef PG8_WAIT_V
#undef PG8_WAIT_L
#undef PG8_BAR
#undef PG8_SCHED
}
}
#define LAS __attribute__((address_space(3)))
typedef unsigned short bf16;
typedef short bf16x8 __attribute__((ext_vector_type(8)));
typedef float f32x4 __attribute__((ext_vector_type(4)));
typedef float f32x16 __attribute__((ext_vector_type(16)));
typedef unsigned v4u __attribute__((ext_vector_type(4)));
typedef unsigned v2u __attribute__((ext_vector_type(2)));
constexpr int NWAVES = 8, NTHR = 512;
constexpr int DM = 1024, NBATCH = 8, SEQ = 2048, MP = NBATCH * SEQ, NS = 128, MT = MP + NS, MPAD = 16640;
constexpr int DFF = 2816, NGU = 2 * DFF, DMIX = 2048, NINP = 5888, LDPJ = 5632, DINP = 5648, CONVD = 1536;
constexpr int PC_Z = 0, PC_SCB = 1024, PC_XBC = 2048, PC_SCC = 3584, PC_SCH = 4608;
constexpr float EPS = 1e-6f;
constexpr size_t MiB = 1u << 20;
constexpr size_t WS_W2GU = 0, WS_W2D = 11 * MiB, WS_WOUT = WS_W2D + 5632 * 1024, WS_WIN = WS_WOUT + 4 * MiB, WS_XW = 32 * MiB;
constexpr size_t WS_SMALL = WS_XW + (size_t)MPAD * DM * 2;
constexpr size_t SM_SS2 = 0, SM_SS3 = 128 * 1024, SM_SSG = 256 * 1024, SM_DT = 512 * 1024;
constexpr size_t WS_PROJ = WS_SMALL + 2 * MiB;
constexpr size_t WS_W1GU = WS_PROJ, WS_W1D = WS_W1GU + 11 * MiB, WS_H = WS_W1D + 5632 * 1024;
constexpr size_t WS_END = WS_PROJ + (size_t)MPAD * LDPJ * 2;
constexpr size_t WS_BAR = WS_END, WS_SSGP = WS_BAR + 64 * 1024, WS_END2 = WS_SSGP + (size_t)MPAD * 2 * 16 * 4;
constexpr size_t WS_BCB = WS_WIN, WS_BCC = WS_END2, WS_END3 = WS_BCC + (size_t)MP * 256 * 2;
constexpr long BC_CDELTA = (long)((WS_BCC - WS_BCB) / 2);
static_assert(WS_END3 <= 256 * MiB && (size_t)MP * 256 * 2 <= (size_t)NINP * DM * 2, "d_ws map 2");
static_assert(WS_WIN + (size_t)NINP * DM * 2 <= WS_XW && WS_H + (size_t)MPAD * DFF * 2 <= WS_END && SM_DT + (size_t)MPAD * 16 * 4 <= 2 * MiB && WS_END <= 256 * MiB, "d_ws map");
constexpr size_t O_Y = 0, O_SSMP = (size_t)MT * DM, O_CONVP = O_SSMP + (size_t)NBATCH * 16 * 64 * 128, O_SCP = O_CONVP + (size_t)NBATCH * 3 * CONVD,
                 O_SSMS = O_SCP + (size_t)NBATCH * 2 * 1024, O_CONVS = O_SSMS + (size_t)NS * 16 * 64 * 128, O_SCS = O_CONVS + (size_t)NS * 3 * CONVD, O_END = O_SCS + (size_t)NS * 2 * 1024;
constexpr int LDS_BYTES = 147456;
constexpr int LDP = 136;
constexpr int CL_OFF = 0, BL_OFF = 128 * LDP * 2, BT_OFF = 2 * BL_OFF, XDT_OFF = 3 * BL_OFF, XDD_OFF = XDT_OFF + 32 * LDP * 2, SENT_OFF = XDD_OFF + 32 * LDP * 2,
              XS_OFF = SENT_OFF + 32 * LDP * 2, ACUM_OFF = XS_OFF + 128 * 32 * 2, DTV_OFF = ACUM_OFF + 1024, WBC_OFF = DTV_OFF + 1024, WX_OFF = WBC_OFF + 5 * 256 * 4, SSD_LDS_END = WX_OFF + 5 * 32 * 4;
static_assert(SSD_LDS_END <= LDS_BYTES, "LDS map");

struct Args { const float* in[24]; float* out; unsigned char* ws; int ph_lo, ph_hi, flags, pad; };
enum { I_XP = 0, I_XS, I_SSM, I_SCONV0, I_SSCONV, I_N1W, I_F1G, I_F1U, I_F1D, I_NMW, I_WIN, I_CW, I_CB, I_DTB, I_ALOG, I_DSKIP, I_SNW, I_SCW, I_WOUT, I_N2W, I_F2G, I_F2U, I_F2D, I_FNW };

__device__ __forceinline__ float bf2f(unsigned short b) { return __uint_as_float((unsigned)b << 16); }
__device__ __forceinline__ unsigned pk2(float lo, float hi) { return pg8::cvt_pk_bf16(lo, hi); }
__device__ __forceinline__ unsigned short f2bf1(float f) { return (unsigned short)(pg8::cvt_pk_bf16(f, 0.f) & 0xffffu); }
__device__ __forceinline__ float silu(float v) { return pg8::silu_f(v); }
__device__ __forceinline__ float softplus(float x) { return x > 20.f ? x : log1pf(__expf(x)); }
__device__ __forceinline__ float softplus_fast(float x) { const float e = __expf(x); return x > 20.f ? x : (e < 0.03125f ? e * (1.f + e * (-0.5f + e * (0.33333333f - 0.25f * e))) : __logf(1.f + e)); }
__device__ __forceinline__ float wave_sum(float v) {
#pragma unroll
    for (int o = 1; o < 64; o <<= 1) v += __shfl_xor(v, o);
    return v;
}
__device__ __forceinline__ void unpack8(const v4u r, float (&f)[8]) {
#pragma unroll
    for (int i = 0; i < 4; ++i) { f[2 * i] = __uint_as_float(r[i] << 16); f[2 * i + 1] = __uint_as_float(r[i] & 0xffff0000u); }
}
#define LDS_WAIT() asm volatile("s_waitcnt lgkmcnt(0)" ::: "memory")
#define MFMA32(a, b, c) __builtin_amdgcn_mfma_f32_32x32x16_bf16((a), (b), (c), 0, 0, 0)

__device__ __forceinline__ void p0_item(const float* W, int K, int Nsrc, int src_col0, int nvalid, bf16* WT, int dst_row0, int kb, LAS float* scr, int lane, const float* rscale = nullptr) {
    const int k0 = 64 * kb, nl = lane & 31; const bool ok = nl < nvalid;
#pragma unroll
    for (int i = 0; i < 32; ++i) { const int kk = 2 * i + (lane >> 5); float v = ok ? W[(size_t)(k0 + kk) * Nsrc + src_col0 + nl] : 0.f; if (rscale && k0 + kk < 1024) v *= rscale[k0 + kk]; scr[kk * 33 + nl] = v; }
    LDS_WAIT();
    const int c = lane & 7;
#pragma unroll
    for (int j = 0; j < 4; ++j) { const int n = (lane >> 3) + 8 * j; const LAS float* s = scr + (8 * c) * 33 + n;
        v4u o; o.x = pk2(s[0 * 33], s[1 * 33]); o.y = pk2(s[2 * 33], s[3 * 33]); o.z = pk2(s[4 * 33], s[5 * 33]); o.w = pk2(s[6 * 33], s[7 * 33]);
        *(v4u*)(WT + (size_t)(dst_row0 + n) * K + k0 + 8 * c) = o; }
    LDS_WAIT();
}
constexpr int P0_I_GU = 176 * 16, P0_I_D = 32 * 44, P0_I_IN = 184 * 16, P0_I_O = 32 * 32, P0_NITEMS = 2 * P0_I_GU + 2 * P0_I_D + P0_I_IN + P0_I_O;
__device__ __forceinline__ void p0_do_item(const Args& a, int it, LAS float* scr, int lane) {
    unsigned char* ws = a.ws; int r = it;
    if (r < 2 * P0_I_GU) {
        const int which = r >= P0_I_GU; r -= which * P0_I_GU; const int kb = r / 176, nb = r % 176, tile = nb >> 3, sub = nb & 7, bj = sub >> 2, c0 = (sub & 3) * 32;
        const float* W = which ? (bj ? a.in[I_F2U] : a.in[I_F2G]) : (bj ? a.in[I_F1U] : a.in[I_F1G]);
        p0_item(W, DM, DFF, tile * 128 + c0, 32, (bf16*)(ws + (which ? WS_W2GU : WS_W1GU)), nb * 32, kb, scr, lane); return; }
    r -= 2 * P0_I_GU;
    if (r < 2 * P0_I_D) { const int which = r >= P0_I_D; r -= which * P0_I_D; const int kb = r / 32, nb = r % 32;
        p0_item(which ? a.in[I_F2D] : a.in[I_F1D], DFF, DM, nb * 32, 32, (bf16*)(ws + (which ? WS_W2D : WS_W1D)), nb * 32, kb, scr, lane); return; }
    r -= 2 * P0_I_D;
    if (r < P0_I_IN) { const int kb = r / 184, nb = r % 184, n = nb * 32; int src, nv = 32;
        if (n < 1024) src = n; else if (n < 2048) src = 2576 + (n - 1024); else if (n < 3584) src = 1024 + (n - 2048); else if (n < 5632) { const int tl_ = (n - 3584) >> 8, w_ = (n - 3584) & 255; src = w_ < 128 ? 3600 + 128 * tl_ + w_ : 4624 + 128 * tl_ + (w_ - 128); }
        else if (n == 5632) { src = 2560; nv = 16; } else { src = 0; nv = 0; }
        p0_item(a.in[I_WIN], DM, DINP, src, nv, (bf16*)(ws + WS_WIN), n, kb, scr, lane); return; }
    r -= P0_I_IN;
    { const int kb = r / 32, nb = r % 32; p0_item(a.in[I_WOUT], DMIX, DM, nb * 32, 32, (bf16*)(ws + WS_WOUT), nb * 32, kb, scr, lane, a.in[I_SNW]); }
}
__device__ __forceinline__ void p0_late_weights(const Args& a, LAS unsigned char* lds, int gw, int NGW, int wave, int lane) {
    LAS float* scr = (LAS float*)(lds + wave * 16384);
    constexpr int NL = P0_I_GU + P0_I_D + P0_I_O;
    for (int i = gw; i < NL; i += NGW) {
        const int it = i < P0_I_GU ? P0_I_GU + i : (i < P0_I_GU + P0_I_D ? 2 * P0_I_GU + P0_I_D + (i - P0_I_GU) : 2 * P0_I_GU + 2 * P0_I_D + P0_I_IN + (i - P0_I_GU - P0_I_D));
        p0_do_item(a, it, scr, lane); }
}
__device__ __forceinline__ void p0_prologue(const Args& a, LAS unsigned char* lds, int gw, int NGW, int wave, int lane) {
    LAS float* scr = (LAS float*)(lds + wave * 16384);
    unsigned char* ws = a.ws;
    constexpr int NE = P0_I_GU + P0_I_D + P0_I_IN;
    for (int i = gw; i < NE; i += NGW) {
        const int it = i < P0_I_GU ? i : (i < P0_I_GU + P0_I_D ? 2 * P0_I_GU + (i - P0_I_GU) : 2 * P0_I_GU + 2 * P0_I_D + (i - P0_I_GU - P0_I_D));
        p0_do_item(a, it, scr, lane); }
    bf16* XW = (bf16*)(ws + WS_XW);
    for (int m0 = gw; m0 < MPAD; m0 += 2 * NGW) {
        f32x4 v[2][4]; float sq[2] = {0.f, 0.f};
#pragma unroll
        for (int q = 0; q < 2; ++q) { const int m = m0 + q * NGW, mc = m < MT ? m : MT - 1;
            const float* xrow = mc < MP ? a.in[I_XP] + (size_t)mc * DM : a.in[I_XS] + (size_t)(mc - MP) * DM; const f32x4* xr = (const f32x4*)xrow + lane;
#pragma unroll
            for (int j = 0; j < 4; ++j) v[q][j] = xr[64 * j]; }
#pragma unroll
        for (int q = 0; q < 2; ++q) { const float keep = (m0 + q * NGW < MT) ? 1.f : 0.f;
#pragma unroll
            for (int j = 0; j < 4; ++j) v[q][j] = v[q][j] * keep; }
        const f32x4* wr = (const f32x4*)a.in[I_N1W] + lane;
#pragma unroll
        for (int q = 0; q < 2; ++q)
#pragma unroll
            for (int j = 0; j < 4; ++j) sq[q] += (v[q][j].x * v[q][j].x + v[q][j].y * v[q][j].y) + (v[q][j].z * v[q][j].z + v[q][j].w * v[q][j].w);
#pragma unroll
        for (int q = 0; q < 2; ++q) { const int m = m0 + q * NGW; if (m >= MPAD) continue;
            const float rstd = rsqrtf(wave_sum(sq[q]) * (1.f / DM) + EPS);
            unsigned long long* o8 = (unsigned long long*)(XW + (size_t)m * DM) + lane;
#pragma unroll
            for (int j = 0; j < 4; ++j) { const f32x4 w4 = wr[64 * j]; o8[64 * j] = (unsigned long long)pk2(v[q][j].x * rstd * w4.x, v[q][j].y * rstd * w4.y) | ((unsigned long long)pk2(v[q][j].z * rstd * w4.z, v[q][j].w * rstd * w4.w) << 32); } }
    }
    { f32x4* z = (f32x4*)(ws + WS_SMALL); const int n16 = (int)(SM_DT / 16); for (int i = gw * 64 + lane; i < n16; i += NGW * 64) z[i] = (f32x4){0.f, 0.f, 0.f, 0.f}; }
}

__device__ __forceinline__ void small_gemm(LAS unsigned char* lds, const bf16* A, int lda, const bf16* Bt, int K,
                                           const float* base, float* out, float scale, bf16* xw, const float* wn, float* ss, const float* ssgp_rows = nullptr, const bf16* bbase = nullptr, const float* bw = nullptr) {
    const int tid = threadIdx.x, wid = __builtin_amdgcn_readfirstlane(tid >> 6), lane = tid & 63, i = lane & 15, q = lane >> 4, ks = wid & 3, tl = wid >> 2;
    LAS f32x4* red = (LAS f32x4*)lds;
    const int kq = K >> 2;
    for (int t0 = blockIdx.x * 2; t0 < 512; t0 += gridDim.x * 2) {
        const int t = t0 + tl, tr = t >> 6, tc = t & 63;
        f32x4 acc = {0.f, 0.f, 0.f, 0.f};
        if (t < 512) {
            const bf16* ap = A + (size_t)(tr * 16 + i) * lda + ks * kq + 8 * q; const bf16* bp = Bt + (size_t)(tc * 16 + i) * K + ks * kq + 8 * q;
#pragma unroll 4
            for (int k = 0; k < kq; k += 32) { const bf16x8 av = *(const bf16x8*)(ap + k), bv = *(const bf16x8*)(bp + k); acc = __builtin_amdgcn_mfma_f32_16x16x32_bf16(bv, av, acc, 0, 0, 0); }
        }
        if (ssgp_rows && ks < 2 && t < 512) {
            const f32x4* pp = (const f32x4*)(ssgp_rows + ((size_t)(tr * 16 + i) * 2 + ks) * 16); const f32x4 q4 = (pp[0] + pp[1]) + (pp[2] + pp[3]);
            acc = acc * rsqrtf(((q4[0] + q4[1]) + (q4[2] + q4[3])) * (1.0f / 512.0f) + 1e-6f); }
        red[(tl * 4 + ks) * 64 + lane] = acc;
        __syncthreads();
        if (ks == 0 && t < 512) {
            const f32x4 sum = (red[(tl * 4 + 0) * 64 + lane] + red[(tl * 4 + 1) * 64 + lane]) + (red[(tl * 4 + 2) * 64 + lane] + red[(tl * 4 + 3) * 64 + lane]);
            const int row = tr * 16 + i, col = tc * 16 + 4 * q; const size_t off = (size_t)row * 1024 + col;
            f32x4 bs_;
            if (bbase) { const v2u r_ = *(const v2u*)(bbase + off); const f32x4 q_ = *(const f32x4*)(bw + col);
                bs_ = (f32x4){__uint_as_float(r_.x << 16) / q_[0], __uint_as_float(r_.x & 0xffff0000u) / q_[1], __uint_as_float(r_.y << 16) / q_[2], __uint_as_float(r_.y & 0xffff0000u) / q_[3]}; }
            else bs_ = *(const f32x4*)(base + off);
            const f32x4 v = bs_ + sum * scale; if (out) *(f32x4*)(out + off) = v;
            float s = (v[0] * v[0] + v[1] * v[1]) + (v[2] * v[2] + v[3] * v[3]);
            if (xw) { const f32x4 w4 = wn ? *(const f32x4*)(wn + col) : (f32x4){1.f, 1.f, 1.f, 1.f}; v2u p; p.x = pk2(v[0] * w4[0], v[1] * w4[1]); p.y = pk2(v[2] * w4[2], v[3] * w4[3]); *(v2u*)(xw + off) = p; }
            if (ss) { s += __shfl_xor(s, 16); s += __shfl_xor(s, 32); if (q == 0) atomicAdd(ss + row, s); }
        }
        __syncthreads();
    }
}

__device__ __forceinline__ void bc_conv_prepass(const Args& a, int gw, int NGW, int lane) {
    const bf16* proj = (const bf16*)(a.ws + WS_PROJ); bf16* BCB = (bf16*)(a.ws + WS_BCB);
    const float* cw = a.in[I_CW] + 1024 + 8 * lane; const float* cb = a.in[I_CB] + 1024 + 8 * lane;
    float w[4][8], bi[8];
#pragma unroll
    for (int k = 0; k < 4; ++k) { const f32x4 w0 = *(const f32x4*)(cw + k * CONVD), w1 = *(const f32x4*)(cw + k * CONVD + 4);
        w[k][0] = w0[0]; w[k][1] = w0[1]; w[k][2] = w0[2]; w[k][3] = w0[3]; w[k][4] = w1[0]; w[k][5] = w1[1]; w[k][6] = w1[2]; w[k][7] = w1[3]; }
    { const f32x4 b0 = *(const f32x4*)(cb), b1 = *(const f32x4*)(cb + 4); bi[0] = b0[0]; bi[1] = b0[1]; bi[2] = b0[2]; bi[3] = b0[3]; bi[4] = b1[0]; bi[5] = b1[1]; bi[6] = b1[2]; bi[7] = b1[3]; }
    for (int u = gw; u < MP / 8; u += NGW) {
        const int row0 = u * 8, l0 = row0 & (SEQ - 1);
        const bf16* src = proj + (size_t)(row0 - 3) * LDPJ + PC_XBC + 1024 + 8 * lane;
        v4u raw[11];
#pragma unroll
        for (int rr = 0; rr < 11; ++rr) raw[rr] = (l0 - 3 + rr >= 0) ? *(const v4u*)(src + (size_t)rr * LDPJ) : (v4u){0u, 0u, 0u, 0u};
#pragma unroll
        for (int t = 0; t < 8; ++t) {
            float x0[8], x1[8], x2[8], x3[8], o[8]; unpack8(raw[t], x0); unpack8(raw[t + 1], x1); unpack8(raw[t + 2], x2); unpack8(raw[t + 3], x3);
#pragma unroll
            for (int j = 0; j < 8; ++j) o[j] = silu(bi[j] + w[0][j] * x0[j] + w[1][j] * x1[j] + w[2][j] * x2[j] + w[3][j] * x3[j]);
            v4u p; p.x = pk2(o[0], o[1]); p.y = pk2(o[2], o[3]); p.z = pk2(o[4], o[5]); p.w = pk2(o[6], o[7]);
            *(v4u*)(BCB + (lane < 32 ? 0 : BC_CDELTA) + (size_t)(row0 + t) * 256 + 8 * (lane & 31)) = p;
        }
    }
}

__device__ __forceinline__ int crow(int i, int hh) { return (i & 3) + 8 * (i >> 2) + 4 * hh; }
__device__ __forceinline__ void ssd_prompt(const Args& a, LAS unsigned char* lds, int unit) {
    const int tid0 = threadIdx.x, wid = __builtin_amdgcn_readfirstlane(tid0 >> 6);
    const int b = unit >> 5, h = (unit >> 1) & 15, ph = unit & 1, g = h >> 3;
    const float A_h = -__expf(a.in[I_ALOG][h]), dtb = a.in[I_DTB][h], Dh = a.in[I_DSKIP][h];
    bf16* proj = (bf16*)(a.ws + WS_PROJ); const float* dtbuf = (const float*)(a.ws + WS_SMALL + SM_DT); float* ssgp = (float*)(a.ws + WS_SSGP);
    LAS bf16* Cl = (LAS bf16*)(lds + CL_OFF); LAS bf16* Bl = (LAS bf16*)(lds + BL_OFF); LAS bf16* BT = (LAS bf16*)(lds + BT_OFF);
    LAS bf16* XDT = (LAS bf16*)(lds + XDT_OFF); LAS bf16* XDD = (LAS bf16*)(lds + XDD_OFF); LAS bf16* SENT = (LAS bf16*)(lds + SENT_OFF); LAS bf16* XS = (LAS bf16*)(lds + XS_OFF);
    LAS float* acum2 = (LAS float*)(lds + ACUM_OFF); LAS float* dtv2 = (LAS float*)(lds + DTV_OFF); LAS float* eac2 = (LAS float*)(lds + WBC_OFF); LAS float* WX = (LAS float*)(lds + WX_OFF);
    for (int i = tid0; i < 32 * LDP / 2; i += NTHR) ((LAS unsigned*)SENT)[i] = 0u;
    {
        const float* cw = a.in[I_CW]; const float* cb = a.in[I_CB];
        if (tid0 < 160) { const int k = tid0 >> 5, ch = h * 64 + 32 * ph + (tid0 & 31); WX[tid0] = k < 4 ? cw[k * CONVD + ch] : cb[ch]; }
    }
    const bf16* BCB = (const bf16*)(a.ws + WS_BCB);
    f32x16 st;
#pragma unroll
    for (int i = 0; i < 16; ++i) st[i] = 0.f;
    v4u nraw[8], nxraw[4]; float ndt0 = 0.f, ndt1 = 0.f;
    {
        const int tcol = tid0 & 15, tg = tid0 >> 4, xl = (tid0 & 15) | ((tid0 >> 6) << 4), xc = (tid0 >> 4) & 3;
        const bf16* src = BCB + (size_t)(b * SEQ + 4 * tg) * 256 + g * 128 + 8 * tcol;
#pragma unroll
        for (int rr = 0; rr < 4; ++rr) { nraw[rr] = *(const v4u*)(src + (size_t)rr * 256); nraw[4 + rr] = *(const v4u*)(src + BC_CDELTA + (size_t)rr * 256); }
        const bf16* srx = proj + (size_t)(b * SEQ + xl - 3) * LDPJ + PC_XBC + h * 64 + 32 * ph + 8 * xc;
#pragma unroll
        for (int rr = 0; rr < 4; ++rr) nxraw[rr] = (xl - 3 + rr >= 0) ? *(const v4u*)(srx + (size_t)rr * LDPJ) : (v4u){0u, 0u, 0u, 0u};
        if (wid == 4) { const int l0 = 2 * (tid0 & 63); ndt0 = dtbuf[(size_t)(b * SEQ + l0) * 16 + h]; ndt1 = dtbuf[(size_t)(b * SEQ + l0 + 1) * 16 + h]; }
    }
#define SSD_STAGE_D(buf) do { const int ln_ = tid0 & 63, l0_ = 2 * ln_; const float d0_ = softplus_fast(ndt0 + dtb), d1_ = softplus_fast(ndt1 + dtb), a0_ = d0_ * A_h, a1_ = d1_ * A_h, s_ = a0_ + a1_; float incl_ = s_; \
        _Pragma("unroll") for (int o_ = 1; o_ < 64; o_ <<= 1) { const float t_ = __shfl_up(incl_, o_); if (ln_ >= o_) incl_ += t_; } \
        const float c0_ = (incl_ - s_ + a0_) * 1.44269504f, c1_ = incl_ * 1.44269504f; acum2[(buf) * 128 + l0_] = c0_; acum2[(buf) * 128 + l0_ + 1] = c1_; eac2[(buf) * 128 + l0_] = __builtin_amdgcn_exp2f(c0_); eac2[(buf) * 128 + l0_ + 1] = __builtin_amdgcn_exp2f(c1_); dtv2[(buf) * 128 + l0_] = d0_; dtv2[(buf) * 128 + l0_ + 1] = d1_; } while (0)
    if (wid == 4) SSD_STAGE_D(0);
    __syncthreads();
    const bf16* p_bc; const bf16* p_x; bf16* p_z; const float* p_dt; float* p_sq;
    {   const int tcol = tid0 & 15, tg = tid0 >> 4, xl = (tid0 & 15) | ((tid0 >> 6) << 4), xc = (tid0 >> 4) & 3;
        p_bc = BCB + (size_t)(b * SEQ + 128 + 4 * tg) * 256 + g * 128 + 8 * tcol;
        p_x = proj + (size_t)(b * SEQ + 128 + xl - 3) * LDPJ + PC_XBC + h * 64 + 32 * ph + 8 * xc;
        p_z = proj + (size_t)(b * SEQ + xl) * LDPJ + PC_Z + h * 64 + 32 * ph + 8 * xc;
        p_dt = dtbuf + (size_t)(b * SEQ + 128 + 2 * (tid0 & 63)) * 16 + h;
        p_sq = ssgp + ((size_t)(b * SEQ + xl) * 2 + g) * 16 + (h & 7) * 2 + ph; }
#define SSD_BAR() do { asm volatile("s_waitcnt lgkmcnt(0)" ::: "memory"); __builtin_amdgcn_s_barrier(); asm volatile("" ::: "memory"); } while (0)
#pragma unroll 1
    for (int c = 0; c < 16; ++c) {
        int tid = tid0; asm volatile("" : "+v"(tid));
        const int lane = tid & 63, r = lane & 31, hh = lane >> 5;
        const int tcol = tid & 15, tg = tid >> 4;
        const int xl = (tid & 15) | ((tid >> 6) << 4), xc = (tid >> 4) & 3;
        const int tok0 = b * SEQ + c * 128;
        LAS float* acum = acum2 + (c & 1) * 128; LAS float* dtv = dtv2 + (c & 1) * 128; LAS float* eac = eac2 + (c & 1) * 128;
        {
#pragma unroll
            for (int t = 0; t < 4; ++t) { *(LAS v4u*)(Bl + (4 * tg + t) * LDP + 8 * tcol) = nraw[t]; *(LAS v4u*)(Cl + (4 * tg + t) * LDP + 8 * tcol) = nraw[4 + t]; }
            const int boff = 8 * ((tg >> 1) ^ tcol) + 4 * (tg & 1);
#pragma unroll
            for (int i = 0; i < 4; ++i) { v2u lo, hi;
#pragma unroll
                for (int u = 0; u < 2; ++u) { const unsigned e0 = nraw[2 * u][i], e1 = nraw[2 * u + 1][i]; lo[u] = (e0 & 0xffffu) | (e1 << 16); hi[u] = (e0 >> 16) | (e1 & 0xffff0000u); }
                *(LAS v2u*)(BT + (8 * tcol + 2 * i) * LDP + boff) = lo; *(LAS v2u*)(BT + (8 * tcol + 2 * i + 1) * LDP + boff) = hi; }
        }
        {
            float x0[8], x1[8], x2[8], x3[8]; unpack8(nxraw[0], x0); unpack8(nxraw[1], x1); unpack8(nxraw[2], x2); unpack8(nxraw[3], x3);
            float xo[8];
#pragma unroll
            for (int hf = 0; hf < 2; ++hf) { const f32x4 w0 = *(const LAS f32x4*)(WX + 0 * 32 + 8 * xc + 4 * hf), w1 = *(const LAS f32x4*)(WX + 1 * 32 + 8 * xc + 4 * hf), w2 = *(const LAS f32x4*)(WX + 2 * 32 + 8 * xc + 4 * hf),
                                                     w3 = *(const LAS f32x4*)(WX + 3 * 32 + 8 * xc + 4 * hf), bb = *(const LAS f32x4*)(WX + 4 * 32 + 8 * xc + 4 * hf);
#pragma unroll
                for (int e = 0; e < 4; ++e) { const int j = 4 * hf + e; xo[j] = silu(bb[e] + w0[e] * x0[j] + w1[e] * x1[j] + w2[e] * x2[j] + w3[e] * x3[j]); } }
            const float dl = dtv[xl], de = dl * __builtin_amdgcn_exp2f(acum[127] - acum[xl]);
            { v4u p; p.x = pk2(xo[0], xo[1]); p.y = pk2(xo[2], xo[3]); p.z = pk2(xo[4], xo[5]); p.w = pk2(xo[6], xo[7]); *(LAS v4u*)(XS + xl * 32 + 8 * xc) = p; }
#pragma unroll
            for (int j = 0; j < 8; ++j) { const unsigned pk = pk2(xo[j] * dl, xo[j] * de); XDT[(8 * xc + j) * LDP + xl] = (unsigned short)pk; XDD[(8 * xc + j) * LDP + xl] = (unsigned short)(pk >> 16); }
        }
        SSD_BAR();
        if (c < 15) {
#pragma unroll
            for (int rr = 0; rr < 4; ++rr) { nraw[rr] = *(const v4u*)(p_bc + (size_t)rr * 256); nraw[4 + rr] = *(const v4u*)(p_bc + BC_CDELTA + (size_t)rr * 256); }
#pragma unroll
            for (int rr = 0; rr < 4; ++rr) nxraw[rr] = *(const v4u*)(p_x + (size_t)rr * LDPJ);
            if (wid == 4) { ndt0 = p_dt[0]; ndt1 = p_dt[16]; }
        }
        const v4u zraw = *(const v4u*)p_z;
        const int lb = wid >> 1, sh = wid & 1;
        f32x16 sacc[2];
        {
            bf16x8 cf[8];
#pragma unroll
            for (int ks = 0; ks < 8; ++ks) cf[ks] = *(const LAS bf16x8*)(Cl + (32 * lb + r) * LDP + 16 * ks + 8 * hh);
#pragma unroll
            for (int tt = 0; tt < 2; ++tt) { const int sb = 2 * sh + tt;
#pragma unroll
                for (int i = 0; i < 16; ++i) sacc[tt][i] = 0.f;
                if (sb <= lb) {
#pragma unroll
                    for (int ks = 0; ks < 8; ++ks) { const bf16x8 af = *(const LAS bf16x8*)(Bl + (32 * sb + r) * LDP + 16 * ks + 8 * hh); sacc[tt] = MFMA32(af, cf[ks], sacc[tt]); } } }
        }
        SSD_BAR();
        {
            LAS bf16* P = Bl; const int l = 32 * lb + r; const float al = acum[l];
#pragma unroll
            for (int tt = 0; tt < 2; ++tt) { const int sb = 2 * sh + tt;
                if (sb < lb) {
#pragma unroll
                    for (int gq = 0; gq < 4; ++gq) { const int s0 = 32 * sb + 8 * gq + 4 * hh; const f32x4 as4 = *(const LAS f32x4*)(acum + s0); float v[4];
#pragma unroll
                        for (int e = 0; e < 4; ++e) v[e] = sacc[tt][4 * gq + e] * __builtin_amdgcn_exp2f(al - as4[e]);
                        v2u p; p.x = pk2(v[0], v[1]); p.y = pk2(v[2], v[3]); *(LAS v2u*)(P + l * LDP + s0) = p; }
                } else if (sb == lb) {
#pragma unroll
                    for (int gq = 0; gq < 4; ++gq) { const int s0 = 32 * sb + 8 * gq + 4 * hh; const f32x4 as4 = *(const LAS f32x4*)(acum + s0); float v[4];
#pragma unroll
                        for (int e = 0; e < 4; ++e) v[e] = (s0 + e <= l) ? sacc[tt][4 * gq + e] * __builtin_amdgcn_exp2f(al - as4[e]) : 0.f;
                        v2u p; p.x = pk2(v[0], v[1]); p.y = pk2(v[2], v[3]); *(LAS v2u*)(P + l * LDP + s0) = p; } } }
        }
        SSD_BAR();
        asm volatile("" : "+v"(nraw[0]), "+v"(nraw[1]), "+v"(nraw[2]), "+v"(nraw[3]), "+v"(nraw[4]), "+v"(nraw[5]), "+v"(nraw[6]), "+v"(nraw[7]), "+v"(nxraw[0]), "+v"(nxraw[1]), "+v"(nxraw[2]), "+v"(nxraw[3]), "+v"(ndt0), "+v"(ndt1));
        if (wid < 4) {
            const int lb2 = wid; const LAS bf16* P = Bl;
            f32x16 yd, yo;
#pragma unroll
            for (int i = 0; i < 16; ++i) { yd[i] = 0.f; yo[i] = 0.f; }
            for (int sb = 0; sb <= lb2; ++sb) {
                const bf16x8 af0 = *(const LAS bf16x8*)(P + (32 * lb2 + r) * LDP + 32 * sb + 8 * hh), bf0 = *(const LAS bf16x8*)(XDT + r * LDP + 32 * sb + 8 * hh),
                             af1 = *(const LAS bf16x8*)(P + (32 * lb2 + r) * LDP + 32 * sb + 16 + 8 * hh), bf1 = *(const LAS bf16x8*)(XDT + r * LDP + 32 * sb + 16 + 8 * hh);
                yd = MFMA32(af0, bf0, yd); yd = MFMA32(af1, bf1, yd); }
#pragma unroll
            for (int ks = 0; ks < 8; ++ks) { const bf16x8 af = *(const LAS bf16x8*)(Cl + (32 * lb2 + r) * LDP + 16 * ks + 8 * hh), bfv = *(const LAS bf16x8*)(SENT + r * LDP + 16 * ks + 8 * hh); yo = MFMA32(af, bfv, yo); }
#pragma unroll
            for (int g4 = 0; g4 < 4; ++g4) { const f32x4 ea = *(const LAS f32x4*)(eac + 32 * lb2 + 8 * g4 + 4 * hh);
#pragma unroll
                for (int e = 0; e < 4; ++e) { const int i = 4 * g4 + e, l = 32 * lb2 + 8 * g4 + 4 * hh + e;
                    XS[l * 32 + r] = f2bf1(yd[i] + ea[e] * yo[i] + Dh * bf2f(XS[l * 32 + r])); } }
        } else {
            const int nb = wid - 4; const float cd = eac[127];
#pragma unroll
            for (int i = 0; i < 16; ++i) st[i] *= cd;
#pragma unroll
            for (int ks = 0; ks < 8; ++ks) { const bf16x8 af = *(const LAS bf16x8*)(BT + (32 * nb + r) * LDP + 8 * ((2 * ks + hh) ^ ((4 * nb + (r >> 3)) & 15))), bfv = *(const LAS bf16x8*)(XDD + r * LDP + 16 * ks + 8 * hh); st = MFMA32(af, bfv, st); }
            if (wid == 4 && c < 15) SSD_STAGE_D((c + 1) & 1);
        }
        SSD_BAR();
        if (wid >= 4) { const int nb = wid - 4;
#pragma unroll
            for (int gq = 0; gq < 4; ++gq) { v2u p; p.x = pk2(st[4 * gq], st[4 * gq + 1]); p.y = pk2(st[4 * gq + 2], st[4 * gq + 3]); *(LAS v2u*)(SENT + r * LDP + 32 * nb + 8 * gq + 4 * hh) = p; } }
        {
            float yv[8], zf[8]; unpack8(*(const LAS v4u*)(XS + xl * 32 + 8 * xc), yv); unpack8(zraw, zf);
            float sq = 0.f;
#pragma unroll
            for (int j = 0; j < 8; ++j) { yv[j] *= zf[j]; sq += yv[j] * yv[j]; }
            v4u o; o.x = pk2(yv[0], yv[1]); o.y = pk2(yv[2], yv[3]); o.z = pk2(yv[4], yv[5]); o.w = pk2(yv[6], yv[7]);
            *(v4u*)p_z = o;
            sq += __shfl_xor(sq, 16); sq += __shfl_xor(sq, 32);
            if (xc == 0) *p_sq = sq;
        }
        p_bc += 128 * 256; p_x += (size_t)128 * LDPJ; p_z += (size_t)128 * LDPJ; p_dt += 128 * 16; p_sq += 128 * 2 * 16;
    }
#undef SSD_STAGE_D
#undef SSD_BAR
    const int r = tid0 & 31, hh = (tid0 >> 5) & 1;
    if (wid >= 4) { const int nb = wid - 4; float* o = a.out + O_SSMP + ((size_t)(b * 16 + h) * 64 + 32 * ph + r) * 128 + 32 * nb + 4 * hh;
#pragma unroll
        for (int gq = 0; gq < 4; ++gq) *(f32x4*)(o + 8 * gq) = (f32x4){st[4 * gq], st[4 * gq + 1], st[4 * gq + 2], st[4 * gq + 3]}; }
    __syncthreads();
}
constexpr int SMP_SCR = 11264;
__device__ __forceinline__ void ssd_sample(const Args& a, LAS float* scr, int wu, int lane) {
    const int j = wu >> 4, h = wu & 15, g = h >> 3; const size_t row = (size_t)(MP + j);
    bf16* prow = (bf16*)(a.ws + WS_PROJ) + row * LDPJ; const float* dtbuf = (const float*)(a.ws + WS_SMALL + SM_DT); float* ssgp = (float*)(a.ws + WS_SSGP);
    const float* cw = a.in[I_CW]; const float* cb = a.in[I_CB]; const float* cst = a.in[I_SCONV0] + (size_t)j * 3 * CONVD;
    const float A_h = -__expf(a.in[I_ALOG][h]), Dh = a.in[I_DSKIP][h];
    const float dt = softplus(dtbuf[row * 16 + h] + a.in[I_DTB][h]), dA = __expf(dt * A_h);
    LAS float* sx = scr; LAS float* sxs = scr + 64; LAS float* sB = scr + 128; LAS float* sC = scr + 256; LAS float* sp = scr + 384;
#pragma unroll
    for (int t = 0; t < 5; ++t) {
        const int ch = t == 0 ? (h * 64 + lane) : (t < 3 ? (1024 + g * 128 + lane + 64 * (t - 1)) : (1280 + g * 128 + lane + 64 * (t - 3)));
        float v = cb[ch] + cw[0 * CONVD + ch] * cst[0 * CONVD + ch] + cw[1 * CONVD + ch] * cst[1 * CONVD + ch] + cw[2 * CONVD + ch] * cst[2 * CONVD + ch] + cw[3 * CONVD + ch] * bf2f(prow[PC_XBC + ch]);
        v = silu(v);
        if (t == 0) { sx[lane] = v * dt; sxs[lane] = v; } else if (t < 3) sB[lane + 64 * (t - 1)] = v; else sC[lane + 64 * (t - 3)] = v;
    }
    const float zf = bf2f(prow[PC_Z + h * 64 + lane]);
    LDS_WAIT();
    const int rs = lane >> 5, n4 = lane & 31;
    const f32x4 Br = *(const LAS f32x4*)(sB + 4 * n4), Cr = *(const LAS f32x4*)(sC + 4 * n4);
    const f32x4* __restrict__ S0 = (const f32x4*)(a.in[I_SSM] + ((size_t)(j * 16 + h) * 64) * 128) + lane; f32x4* __restrict__ S1 = (f32x4*)(a.out + O_SSMS + ((size_t)(j * 16 + h) * 64) * 128) + lane;
#pragma unroll 1
    for (int it0 = 0; it0 < 32; it0 += 16) {
        f32x4 s4[16];
#pragma unroll
        for (int k = 0; k < 16; ++k) s4[k] = __builtin_nontemporal_load(S0 + 64 * (it0 + k));
#pragma unroll
        for (int k = 0; k < 16; ++k) { const int p = 2 * (it0 + k) + rs; const float xd = sx[p];
            const f32x4 nv = s4[k] * dA + Br * xd; __builtin_nontemporal_store(nv, S1 + 64 * (it0 + k));
            sp[p * 36 + n4] = (nv[0] * Cr[0] + nv[1] * Cr[1]) + (nv[2] * Cr[2] + nv[3] * Cr[3]); }
    }
    LDS_WAIT();
    float y = 0.f;
#pragma unroll
    for (int k = 0; k < 8; ++k) { const f32x4 v = *(const LAS f32x4*)(sp + lane * 36 + 4 * k); y += (v[0] + v[1]) + (v[2] + v[3]); }
    y = (y + Dh * sxs[lane]) * zf;
    prow[PC_Z + h * 64 + lane] = f2bf1(y);
    const float sq = wave_sum(y * y);
    if (lane < 2) ssgp[(row * 2 + g) * 16 + (h & 7) * 2 + lane] = lane == 0 ? sq : 0.f;
    LDS_WAIT();
}

__device__ __forceinline__ void p5_fix(const Args& a, int gw, int NGW, int lane) {
    bf16* proj = (bf16*)(a.ws + WS_PROJ); const float* ssgp = (const float*)(a.ws + WS_SSGP);
    const float* snw = a.in[I_SNW]; const float* scw = a.in[I_SCW];
    for (int u = gw; u < 2048 + 256; u += NGW) {
        const bool smp = u >= 2048; const int uu = smp ? u - 2048 : u, tgp = uu >> 1, kind = 2 + (uu & 1);
        const size_t row0 = smp ? (size_t)(MP + tgp) : (size_t)tgp * 16;
        if (kind < 2) continue;
        if (false) {
            const int ch = 512 * kind + 8 * lane; const f32x4 w0 = *(const f32x4*)(snw + ch), w1 = *(const f32x4*)(snw + ch + 4);
            if (smp) {
                const f32x4* pp = (const f32x4*)(ssgp + (row0 * 2 + kind) * 16); const f32x4 q4 = (pp[0] + pp[1]) + (pp[2] + pp[3]); const float rs = rsqrtf(((q4[0] + q4[1]) + (q4[2] + q4[3])) * (1.f / 512.f) + EPS);
                v4u* p = (v4u*)(proj + row0 * LDPJ + PC_Z + ch); float f[8]; unpack8(*p, f);
                v4u o; o.x = pk2(f[0] * rs * w0[0], f[1] * rs * w0[1]); o.y = pk2(f[2] * rs * w0[2], f[3] * rs * w0[3]); o.z = pk2(f[4] * rs * w1[0], f[5] * rs * w1[1]); o.w = pk2(f[6] * rs * w1[2], f[7] * rs * w1[3]); *p = o;
            } else {
                v4u raw[16]; float qs[16];
#pragma unroll
                for (int t = 0; t < 16; ++t) raw[t] = *(const v4u*)(proj + (row0 + t) * LDPJ + PC_Z + ch);
#pragma unroll
                for (int t = 0; t < 16; ++t) { const f32x4* pp = (const f32x4*)(ssgp + ((row0 + t) * 2 + kind) * 16); const f32x4 q4 = (pp[0] + pp[1]) + (pp[2] + pp[3]); qs[t] = (q4[0] + q4[1]) + (q4[2] + q4[3]); }
#pragma unroll
                for (int t = 0; t < 16; ++t) { const float rs = rsqrtf(qs[t] * (1.f / 512.f) + EPS); float f[8]; unpack8(raw[t], f);
                    v4u o; o.x = pk2(f[0] * rs * w0[0], f[1] * rs * w0[1]); o.y = pk2(f[2] * rs * w0[2], f[3] * rs * w0[3]); o.z = pk2(f[4] * rs * w1[0], f[5] * rs * w1[1]); o.w = pk2(f[6] * rs * w1[2], f[7] * rs * w1[3]);
                    *(v4u*)(proj + (row0 + t) * LDPJ + PC_Z + ch) = o; }
            }
        } else {
            const int ch = 512 * (kind - 2) + 8 * lane; float w[3][8];
#pragma unroll
            for (int k = 0; k < 3; ++k) { const f32x4 a0 = *(const f32x4*)(scw + k * 1024 + ch), a1 = *(const f32x4*)(scw + k * 1024 + ch + 4);
                w[k][0] = a0[0]; w[k][1] = a0[1]; w[k][2] = a0[2]; w[k][3] = a0[3]; w[k][4] = a1[0]; w[k][5] = a1[1]; w[k][6] = a1[2]; w[k][7] = a1[3]; }
            float u2[8], u1[8];
            if (smp) { const float* sp_ = a.in[I_SSCONV] + (size_t)tgp * 2 * 1024 + ch; float cc[8], hv[8], bb[8], uc[8], y[8];
#pragma unroll
                for (int e = 0; e < 8; ++e) { u2[e] = sp_[e]; u1[e] = sp_[1024 + e]; }
                unpack8(*(const v4u*)(proj + row0 * LDPJ + PC_SCC + ch), cc); v4u* pb = (v4u*)(proj + row0 * LDPJ + PC_SCB + ch); unpack8(*pb, bb); (void)hv;
#pragma unroll
                for (int e = 0; e < 8; ++e) { uc[e] = cc[e]; y[e] = bb[e] * (w[0][e] * u2[e] + w[1][e] * u1[e] + w[2][e] * uc[e]); }
                v4u o; o.x = pk2(y[0], y[1]); o.y = pk2(y[2], y[3]); o.z = pk2(y[4], y[5]); o.w = pk2(y[6], y[7]); *pb = o;
                float* d = a.out + O_SCS + (size_t)tgp * 2 * 1024 + ch;
#pragma unroll
                for (int e = 0; e < 8; ++e) { d[e] = u1[e]; d[1024 + e] = uc[e]; }
            } else {
                const int l0 = (tgp & 127) * 16;
                v4u hc[2];
#pragma unroll
                for (int q = 0; q < 2; ++q) { const bool ok = l0 > 0; hc[q] = ok ? *(const v4u*)(proj + (row0 - 2 + q) * LDPJ + PC_SCC + ch) : (v4u){0u, 0u, 0u, 0u}; }
                unpack8(hc[0], u2); unpack8(hc[1], u1);
#pragma unroll
                for (int half = 0; half < 2; ++half) {
                    v4u rc[8], rb[8];
#pragma unroll
                    for (int t = 0; t < 8; ++t) { const size_t row = row0 + 8 * half + t; rc[t] = *(const v4u*)(proj + row * LDPJ + PC_SCC + ch); rb[t] = *(const v4u*)(proj + row * LDPJ + PC_SCB + ch); }
#pragma unroll
                    for (int t = 0; t < 8; ++t) { const size_t row = row0 + 8 * half + t; float bb[8], uc[8], y[8]; unpack8(rc[t], uc); unpack8(rb[t], bb);
#pragma unroll
                        for (int e = 0; e < 8; ++e) { y[e] = bb[e] * (w[0][e] * u2[e] + w[1][e] * u1[e] + w[2][e] * uc[e]); }
                        v4u o; o.x = pk2(y[0], y[1]); o.y = pk2(y[2], y[3]); o.z = pk2(y[4], y[5]); o.w = pk2(y[6], y[7]); *(v4u*)(proj + row * LDPJ + PC_SCB + ch) = o;
                        const int l = l0 + 8 * half + t;
                        if (l >= SEQ - 2) { float* d = a.out + O_SCP + ((size_t)(tgp >> 7) * 2 + (l - (SEQ - 2))) * 1024 + ch;
#pragma unroll
                            for (int e = 0; e < 8; ++e) d[e] = uc[e]; }
#pragma unroll
                        for (int e = 0; e < 8; ++e) { u2[e] = u1[e]; u1[e] = uc[e]; } }
                }
            }
        }
    }
    const int gt = gw * 64 + lane, NT = NGW * 64;
    for (int i4 = gt; i4 < NBATCH * 3 * CONVD / 4; i4 += NT) { const int i = 4 * i4, c = i % CONVD, k = (i / CONVD) % 3, b = i / (3 * CONVD);
        const v2u r2 = *(const v2u*)(proj + (size_t)(b * SEQ + SEQ - 3 + k) * LDPJ + PC_XBC + c);
        *(f32x4*)(a.out + O_CONVP + i) = (f32x4){__uint_as_float(r2.x << 16), __uint_as_float(r2.x & 0xffff0000u), __uint_as_float(r2.y << 16), __uint_as_float(r2.y & 0xffff0000u)}; }
    for (int i4 = gt; i4 < NS * 3 * CONVD / 4; i4 += NT) { const int i = 4 * i4, c = i % CONVD, k = (i / CONVD) % 3, j = i / (3 * CONVD);
        f32x4 o;
        if (k < 2) o = *(const f32x4*)(a.in[I_SCONV0] + (size_t)j * 3 * CONVD + (k + 1) * CONVD + c);
        else { const v2u r2 = *(const v2u*)(proj + (size_t)(MP + j) * LDPJ + PC_XBC + c); o = (f32x4){__uint_as_float(r2.x << 16), __uint_as_float(r2.x & 0xffff0000u), __uint_as_float(r2.y << 16), __uint_as_float(r2.y & 0xffff0000u)}; }
        *(f32x4*)(a.out + O_CONVS + i) = o; }
}

#define XB_TMO      128
#define XB_XCNT(j)  (256  + 64 * (j))
#define XB_XSUB(j)  (1280 + 64 * (j))
#define XB_XGEN(j)  (2304 + 64 * (j))
#define XB_TOP      3328
#define XB_TOPGEN   3392
#define XCD_BAR_WORDS 3456
#define XB_SPIN_CAP (1u << 18)

__device__ __forceinline__ unsigned xb_ld(unsigned* p)              { return __hip_atomic_load(p, __ATOMIC_RELAXED, __HIP_MEMORY_SCOPE_AGENT); }
__device__ __forceinline__ unsigned xb_add(unsigned* p, unsigned v) { return __hip_atomic_fetch_add(p, v, __ATOMIC_RELAXED, __HIP_MEMORY_SCOPE_AGENT); }
__device__ __forceinline__ unsigned xb_xcc_id() { return (unsigned)__builtin_amdgcn_s_getreg((3 << 11) | 20) & 0xFu; }
#define XB_SPIN(cond, bar) do { unsigned _sp = 0; while (cond) { __builtin_amdgcn_s_sleep(1); \
    if ((++_sp & 255u) == 0u) { if (xb_ld(&(bar)[XB_TMO])) break; if (_sp > XB_SPIN_CAP) { atomicAdd(&(bar)[XB_TMO], 1u); break; } } } } while (0)

struct XcdBarrier {
    unsigned* bar; unsigned x;
    volatile LAS unsigned* st;
};

__device__ __forceinline__ XcdBarrier xcd_barrier_post(unsigned* bar, volatile LAS unsigned* st) {
    XcdBarrier b; b.bar = bar; b.x = xb_xcc_id(); b.st = st;
    if (threadIdx.x == 0) (void)xb_add(&bar[XB_XCNT(b.x)], 1u);
    return b;
}
__device__ __forceinline__ void xcd_barrier_complete(unsigned* bar, unsigned x, unsigned& nloc, unsigned& nx) {
    const unsigned G = gridDim.x * gridDim.y * gridDim.z;
    unsigned sum, cnt, mine, sp = 0u;
    for (;;) {
        sum = 0u; cnt = 0u; mine = 0u;
#pragma unroll
        for (unsigned j = 0; j < 16; ++j) { const unsigned c = xb_ld(&bar[XB_XCNT(j)]); sum += c; cnt += (c > 0u) ? 1u : 0u; mine = (j == x) ? c : mine; }
        if (sum == G) break;
        __builtin_amdgcn_s_sleep(1);
        if ((++sp & 255u) == 0u) { if (xb_ld(&bar[XB_TMO])) break; if (sp > XB_SPIN_CAP) { atomicAdd(&bar[XB_TMO], 1u); break; } }
    }
    nloc = mine > 0u ? mine : 1u; nx = cnt > 0u ? cnt : 1u;
}

__device__ __forceinline__ void xcd_barrier(const XcdBarrier& b) {
    asm volatile("s_waitcnt vmcnt(0)" ::: "memory");
    __syncthreads();
    if (threadIdx.x == 0) {
        unsigned* bar = b.bar;
        __builtin_amdgcn_s_waitcnt(0);
        unsigned nloc = b.st[0], nx = b.st[1];
        if (nloc == 0u) { xcd_barrier_complete(bar, b.x, nloc, nx); b.st[0] = nloc; b.st[1] = nx; }
        const unsigned old = xb_add(&bar[XB_XSUB(b.x)], 1u);
        const unsigned gen = old / nloc;
        if (old + 1u == (gen + 1u) * nloc) {
            __builtin_amdgcn_fence(__ATOMIC_RELEASE, "agent");
            asm volatile("s_waitcnt vmcnt(0)" ::: "memory");
            const unsigned og = xb_add(&bar[XB_TOP], 1u);
            const unsigned tg = og / nx;
            if (og + 1u == (tg + 1u) * nx) xb_add(&bar[XB_TOPGEN], 1u);
            else XB_SPIN(xb_ld(&bar[XB_TOPGEN]) == tg, bar);
            __builtin_amdgcn_fence(__ATOMIC_ACQUIRE, "agent");
            xb_add(&bar[XB_XGEN(b.x)], 1u);
            asm volatile("s_waitcnt vmcnt(0)" ::: "memory");
        } else {
            XB_SPIN(xb_ld(&bar[XB_XGEN(b.x)]) == gen, bar);
            __builtin_amdgcn_fence(__ATOMIC_ACQUIRE, "agent");
            asm volatile("s_waitcnt vmcnt(0)" ::: "memory");
        }
    }
    __syncthreads();
}

__global__ void __launch_bounds__(NTHR, 2) hymba_fwd(Args a) {
    extern __shared__ __attribute__((aligned(16))) unsigned char lds_raw[];
    cg::grid_group grid = cg::this_grid();
    LAS unsigned char* lds = (LAS unsigned char*)lds_raw;
    const int tid = threadIdx.x, lane = tid & 63, wave = __builtin_amdgcn_readfirstlane(tid >> 6);
    const int G = gridDim.x, gw = blockIdx.x * NWAVES + wave, NGW = G * NWAVES;
    unsigned char* ws = a.ws;
    bf16* XW = (bf16*)(ws + WS_XW); bf16* H = (bf16*)(ws + WS_H); bf16* PROJ = (bf16*)(ws + WS_PROJ);
    float* ss2 = (float*)(ws + WS_SMALL + SM_SS2); float* ss3 = (float*)(ws + WS_SMALL + SM_SS3); float* dtbuf = (float*)(ws + WS_SMALL + SM_DT);
    float* xres = a.out + O_Y;
    volatile LAS unsigned* MISC = (volatile LAS unsigned*)(lds + LDS_BYTES - 64);
    if (tid < 16) MISC[tid] = 0u;
    __syncthreads();
    XcdBarrier bar = xcd_barrier_post((unsigned*)(ws + WS_BAR), MISC);
    const int lo = a.ph_lo, hi = a.ph_hi;
#ifndef PH_MASK
#define PH_MASK 0x7ff
#endif
#define IN(k) (((PH_MASK >> (k)) & 1) && lo <= (k) && (k) < hi)
#define SEAM(k) do { if (IN(k) && IN((k) + 1)) xcd_barrier(bar); } while (0)
    if (a.ph_hi > 1000) grid.sync();
    if (IN(0)) p0_prologue(a, lds, gw, NGW, wave, lane);
    SEAM(0);
    if (IN(1)) {
        pg8::Gemm g{XW, (const bf16*)(ws + WS_W1GU), MPAD, NGU, DM, DM}; pg8::StaticOrder S; S.init(MPAD, NGU, G, (int)blockIdx.x);
        pg8::EpiSwiGLU<false> E{H, DFF, nullptr};
        pg8::gemm_phase<pg8::EpiSwiGLU<false>, pg8::StaticOrder, true, true>(lds, g, S, E);
    }
    SEAM(1);
    if (IN(2)) {
        pg8::Gemm g{H, (const bf16*)(ws + WS_W1D), MP, DM, DFF, DFF}; pg8::StaticOrder S; S.init(MP, DM, G, (int)blockIdx.x);
        pg8::EpiRes E{a.in[I_XP], nullptr, 0.5f, XW, a.in[I_NMW], ss2, nullptr, nullptr, nullptr};
        pg8::gemm_phase<pg8::EpiRes, pg8::StaticOrder, true, true>(lds, g, S, E);
        if (!(a.flags & 4)) small_gemm(lds, H + (size_t)MP * DFF, DFF, (const bf16*)(ws + WS_W1D), DFF, a.in[I_XS], nullptr, 0.5f, XW + (size_t)MP * DM, a.in[I_NMW], ss2 + MP);
    }
    SEAM(2);
    if (IN(3)) {
        pg8::Gemm g{XW, (const bf16*)(ws + WS_WIN), MPAD, NINP, DM, DM}; pg8::StaticOrder S; S.init(MPAD, NINP, G, (int)blockIdx.x);
        pg8::EpiProj E{PROJ, LDPJ, ss2, dtbuf, LDPJ / 256, a.flags & 8, PC_SCC / 256};
        pg8::gemm_phase<pg8::EpiProj, pg8::StaticOrder, true, true>(lds, g, S, E);
    }
    SEAM(3);
    if (IN(4)) { bc_conv_prepass(a, gw, NGW, lane); p5_fix(a, gw, NGW, lane); p0_late_weights(a, lds, gw, NGW, wave, lane); }
    SEAM(4);
    if (IN(5)) {
        if (!(a.flags & 2)) for (int u = blockIdx.x; u < NBATCH * 32; u += G) ssd_prompt(a, lds, (G == NBATCH * 32) ? ((u & 7) * 32 + (u >> 3)) : u);
        if (!(a.flags & 1)) for (int wu = gw; wu < NS * 16; wu += NGW) ssd_sample(a, (LAS float*)(lds + wave * SMP_SCR), wu, lane);
    }
    do { if (IN(5) && IN(7)) xcd_barrier(bar); } while (0);
    if (IN(7)) {
        pg8::Gemm g{PROJ, (const bf16*)(ws + WS_WOUT), MP, DM, DMIX, LDPJ}; pg8::StaticOrder S; S.init(MP, DM, G, (int)blockIdx.x);
        pg8::EpiResT<true> E{nullptr, nullptr, 1.0f, XW, a.in[I_N2W], ss3, (const float*)(ws + WS_SSGP), XW, a.in[I_NMW]};
        pg8::gemm_phase<pg8::EpiResT<true>, pg8::StaticOrder, true, true>(lds, g, S, E);
        if (!(a.flags & 4)) small_gemm(lds, PROJ + (size_t)MP * LDPJ, LDPJ, (const bf16*)(ws + WS_WOUT), DMIX, nullptr, nullptr, 1.0f, XW + (size_t)MP * DM, a.in[I_N2W], ss3 + MP, (const float*)(ws + WS_SSGP) + (size_t)MP * 2 * 16, XW + (size_t)MP * DM, a.in[I_NMW]);
    }
    SEAM(7);
    if (IN(8)) {
        pg8::Gemm g{XW, (const bf16*)(ws + WS_W2GU), MPAD, NGU, DM, DM}; pg8::StaticOrder S; S.init(MPAD, NGU, G, (int)blockIdx.x);
        pg8::EpiSwiGLU<true> E{H, DFF, ss3};
        pg8::gemm_phase<pg8::EpiSwiGLU<true>, pg8::StaticOrder, true, true>(lds, g, S, E);
    }
    SEAM(8);
    if (IN(9)) {
        pg8::Gemm g{H, (const bf16*)(ws + WS_W2D), MP, DM, DFF, DFF}; pg8::StaticOrder S; S.init(MP, DM, G, (int)blockIdx.x);
        pg8::EpiRes E{nullptr, nullptr, 0.5f, XW, nullptr, nullptr, nullptr, XW, a.in[I_N2W]};
        pg8::gemm_phase<pg8::EpiRes, pg8::StaticOrder, true, true>(lds, g, S, E);
        if (!(a.flags & 4)) small_gemm(lds, H + (size_t)MP * DFF, DFF, (const bf16*)(ws + WS_W2D), DFF, nullptr, nullptr, 0.5f, XW + (size_t)MP * DM, nullptr, nullptr, nullptr, XW + (size_t)MP * DM, a.in[I_N2W]);
    }
    SEAM(9);
    if (IN(10)) {
        const f32x4* wr = (const f32x4*)a.in[I_FNW] + lane;
        f32x4 w4[4];
#pragma unroll
        for (int j = 0; j < 4; ++j) w4[j] = wr[64 * j];
        for (int m = gw; m < MT; m += 2 * NGW) { const int m2 = m + NGW; const bool two = m2 < MT;
            const unsigned long long* xb = (const unsigned long long*)(XW + (size_t)m * DM) + lane; const unsigned long long* xb2 = (const unsigned long long*)(XW + (size_t)(two ? m2 : m) * DM) + lane;
            f32x4* xr = (f32x4*)(xres + (size_t)m * DM) + lane; f32x4* xr2 = (f32x4*)(xres + (size_t)(two ? m2 : m) * DM) + lane; unsigned long long r[4], r2[4]; f32x4 v[4], v2[4]; float s = 0.f, s2 = 0.f;
#pragma unroll
            for (int j = 0; j < 4; ++j) { r[j] = __builtin_nontemporal_load(xb + 64 * j); r2[j] = __builtin_nontemporal_load(xb2 + 64 * j); }
#pragma unroll
            for (int j = 0; j < 4; ++j) { const unsigned lo = (unsigned)r[j], hi = (unsigned)(r[j] >> 32), lo2 = (unsigned)r2[j], hi2 = (unsigned)(r2[j] >> 32);
                v[j] = (f32x4){__uint_as_float(lo << 16), __uint_as_float(lo & 0xffff0000u), __uint_as_float(hi << 16), __uint_as_float(hi & 0xffff0000u)};
                v2[j] = (f32x4){__uint_as_float(lo2 << 16), __uint_as_float(lo2 & 0xffff0000u), __uint_as_float(hi2 << 16), __uint_as_float(hi2 & 0xffff0000u)}; }
#pragma unroll
            for (int j = 0; j < 4; ++j) { s += (v[j].x * v[j].x + v[j].y * v[j].y) + (v[j].z * v[j].z + v[j].w * v[j].w); s2 += (v2[j].x * v2[j].x + v2[j].y * v2[j].y) + (v2[j].z * v2[j].z + v2[j].w * v2[j].w); }
            const float rstd = rsqrtf(wave_sum(s) * (1.f / DM) + EPS), rstd2 = rsqrtf(wave_sum(s2) * (1.f / DM) + EPS);
#pragma unroll
            for (int j = 0; j < 4; ++j) __builtin_nontemporal_store(v[j] * rstd * w4[j], xr + 64 * j);
            if (two) {
#pragma unroll
                for (int j = 0; j < 4; ++j) __builtin_nontemporal_store(v2[j] * rstd2 * w4[j], xr2 + 64 * j); } }
    }
#ifdef EXTRA_SYNCS
    for (int i = 0; i < EXTRA_SYNCS; ++i) grid.sync();
#endif
#undef IN
#undef SEAM
}

extern "C" void kernel_launch(void* const* d_in, const int* in_sizes, int n_in, void* d_out, int out_size, void* d_ws, size_t ws_size, hipStream_t stream) {
    static int grid = 0;
    if (grid == 0) {
        if (n_in != 24 || (size_t)out_size != O_END || ws_size < WS_END3) { fprintf(stderr, "kernel_launch: unexpected sizes: n_in %d out %d (want %zu) ws %zu (need %zu)\n", n_in, out_size, (size_t)O_END, ws_size, (size_t)WS_END3); grid = -1; return; }
        int dev = 0, cus = 0, per_cu = 0;
        hipGetDevice(&dev); hipDeviceGetAttribute(&cus, hipDeviceAttributeMultiprocessorCount, dev);
        if (hipFuncSetAttribute((const void*)hymba_fwd, hipFuncAttributeMaxDynamicSharedMemorySize, LDS_BYTES) != hipSuccess) { fprintf(stderr, "kernel_launch: hipFuncSetAttribute failed\n"); grid = -1; return; }
        if (hipOccupancyMaxActiveBlocksPerMultiprocessor(&per_cu, (const void*)hymba_fwd, NTHR, LDS_BYTES) != hipSuccess || per_cu < 1) { fprintf(stderr, "kernel_launch: occupancy query says %d blocks per CU\n", per_cu); grid = -1; (void)hipGetLastError(); return; }
        grid = cus * per_cu;
    }
    if (grid < 0) return;
    if (hipMemsetAsync((unsigned char*)d_ws + WS_BAR, 0, 16384, stream) != hipSuccess) { fprintf(stderr, "kernel_launch: memset of the barrier words failed\n"); return; }
    Args a{};
    for (int i = 0; i < 24; ++i) a.in[i] = (const float*)d_in[i];
    a.out = (float*)d_out; a.ws = (unsigned char*)d_ws; a.ph_lo = 0; a.ph_hi = 11;
    void* args[] = {&a};
#ifndef PRE_PASS
#define PRE_PASS 0
#endif
#ifndef PRE_FLAGS
#define PRE_FLAGS 0
#endif
    if (PRE_PASS > 0) {
        a.ph_hi = PRE_PASS; a.flags = PRE_FLAGS; (void)hipLaunchCooperativeKernel((const void*)hymba_fwd, dim3(grid), dim3(NTHR), args, LDS_BYTES, stream); a.ph_hi = 11; a.flags = 0; (void)hipMemsetAsync((unsigned char*)d_ws + WS_BAR, 0, 16384, stream); }
    hipError_t e = hipLaunchCooperativeKernel((const void*)hymba_fwd, dim3(grid), dim3(NTHR), args, LDS_BYTES, stream);
    if (e != hipSuccess) fprintf(stderr, "kernel_launch: cooperative launch failed: %s (grid %d)\n", hipGetErrorString(e), grid);
}
```

```cpp
#include <hip/hip_runtime.h>
#include <hip/hip_cooperative_groups.h>
#include <cstdio>
#include <cstdint>
namespace cg = cooperative_groups;
namespace pg8 {
#define PG8_LAS __attribute__((address_space(3)))
typedef unsigned short bf16_t;
typedef short bf16x8 __attribute__((ext_vector_type(8)));
typedef float f32x4 __attribute__((ext_vector_type(4)));
typedef unsigned u32x4 __attribute__((ext_vector_type(4)));
constexpr int BM = 256, BK = 64, HALF = 128, HTB = HALF * BK * 2  , STAGE_BYTES = 8 * HTB, NXCD = 8, WGM = 8;

__host__ __device__ __forceinline__ int lds_byte(int r, int c) { const int st = (r >> 4) * 2 + (c >> 5), rr = r & 15, cc = c & 31, ob = rr * 64 + cc * 2; return st * 1024 + (ob ^ (((ob >> 9) & 1) << 5)); }
__host__ __device__ __forceinline__ void stage_rc(int b, int& R, int& C) { const int st = b / 1024, sb = b % 1024, swz = sb ^ (((sb >> 9) & 1) << 5); R = (st >> 1) * 16 + swz / 64; C = (st & 1) * 32 + (swz % 64) / 2; }
__host__ __device__ __forceinline__ int perm32(int rho) { const int n = rho >> 4, i = rho & 15; return 8 * (i >> 2) + 4 * n + (i & 3); }

struct Unit { int pm, pn; };
struct Gemm { const bf16_t* A; const bf16_t* Bt; int M, N, K, lda; };

struct StaticOrder {
    int nM, nN, nwg, G, c;
    __host__ __device__ void init(int M, int N, int G_, int c_) { nM = M / BM; nN = N / BM; nwg = nM * nN; G = G_; c = c_; }
    __host__ __device__ bool next(int i, Unit& u) const {
        const long L = (long)i * G + c; if (L >= nwg) return false;
        int wgid = (int)L; { const int q = nwg / NXCD, r = nwg % NXCD, xcd = wgid % NXCD, off = wgid / NXCD; wgid = (xcd < r ? xcd * (q + 1) : r * (q + 1) + (xcd - r) * q) + off; }
        const int nig = WGM * nN, gid = wgid / nig, fm = gid * WGM, gsz = (nM - fm) < WGM ? (nM - fm) : WGM;
        u.pm = fm + ((wgid % nig) % gsz); u.pn = (wgid % nig) / gsz; return true;
    }
    __device__ __forceinline__ void a_ready(const Unit&) const {}
    __device__ __forceinline__ void done(const Unit&) const {}
};


__device__ __forceinline__ unsigned cvt_pk_bf16(float lo, float hi) { unsigned r; asm volatile("v_cvt_pk_bf16_f32 %0, %1, %2" : "=v"(r) : "v"(lo), "v"(hi)); return r; }
__device__ __forceinline__ float silu_f(float v) { return v * __builtin_amdgcn_rcpf(1.0f + __expf(-v)); }
typedef unsigned u32x2 __attribute__((ext_vector_type(2)));

typedef float f32x2 __attribute__((ext_vector_type(2)));
__device__ __forceinline__ f32x2 swiglu_pk(f32x2 g, f32x2 u) {
    const f32x2 t = g * (-1.44269504f); f32x2 e; e.x = __builtin_amdgcn_exp2f(t.x); e.y = __builtin_amdgcn_exp2f(t.y);
    const f32x2 d = e + 1.0f; f32x2 r; r.x = __builtin_amdgcn_rcpf(d.x); r.y = __builtin_amdgcn_rcpf(d.y);
    return (g * u) * r;
}
template <bool SCALE> struct EpiSwiGLU {
    static constexpr bool PERM = true, AFTER_DRAIN = false, KSCALE = false;
    bf16_t* H; int ldh; const float* ss;
    __device__ __forceinline__ void prefetch(const Unit& u, int wr, int fr, float (&rsv)[8]) const {
        const int row0 = u.pm * BM + wr * 64 + fr;
#pragma unroll
        for (int q = 0; q < 8; ++q) rsv[q] = SCALE ? ss[row0 + (q >> 2) * HALF + (q & 3) * 16] : 0.f;
    }
    __device__ __forceinline__ void operator()(const f32x4 (&acc)[2][2][4][2], const Unit& u, int wr, int wc, int fr, int fq, const float (&rsv)[8]) const {
        const int row0 = u.pm * BM + wr * 64 + fr, col0 = u.pn * HALF + wc * 32 + 8 * fq;
#pragma unroll
        for (int ai = 0; ai < 2; ++ai)
#pragma unroll
            for (int m = 0; m < 4; ++m) {
                const int row = row0 + ai * HALF + m * 16;
                f32x4 g0 = acc[ai][0][m][0], g1 = acc[ai][0][m][1], u0 = acc[ai][1][m][0], u1 = acc[ai][1][m][1];
                if (SCALE) { const float rs = rsqrtf(rsv[ai * 4 + m] * (1.0f / 1024.0f) + 1e-6f); g0 = g0 * rs; g1 = g1 * rs; u0 = u0 * rs; u1 = u1 * rs; }
                const f32x2 h0 = swiglu_pk((f32x2){g0[0], g0[1]}, (f32x2){u0[0], u0[1]}), h1 = swiglu_pk((f32x2){g0[2], g0[3]}, (f32x2){u0[2], u0[3]}),
                            h2 = swiglu_pk((f32x2){g1[0], g1[1]}, (f32x2){u1[0], u1[1]}), h3 = swiglu_pk((f32x2){g1[2], g1[3]}, (f32x2){u1[2], u1[3]});
                u32x4 w; w.x = cvt_pk_bf16(h0.x, h0.y); w.y = cvt_pk_bf16(h1.x, h1.y); w.z = cvt_pk_bf16(h2.x, h2.y); w.w = cvt_pk_bf16(h3.x, h3.y);
                *(u32x4*)(H + (size_t)row * ldh + col0) = w;
            }
    }
};
struct EpiProj {
    static constexpr bool PERM = true, AFTER_DRAIN = false, KSCALE = false;
    bf16_t* P; int ldp; const float* ss; float* dtb; int npn; int skip; int pn_u0;
    __device__ __forceinline__ void prefetch(const Unit& u, int wr, int fr, float (&rsv)[8]) const {
        const int row0 = u.pm * BM + wr * 64 + fr;
#pragma unroll
        for (int q = 0; q < 8; ++q) rsv[q] = ss[row0 + (q >> 2) * HALF + (q & 3) * 16];
    }
    __device__ __forceinline__ void operator()(const f32x4 (&acc)[2][2][4][2], const Unit& u, int wr, int wc, int fr, int fq, const float (&rsv)[8]) const {
        if (skip) return;
        const int row0 = u.pm * BM + wr * 64 + fr, col0 = u.pn * BM + wc * 32 + 8 * fq;
#pragma unroll
        for (int ai = 0; ai < 2; ++ai)
#pragma unroll
            for (int m = 0; m < 4; ++m) {
                const int row = row0 + ai * HALF + m * 16;
                const float rs = rsqrtf(rsv[ai * 4 + m] * (1.0f / 1024.0f) + 1e-6f);
                if (u.pn >= pn_u0 && u.pn < npn) {
                    const f32x4 c0 = acc[ai][0][m][0] * rs, c1 = acc[ai][0][m][1] * rs, h0 = acc[ai][1][m][0] * rs, h1 = acc[ai][1][m][1] * rs; u32x4 w;
                    w.x = cvt_pk_bf16(c0[0] * h0[0], c0[1] * h0[1]); w.y = cvt_pk_bf16(c0[2] * h0[2], c0[3] * h0[3]); w.z = cvt_pk_bf16(c1[0] * h1[0], c1[1] * h1[1]); w.w = cvt_pk_bf16(c1[2] * h1[2], c1[3] * h1[3]);
                    *(u32x4*)(P + (size_t)row * ldp + pn_u0 * BM + (u.pn - pn_u0) * HALF + wc * 32 + 8 * fq) = w;
                } else if (u.pn < npn) {
#pragma unroll
                    for (int bj = 0; bj < 2; ++bj) { f32x4 v0 = acc[ai][bj][m][0] * rs, v1 = acc[ai][bj][m][1] * rs; u32x4 w;
                        if (u.pn < 4) {
#pragma unroll
                            for (int e = 0; e < 4; ++e) { v0[e] = silu_f(v0[e]); v1[e] = silu_f(v1[e]); } }
                        w.x = cvt_pk_bf16(v0[0], v0[1]); w.y = cvt_pk_bf16(v0[2], v0[3]); w.z = cvt_pk_bf16(v1[0], v1[1]); w.w = cvt_pk_bf16(v1[2], v1[3]);
                        *(u32x4*)(P + (size_t)row * ldp + col0 + bj * HALF) = w; }
                } else if (wc == 0 && fq < 2) {
                    *(f32x4*)(dtb + (size_t)row * 16 + 8 * fq) = acc[ai][0][m][0] * rs; *(f32x4*)(dtb + (size_t)row * 16 + 8 * fq + 4) = acc[ai][0][m][1] * rs;
                }
            }
    }
};
template <bool KS> struct EpiResT {
    static constexpr bool PERM = false, AFTER_DRAIN = false, KSCALE = KS;
    const float* base; float* out; float scale; bf16_t* xw; const float* wn; float* ss; const float* ssgp; const bf16_t* bbase; const float* bw;
    __device__ __forceinline__ void unit_begin(const Unit& u, PG8_LAS unsigned char* lds) const {
        PG8_LAS float* R = (PG8_LAS float*)(lds + STAGE_BYTES); const int t = threadIdx.x, row = t >> 1, g = t & 1;
        const f32x4* pp = (const f32x4*)(ssgp + ((size_t)(u.pm * BM + row) * 2 + g) * 16); const f32x4 q4 = (pp[0] + pp[1]) + (pp[2] + pp[3]);
        R[row * 2 + g] = rsqrtf(((q4[0] + q4[1]) + (q4[2] + q4[3])) * (1.0f / 512.0f) + 1e-6f);
    }
    __device__ __forceinline__ void kscale(int t, f32x4 (&acc)[2][2][4][2], int wr, int fr, PG8_LAS unsigned char* lds) const {
        const PG8_LAS float* R = (const PG8_LAS float*)(lds + STAGE_BYTES);
#pragma unroll
        for (int ai = 0; ai < 2; ++ai)
#pragma unroll
            for (int m = 0; m < 4; ++m) { const int r = ai * HALF + wr * 64 + m * 16 + fr; const float r0 = R[r * 2], r1 = R[r * 2 + 1]; const float f = (t == 8) ? r0 * __builtin_amdgcn_rcpf(r1) : r1;
#pragma unroll
                for (int bj = 0; bj < 2; ++bj)
#pragma unroll
                    for (int n = 0; n < 2; ++n) acc[ai][bj][m][n] = acc[ai][bj][m][n] * f; }
    }
    __device__ __forceinline__ void prefetch(const Unit&, int, int, float (&rsv)[8]) const {
#pragma unroll
        for (int q = 0; q < 8; ++q) rsv[q] = 0.f;
    }
    __device__ __forceinline__ void operator()(const f32x4 (&acc)[2][2][4][2], const Unit& u, int wr, int wc, int fr, int fq, const float (&)[8]) const {
        const int row0 = u.pm * BM + wr * 64 + fr, col0 = u.pn * BM + wc * 32 + 4 * fq;
        f32x4 w4[2][2];
#pragma unroll
        for (int bj = 0; bj < 2; ++bj)
#pragma unroll
            for (int n = 0; n < 2; ++n) w4[bj][n] = (xw && wn) ? *(const f32x4*)(wn + col0 + bj * HALF + n * 16) : (f32x4){1.f, 1.f, 1.f, 1.f};
        f32x4 winv[2][2];
#pragma unroll
        for (int bj = 0; bj < 2; ++bj)
#pragma unroll
            for (int n = 0; n < 2; ++n) { f32x4 t_ = {1.f, 1.f, 1.f, 1.f}; if (bbase) { const f32x4 q_ = *(const f32x4*)(bw + col0 + bj * HALF + n * 16); t_ = (f32x4){1.f / q_[0], 1.f / q_[1], 1.f / q_[2], 1.f / q_[3]}; } winv[bj][n] = t_; }
#pragma unroll
        for (int ai = 0; ai < 2; ++ai)
#pragma unroll
        for (int mh = 0; mh < 2; ++mh) {
            f32x4 bv[2][2][2];
#pragma unroll
            for (int mm = 0; mm < 2; ++mm)
#pragma unroll
                for (int bj = 0; bj < 2; ++bj)
#pragma unroll
                    for (int n = 0; n < 2; ++n) { const size_t o_ = (size_t)(row0 + ai * HALF + (2 * mh + mm) * 16) * 1024 + col0 + bj * HALF + n * 16;
                        if (bbase) { const u32x2 r_ = *(const u32x2*)(bbase + o_); bv[mm][bj][n] = (f32x4){__uint_as_float(r_.x << 16), __uint_as_float(r_.x & 0xffff0000u), __uint_as_float(r_.y << 16), __uint_as_float(r_.y & 0xffff0000u)} * winv[bj][n]; }
                        else bv[mm][bj][n] = *(const f32x4*)(base + o_); }
#pragma unroll
            for (int mm = 0; mm < 2; ++mm) {
                const int m = 2 * mh + mm, row = row0 + ai * HALF + m * 16; float s = 0.f;
#pragma unroll
                for (int bj = 0; bj < 2; ++bj)
#pragma unroll
                    for (int n = 0; n < 2; ++n) { const int col = col0 + bj * HALF + n * 16; const size_t off = (size_t)row * 1024 + col;
                        const f32x4 v = bv[mm][bj][n] + acc[ai][bj][m][n] * scale; if (out) *(f32x4*)(out + off) = v;
                        s += (v[0] * v[0] + v[1] * v[1]) + (v[2] * v[2] + v[3] * v[3]);
                        if (xw) { const f32x4 ww = w4[bj][n]; u32x2 p; p.x = cvt_pk_bf16(v[0] * ww[0], v[1] * ww[1]); p.y = cvt_pk_bf16(v[2] * ww[2], v[3] * ww[3]); *(u32x2*)(xw + off) = p; } }
                if (ss) { s += __shfl_xor(s, 16); s += __shfl_xor(s, 32); if (fq == 0) atomicAdd(ss + row, s); }
            }
        }
    }
};
typedef EpiResT<false> EpiRes;

template <class Epi, class Sched, bool ALIGN_EPI = false, bool SP2 = false>
__device__ __forceinline__ void gemm_phase(PG8_LAS unsigned char* lds, const Gemm g, const Sched& S, const Epi& E) {
    const int tid = threadIdx.x, wid = __builtin_amdgcn_readfirstlane(tid >> 6), lane = tid & 63, wr = wid >> 2, wc = wid & 3, fr = lane & 15, fq = lane >> 4;
    const int K = g.K, nt = K / BK;
    unsigned voffA[2], voffB[2];
#pragma unroll
    for (int i = 0; i < 2; ++i) { int R, C; stage_rc(tid * 16 + i * 8192, R, C); const int Rb = Epi::PERM ? ((R & ~31) + perm32(R & 31)) : R;
        voffA[i] = (unsigned)(R * g.lda + C) * 2u; voffB[i] = (unsigned)(Rb * K + C) * 2u; }
    const size_t kstep = (size_t)(BK * 2);
    const size_t hstepA = (size_t)HALF * g.lda * 2, hstepB = (size_t)HALF * K * 2;
    const size_t tstepA = 2 * hstepA, tstepB = 2 * hstepB;
    const unsigned ldsw = (unsigned)wid * 1024u;
    const int aoff = lds_byte(wr * 64 + fr, fq * 8), boff = lds_byte(wc * 32 + fr, fq * 8);
#define PG8_SA(b, h) (((b) * 2 + (h)) * HTB)
#define PG8_SB(b, h) ((4 + (b) * 2 + (h)) * HTB)
#define PG8_STAGE(bufoff, gbase, voff) do { _Pragma("unroll") for (int _i = 0; _i < 2; ++_i) \
        __builtin_amdgcn_global_load_lds((const unsigned*)((const char*)(gbase) + (voff)[_i]), (PG8_LAS unsigned*)(lds + (bufoff) + ldsw + _i * 8192), 16, 0, 0); } while (0)
#define PG8_LDA(dst, b, h) do { _Pragma("unroll") for (int m = 0; m < 4; ++m) _Pragma("unroll") for (int k = 0; k < 2; ++k) dst[m][k] = *(const PG8_LAS bf16x8*)(lds + PG8_SA(b, h) + aoff + m * 2048 + k * 1024); } while (0)
#define PG8_LDB(dst, b, h) do { _Pragma("unroll") for (int n = 0; n < 2; ++n) _Pragma("unroll") for (int k = 0; k < 2; ++k) dst[n][k] = *(const PG8_LAS bf16x8*)(lds + PG8_SB(b, h) + boff + n * 2048 + k * 1024); } while (0)
#define PG8_MMA(ai, bj, At, Bt) do { __builtin_amdgcn_s_setprio(1); _Pragma("unroll") for (int m = 0; m < 4; ++m) _Pragma("unroll") for (int n = 0; n < 2; ++n) _Pragma("unroll") for (int k = 0; k < 2; ++k) \
        acc[ai][bj][m][n] = __builtin_amdgcn_mfma_f32_16x16x32_bf16(Bt[n][k], At[m][k], acc[ai][bj][m][n], 0, 0, 0); __builtin_amdgcn_s_setprio(0); } while (0)
#define PG8_WAIT_V(n) asm volatile("s_waitcnt vmcnt(" #n ")" ::: "memory")
#define PG8_WAIT_L(n) asm volatile("s_waitcnt lgkmcnt(" #n ")" ::: "memory")
#define PG8_BAR __builtin_amdgcn_s_barrier()
#define PG8_SCHED __builtin_amdgcn_sched_barrier(0)
    Unit cur, nxt; int ui = 0;
    if (!S.next(0, cur)) return;
    f32x4 acc[2][2][4][2];
#pragma unroll
    for (int a = 0; a < 2; ++a)
#pragma unroll
        for (int b = 0; b < 2; ++b)
#pragma unroll
            for (int m = 0; m < 4; ++m)
#pragma unroll
                for (int n = 0; n < 2; ++n) acc[a][b][m][n] = (f32x4){0.f, 0.f, 0.f, 0.f};
    bf16x8 At[4][2], B0[2][2], B1[2][2];
    const char* cA = (const char*)g.A + (size_t)cur.pm * tstepA; const char* cB = (const char*)g.Bt + (size_t)cur.pn * tstepB;
    S.a_ready(cur);
    if constexpr (SP2) {
        PG8_STAGE(PG8_SB(0, 0), cB, voffB); PG8_STAGE(PG8_SB(0, 1), cB + hstepB, voffB); PG8_STAGE(PG8_SA(0, 0), cA, voffA); PG8_STAGE(PG8_SA(0, 1), cA + hstepA, voffA);
        if (wr == 1) PG8_BAR;
        PG8_WAIT_V(2); PG8_BAR;
        PG8_STAGE(PG8_SB(1, 0), cB + kstep, voffB); PG8_STAGE(PG8_SA(1, 0), cA + kstep, voffA); PG8_STAGE(PG8_SB(1, 1), cB + hstepB + kstep, voffB);
        PG8_WAIT_V(6); PG8_BAR;
    } else {
        PG8_STAGE(PG8_SB(0, 0), cB, voffB); PG8_STAGE(PG8_SA(0, 0), cA, voffA); PG8_STAGE(PG8_SB(0, 1), cB + hstepB, voffB); PG8_STAGE(PG8_SA(0, 1), cA + hstepA, voffA);
        if (wr == 1) PG8_BAR;
        PG8_WAIT_V(4); PG8_BAR;
        PG8_STAGE(PG8_SB(1, 0), cB + kstep, voffB); PG8_STAGE(PG8_SA(1, 0), cA + kstep, voffA); PG8_STAGE(PG8_SB(1, 1), cB + hstepB + kstep, voffB);
        PG8_WAIT_V(6); PG8_BAR;
    }
    for (;;) {
        const bool has_next = S.next(ui + 1, nxt);
        const char* nA = has_next ? (const char*)g.A + (size_t)nxt.pm * tstepA : cA; const char* nB = has_next ? (const char*)g.Bt + (size_t)nxt.pn * tstepB : cB;
        float rsv[8]; E.prefetch(cur, wr, fr, rsv);
        if constexpr (Epi::KSCALE) E.unit_begin(cur, lds);
        for (int t = 0; t < nt; t += 2) {
            if constexpr (Epi::KSCALE) { if (t == 8 || t == 16) E.kscale(t, acc, wr, fr, lds); }
            const bool last = (t == nt - 2);
            const char* a1 = cA + (size_t)(t + 1) * kstep;
            const char* a2 = last ? nA : cA + (size_t)(t + 2) * kstep; const char* b2 = last ? nB : cB + (size_t)(t + 2) * kstep;
            const char* a3 = a2 + kstep; const char* b3 = b2 + kstep;
            if (last && has_next) S.a_ready(nxt);
            if constexpr (SP2) {
            PG8_LDB(B0, 0, 0); PG8_LDB(B1, 0, 1); PG8_SCHED; PG8_LDA(At, 0, 0); PG8_STAGE(PG8_SA(1, 1), a1 + hstepA, voffA);
            PG8_WAIT_V(8); PG8_WAIT_L(0); PG8_BAR; PG8_MMA(0, 0, At, B0); PG8_MMA(0, 1, At, B1); PG8_BAR; PG8_SCHED;
            PG8_LDA(At, 0, 1); PG8_STAGE(PG8_SB(0, 0), b2, voffB); PG8_STAGE(PG8_SB(0, 1), b2 + hstepB, voffB); PG8_STAGE(PG8_SA(0, 0), a2, voffA);
            PG8_WAIT_V(8); PG8_WAIT_L(0); PG8_BAR; PG8_MMA(1, 0, At, B0); PG8_MMA(1, 1, At, B1); PG8_BAR; PG8_SCHED;
            PG8_LDB(B0, 1, 0); PG8_LDB(B1, 1, 1); PG8_SCHED; PG8_LDA(At, 1, 0); PG8_STAGE(PG8_SA(0, 1), a2 + hstepA, voffA);
            PG8_WAIT_V(8); PG8_WAIT_L(0); PG8_BAR; PG8_MMA(0, 0, At, B0); PG8_MMA(0, 1, At, B1); PG8_BAR; PG8_SCHED;
            PG8_LDA(At, 1, 1); PG8_STAGE(PG8_SB(1, 0), b3, voffB); PG8_STAGE(PG8_SB(1, 1), b3 + hstepB, voffB); PG8_STAGE(PG8_SA(1, 0), a3, voffA);
            PG8_WAIT_V(8); PG8_WAIT_L(0); PG8_BAR; PG8_MMA(1, 0, At, B0); PG8_MMA(1, 1, At, B1); PG8_BAR; PG8_SCHED;
            } else {
            PG8_LDB(B0, 0, 0); PG8_SCHED; PG8_LDA(At, 0, 0); PG8_STAGE(PG8_SA(1, 1), a1 + hstepA, voffA);
            PG8_WAIT_L(8); PG8_BAR; PG8_WAIT_L(0); PG8_MMA(0, 0, At, B0); PG8_BAR; PG8_SCHED;
            PG8_LDB(B1, 0, 1); PG8_STAGE(PG8_SB(0, 0), b2, voffB);
            PG8_BAR; PG8_WAIT_L(0); PG8_MMA(0, 1, At, B1); PG8_BAR;
            PG8_LDA(At, 0, 1); PG8_STAGE(PG8_SA(0, 0), a2, voffA);
            PG8_BAR; PG8_WAIT_L(0); PG8_MMA(1, 0, At, B0); PG8_BAR; PG8_SCHED;
            PG8_STAGE(PG8_SB(0, 1), b2 + hstepB, voffB);
            PG8_WAIT_V(6); PG8_BAR; PG8_MMA(1, 1, At, B1); PG8_BAR;
            PG8_LDB(B0, 1, 0); PG8_SCHED; PG8_LDA(At, 1, 0); PG8_STAGE(PG8_SA(0, 1), a2 + hstepA, voffA);
            PG8_WAIT_L(8); PG8_BAR; PG8_WAIT_L(0); PG8_MMA(0, 0, At, B0); PG8_BAR; PG8_SCHED;
            PG8_LDB(B1, 1, 1); PG8_STAGE(PG8_SB(1, 0), b3, voffB);
            PG8_BAR; PG8_WAIT_L(0); PG8_MMA(0, 1, At, B1); PG8_BAR;
            PG8_LDA(At, 1, 1); PG8_STAGE(PG8_SA(1, 0), a3, voffA);
            PG8_BAR; PG8_WAIT_L(0); PG8_MMA(1, 0, At, B0); PG8_BAR; PG8_SCHED;
            PG8_STAGE(PG8_SB(1, 1), b3 + hstepB, voffB);
            PG8_WAIT_V(6); PG8_BAR; PG8_MMA(1, 1, At, B1); PG8_BAR;
            }
        }
        if constexpr (ALIGN_EPI) { if (wr == 0) PG8_BAR; }
        if constexpr (!Epi::AFTER_DRAIN) { E(acc, cur, wr, wc, fr, fq, rsv); S.done(cur); }
        if (!has_next) break;
#pragma unroll
        for (int a = 0; a < 2; ++a)
#pragma unroll
            for (int b = 0; b < 2; ++b)
#pragma unroll
                for (int m = 0; m < 4; ++m)
#pragma unroll
                    for (int n = 0; n < 2; ++n) acc[a][b][m][n] = (f32x4){0.f, 0.f, 0.f, 0.f};
        cur = nxt; cA = nA; cB = nB; ++ui;
        if constexpr (ALIGN_EPI) { if (wr == 1) PG8_BAR; }
    }
    PG8_WAIT_V(0);
    if constexpr (!ALIGN_EPI) { if (wr == 0) PG8_BAR; }
    PG8_BAR;
    if constexpr (Epi::AFTER_DRAIN) { E.fused(acc, cur, wr, wc, fr, fq, lds, wid, lane); S.done(cur); }
#undef PG8_SA
#undef PG8_SB
#undef PG8_STAGE
#undef PG8_LDA
#undef PG8_LDB
#undef PG8_MMA
#undef PG8_WAIT_V
#undef PG8_WAIT_L
#undef PG8_BAR
#undef PG8_SCHED
}
}
#define LAS __attribute__((address_space(3)))
typedef unsigned short bf16;
typedef short bf16x8 __attribute__((ext_vector_type(8)));
typedef float f32x4 __attribute__((ext_vector_type(4)));
typedef float f32x16 __attribute__((ext_vector_type(16)));
typedef unsigned v4u __attribute__((ext_vector_type(4)));
typedef unsigned v2u __attribute__((ext_vector_type(2)));
constexpr int NWAVES = 8, NTHR = 512;
constexpr int DM = 1024, NBATCH = 8, SEQ = 2048, MP = NBATCH * SEQ, NS = 128, MT = MP + NS, MPAD = 16640;
constexpr int DFF = 2816, NGU = 2 * DFF, DMIX = 2048, NINP = 5888, LDPJ = 5632, DINP = 5648, CONVD = 1536;
constexpr int PC_Z = 0, PC_SCB = 1024, PC_XBC = 2048, PC_SCC = 3584, PC_SCH = 4608;
constexpr float EPS = 1e-6f;
constexpr size_t MiB = 1u << 20;
constexpr size_t WS_W2GU = 0, WS_W2D = 11 * MiB, WS_WOUT = WS_W2D + 5632 * 1024, WS_WIN = WS_WOUT + 4 * MiB, WS_XW = 32 * MiB;
constexpr size_t WS_SMALL = WS_XW + (size_t)MPAD * DM * 2;
constexpr size_t SM_SS2 = 0, SM_SS3 = 128 * 1024, SM_SSG = 256 * 1024, SM_DT = 512 * 1024;
constexpr size_t WS_PROJ = WS_SMALL + 2 * MiB;
constexpr size_t WS_W1GU = WS_PROJ, WS_W1D = WS_W1GU + 11 * MiB, WS_H = WS_W1D + 5632 * 1024;
constexpr size_t WS_END = WS_PROJ + (size_t)MPAD * LDPJ * 2;
constexpr size_t WS_BAR = WS_END, WS_SSGP = WS_BAR + 64 * 1024, WS_END2 = WS_SSGP + (size_t)MPAD * 2 * 16 * 4;
constexpr size_t WS_BCB = WS_WIN, WS_BCC = WS_END2, WS_END3 = WS_BCC + (size_t)MP * 256 * 2;
constexpr long BC_CDELTA = (long)((WS_BCC - WS_BCB) / 2);
static_assert(WS_END3 <= 256 * MiB && (size_t)MP * 256 * 2 <= (size_t)NINP * DM * 2, "d_ws map 2");
static_assert(WS_WIN + (size_t)NINP * DM * 2 <= WS_XW && WS_H + (size_t)MPAD * DFF * 2 <= WS_END && SM_DT + (size_t)MPAD * 16 * 4 <= 2 * MiB && WS_END <= 256 * MiB, "d_ws map");
constexpr size_t O_Y = 0, O_SSMP = (size_t)MT * DM, O_CONVP = O_SSMP + (size_t)NBATCH * 16 * 64 * 128, O_SCP = O_CONVP + (size_t)NBATCH * 3 * CONVD,
                 O_SSMS = O_SCP + (size_t)NBATCH * 2 * 1024, O_CONVS = O_SSMS + (size_t)NS * 16 * 64 * 128, O_SCS = O_CONVS + (size_t)NS * 3 * CONVD, O_END = O_SCS + (size_t)NS * 2 * 1024;
constexpr int LDS_BYTES = 147456;
constexpr int LDP = 136;
constexpr int CL_OFF = 0, BL_OFF = 128 * LDP * 2, BT_OFF = 2 * BL_OFF, XDT_OFF = 3 * BL_OFF, XDD_OFF = XDT_OFF + 32 * LDP * 2, SENT_OFF = XDD_OFF + 32 * LDP * 2,
              XS_OFF = SENT_OFF + 32 * LDP * 2, ACUM_OFF = XS_OFF + 128 * 32 * 2, DTV_OFF = ACUM_OFF + 1024, WBC_OFF = DTV_OFF + 1024, WX_OFF = WBC_OFF + 5 * 256 * 4, SSD_LDS_END = WX_OFF + 5 * 32 * 4;
static_assert(SSD_LDS_END <= LDS_BYTES, "LDS map");

struct Args { const float* in[24]; float* out; unsigned char* ws; int ph_lo, ph_hi, flags, pad; };
enum { I_XP = 0, I_XS, I_SSM, I_SCONV0, I_SSCONV, I_N1W, I_F1G, I_F1U, I_F1D, I_NMW, I_WIN, I_CW, I_CB, I_DTB, I_ALOG, I_DSKIP, I_SNW, I_SCW, I_WOUT, I_N2W, I_F2G, I_F2U, I_F2D, I_FNW };

__device__ __forceinline__ float bf2f(unsigned short b) { return __uint_as_float((unsigned)b << 16); }
__device__ __forceinline__ unsigned pk2(float lo, float hi) { return pg8::cvt_pk_bf16(lo, hi); }
__device__ __forceinline__ unsigned short f2bf1(float f) { return (unsigned short)(pg8::cvt_pk_bf16(f, 0.f) & 0xffffu); }
__device__ __forceinline__ float silu(float v) { return pg8::silu_f(v); }
__device__ __forceinline__ float softplus(float x) { return x > 20.f ? x : log1pf(__expf(x)); }
__device__ __forceinline__ float softplus_fast(float x) { const float e = __expf(x); return x > 20.f ? x : (e < 0.03125f ? e * (1.f + e * (-0.5f + e * (0.33333333f - 0.25f * e))) : __logf(1.f + e)); }
__device__ __forceinline__ float wave_sum(float v) {
#pragma unroll
    for (int o = 1; o < 64; o <<= 1) v += __shfl_xor(v, o);
    return v;
}
__device__ __forceinline__ void unpack8(const v4u r, float (&f)[8]) {
#pragma unroll
    for (int i = 0; i < 4; ++i) { f[2 * i] = __uint_as_float(r[i] << 16); f[2 * i + 1] = __uint_as_float(r[i] & 0xffff0000u); }
}
#define LDS_WAIT() asm volatile("s_waitcnt lgkmcnt(0)" ::: "memory")
#define MFMA32(a, b, c) __builtin_amdgcn_mfma_f32_32x32x16_bf16((a), (b), (c), 0, 0, 0)

__device__ __forceinline__ void p0_item(const float* W, int K, int Nsrc, int src_col0, int nvalid, bf16* WT, int dst_row0, int kb, LAS float* scr, int lane, const float* rscale = nullptr) {
    const int k0 = 64 * kb, nl = lane & 31; const bool ok = nl < nvalid;
#pragma unroll
    for (int i = 0; i < 32; ++i) { const int kk = 2 * i + (lane >> 5); float v = ok ? __builtin_nontemporal_load(W + (size_t)(k0 + kk) * Nsrc + src_col0 + nl) : 0.f;   if (rscale && k0 + kk < 1024) v *= rscale[k0 + kk]; scr[kk * 33 + nl] = v; }
    LDS_WAIT();
    const int c = lane & 7;
#pragma unroll
    for (int j = 0; j < 4; ++j) { const int n = (lane >> 3) + 8 * j; const LAS float* s = scr + (8 * c) * 33 + n;
        v4u o; o.x = pk2(s[0 * 33], s[1 * 33]); o.y = pk2(s[2 * 33], s[3 * 33]); o.z = pk2(s[4 * 33], s[5 * 33]); o.w = pk2(s[6 * 33], s[7 * 33]);
        *(v4u*)(WT + (size_t)(dst_row0 + n) * K + k0 + 8 * c) = o; }
    LDS_WAIT();
}
constexpr int P0_I_GU = 176 * 16, P0_I_D = 32 * 44, P0_I_IN = 184 * 16, P0_I_O = 32 * 32, P0_NITEMS = 2 * P0_I_GU + 2 * P0_I_D + P0_I_IN + P0_I_O;
__device__ __forceinline__ void p0_do_item(const Args& a, int it, LAS float* scr, int lane) {
    unsigned char* ws = a.ws; int r = it;
    if (r < 2 * P0_I_GU) {
        const int which = r >= P0_I_GU; r -= which * P0_I_GU; const int kb = r / 176, nb = r % 176, tile = nb >> 3, sub = nb & 7, bj = sub >> 2, c0 = (sub & 3) * 32;
        const float* W = which ? (bj ? a.in[I_F2U] : a.in[I_F2G]) : (bj ? a.in[I_F1U] : a.in[I_F1G]);
        p0_item(W, DM, DFF, tile * 128 + c0, 32, (bf16*)(ws + (which ? WS_W2GU : WS_W1GU)), nb * 32, kb, scr, lane); return; }
    r -= 2 * P0_I_GU;
    if (r < 2 * P0_I_D) { const int which = r >= P0_I_D; r -= which * P0_I_D; const int kb = r / 32, nb = r % 32;
        p0_item(which ? a.in[I_F2D] : a.in[I_F1D], DFF, DM, nb * 32, 32, (bf16*)(ws + (which ? WS_W2D : WS_W1D)), nb * 32, kb, scr, lane); return; }
    r -= 2 * P0_I_D;
    if (r < P0_I_IN) { const int kb = r / 184, nb = r % 184, n = nb * 32; int src, nv = 32;
        if (n < 1024) src = n; else if (n < 2048) src = 2576 + (n - 1024); else if (n < 3584) src = 1024 + (n - 2048); else if (n < 5632) { const int tl_ = (n - 3584) >> 8, w_ = (n - 3584) & 255; src = w_ < 128 ? 3600 + 128 * tl_ + w_ : 4624 + 128 * tl_ + (w_ - 128); }
        else if (n == 5632) { src = 2560; nv = 16; } else { src = 0; nv = 0; }
        p0_item(a.in[I_WIN], DM, DINP, src, nv, (bf16*)(ws + WS_WIN), n, kb, scr, lane); return; }
    r -= P0_I_IN;
    { const int kb = r / 32, nb = r % 32; p0_item(a.in[I_WOUT], DMIX, DM, nb * 32, 32, (bf16*)(ws + WS_WOUT), nb * 32, kb, scr, lane, a.in[I_SNW]); }
}
__device__ __forceinline__ void p0_late_weights(const Args& a, LAS unsigned char* lds, int gw, int NGW, int wave, int lane) {
    LAS float* scr = (LAS float*)(lds + wave * 16384);
    constexpr int NL = P0_I_GU + P0_I_D + P0_I_O;
    for (int i = gw; i < NL; i += NGW) {
        const int it = i < P0_I_GU ? P0_I_GU + i : (i < P0_I_GU + P0_I_D ? 2 * P0_I_GU + P0_I_D + (i - P0_I_GU) : 2 * P0_I_GU + 2 * P0_I_D + P0_I_IN + (i - P0_I_GU - P0_I_D));
        p0_do_item(a, it, scr, lane); }
}
__device__ __forceinline__ void p0_prologue(const Args& a, LAS unsigned char* lds, int gw, int NGW, int wave, int lane) {
    LAS float* scr = (LAS float*)(lds + wave * 16384);
    unsigned char* ws = a.ws;
    constexpr int NE = P0_I_GU + P0_I_D + P0_I_IN;
    for (int i = gw; i < NE; i += NGW) {
        const int it = i < P0_I_GU ? i : (i < P0_I_GU + P0_I_D ? 2 * P0_I_GU + (i - P0_I_GU) : 2 * P0_I_GU + 2 * P0_I_D + (i - P0_I_GU - P0_I_D));
        p0_do_item(a, it, scr, lane); }
    bf16* XW = (bf16*)(ws + WS_XW);
    for (int m0 = gw; m0 < MPAD; m0 += 2 * NGW) {
        f32x4 v[2][4]; float sq[2] = {0.f, 0.f};
#pragma unroll
        for (int q = 0; q < 2; ++q) { const int m = m0 + q * NGW, mc = m < MT ? m : MT - 1;
            const float* xrow = mc < MP ? a.in[I_XP] + (size_t)mc * DM : a.in[I_XS] + (size_t)(mc - MP) * DM; const f32x4* xr = (const f32x4*)xrow + lane;
#pragma unroll
            for (int j = 0; j < 4; ++j) v[q][j] = xr[64 * j]; }
#pragma unroll
        for (int q = 0; q < 2; ++q) { const float keep = (m0 + q * NGW < MT) ? 1.f : 0.f;
#pragma unroll
            for (int j = 0; j < 4; ++j) v[q][j] = v[q][j] * keep; }
        const f32x4* wr = (const f32x4*)a.in[I_N1W] + lane;
#pragma unroll
        for (int q = 0; q < 2; ++q)
#pragma unroll
            for (int j = 0; j < 4; ++j) sq[q] += (v[q][j].x * v[q][j].x + v[q][j].y * v[q][j].y) + (v[q][j].z * v[q][j].z + v[q][j].w * v[q][j].w);
#pragma unroll
        for (int q = 0; q < 2; ++q) { const int m = m0 + q * NGW; if (m >= MPAD) continue;
            const float rstd = rsqrtf(wave_sum(sq[q]) * (1.f / DM) + EPS);
            unsigned long long* o8 = (unsigned long long*)(XW + (size_t)m * DM) + lane;
#pragma unroll
            for (int j = 0; j < 4; ++j) { const f32x4 w4 = wr[64 * j]; o8[64 * j] = (unsigned long long)pk2(v[q][j].x * rstd * w4.x, v[q][j].y * rstd * w4.y) | ((unsigned long long)pk2(v[q][j].z * rstd * w4.z, v[q][j].w * rstd * w4.w) << 32); } }
    }
    { f32x4* z = (f32x4*)(ws + WS_SMALL); const int n16 = (int)(SM_DT / 16); for (int i = gw * 64 + lane; i < n16; i += NGW * 64) z[i] = (f32x4){0.f, 0.f, 0.f, 0.f}; }
}

__device__ __forceinline__ void small_gemm(LAS unsigned char* lds, const bf16* A, int lda, const bf16* Bt, int K,
                                           const float* base, float* out, float scale, bf16* xw, const float* wn, float* ss, const float* ssgp_rows = nullptr, const bf16* bbase = nullptr, const float* bw = nullptr) {
    const int tid = threadIdx.x, wid = __builtin_amdgcn_readfirstlane(tid >> 6), lane = tid & 63, i = lane & 15, q = lane >> 4, ks = wid & 3, tl = wid >> 2;
    LAS f32x4* red = (LAS f32x4*)lds;
    const int kq = K >> 2;
    for (int t0 = blockIdx.x * 2; t0 < 512; t0 += gridDim.x * 2) {
        const int t = t0 + tl, tr = t >> 6, tc = t & 63;
        f32x4 acc = {0.f, 0.f, 0.f, 0.f};
        if (t < 512) {
            const bf16* ap = A + (size_t)(tr * 16 + i) * lda + ks * kq + 8 * q; const bf16* bp = Bt + (size_t)(tc * 16 + i) * K + ks * kq + 8 * q;
#pragma unroll 4
            for (int k = 0; k < kq; k += 32) { const bf16x8 av = *(const bf16x8*)(ap + k), bv = *(const bf16x8*)(bp + k); acc = __builtin_amdgcn_mfma_f32_16x16x32_bf16(bv, av, acc, 0, 0, 0); }
        }
        if (ssgp_rows && ks < 2 && t < 512) {
            const f32x4* pp = (const f32x4*)(ssgp_rows + ((size_t)(tr * 16 + i) * 2 + ks) * 16); const f32x4 q4 = (pp[0] + pp[1]) + (pp[2] + pp[3]);
            acc = acc * rsqrtf(((q4[0] + q4[1]) + (q4[2] + q4[3])) * (1.0f / 512.0f) + 1e-6f); }
        red[(tl * 4 + ks) * 64 + lane] = acc;
        __syncthreads();
        if (ks == 0 && t < 512) {
            const f32x4 sum = (red[(tl * 4 + 0) * 64 + lane] + red[(tl * 4 + 1) * 64 + lane]) + (red[(tl * 4 + 2) * 64 + lane] + red[(tl * 4 + 3) * 64 + lane]);
            const int row = tr * 16 + i, col = tc * 16 + 4 * q; const size_t off = (size_t)row * 1024 + col;
            f32x4 bs_;
            if (bbase) { const v2u r_ = *(const v2u*)(bbase + off); const f32x4 q_ = *(const f32x4*)(bw + col);
                bs_ = (f32x4){__uint_as_float(r_.x << 16) / q_[0], __uint_as_float(r_.x & 0xffff0000u) / q_[1], __uint_as_float(r_.y << 16) / q_[2], __uint_as_float(r_.y & 0xffff0000u) / q_[3]}; }
            else bs_ = *(const f32x4*)(base + off);
            const f32x4 v = bs_ + sum * scale; if (out) *(f32x4*)(out + off) = v;
            float s = (v[0] * v[0] + v[1] * v[1]) + (v[2] * v[2] + v[3] * v[3]);
            if (xw) { const f32x4 w4 = wn ? *(const f32x4*)(wn + col) : (f32x4){1.f, 1.f, 1.f, 1.f}; v2u p; p.x = pk2(v[0] * w4[0], v[1] * w4[1]); p.y = pk2(v[2] * w4[2], v[3] * w4[3]); *(v2u*)(xw + off) = p; }
            if (ss) { s += __shfl_xor(s, 16); s += __shfl_xor(s, 32); if (q == 0) atomicAdd(ss + row, s); }
        }
        __syncthreads();
    }
}

__device__ __forceinline__ void bc_conv_prepass(const Args& a, int gw, int NGW, int lane) {
    const bf16* proj = (const bf16*)(a.ws + WS_PROJ); bf16* BCB = (bf16*)(a.ws + WS_BCB);
    const float* cw = a.in[I_CW] + 1024 + 8 * lane; const float* cb = a.in[I_CB] + 1024 + 8 * lane;
    float w[4][8], bi[8];
#pragma unroll
    for (int k = 0; k < 4; ++k) { const f32x4 w0 = *(const f32x4*)(cw + k * CONVD), w1 = *(const f32x4*)(cw + k * CONVD + 4);
        w[k][0] = w0[0]; w[k][1] = w0[1]; w[k][2] = w0[2]; w[k][3] = w0[3]; w[k][4] = w1[0]; w[k][5] = w1[1]; w[k][6] = w1[2]; w[k][7] = w1[3]; }
    { const f32x4 b0 = *(const f32x4*)(cb), b1 = *(const f32x4*)(cb + 4); bi[0] = b0[0]; bi[1] = b0[1]; bi[2] = b0[2]; bi[3] = b0[3]; bi[4] = b1[0]; bi[5] = b1[1]; bi[6] = b1[2]; bi[7] = b1[3]; }
    for (int u = gw; u < MP / 8; u += NGW) {
        const int row0 = u * 8, l0 = row0 & (SEQ - 1);
        const bf16* src = proj + (size_t)(row0 - 3) * LDPJ + PC_XBC + 1024 + 8 * lane;
        v4u raw[11];
#pragma unroll
        for (int rr = 0; rr < 11; ++rr) raw[rr] = (l0 - 3 + rr >= 0) ? *(const v4u*)(src + (size_t)rr * LDPJ) : (v4u){0u, 0u, 0u, 0u};
#pragma unroll
        for (int t = 0; t < 8; ++t) {
            float x0[8], x1[8], x2[8], x3[8], o[8]; unpack8(raw[t], x0); unpack8(raw[t + 1], x1); unpack8(raw[t + 2], x2); unpack8(raw[t + 3], x3);
#pragma unroll
            for (int j = 0; j < 8; ++j) o[j] = silu(bi[j] + w[0][j] * x0[j] + w[1][j] * x1[j] + w[2][j] * x2[j] + w[3][j] * x3[j]);
            v4u p; p.x = pk2(o[0], o[1]); p.y = pk2(o[2], o[3]); p.z = pk2(o[4], o[5]); p.w = pk2(o[6], o[7]);
            *(v4u*)(BCB + (lane < 32 ? 0 : BC_CDELTA) + (size_t)(row0 + t) * 256 + 8 * (lane & 31)) = p;
        }
    }
}

__device__ __forceinline__ int crow(int i, int hh) { return (i & 3) + 8 * (i >> 2) + 4 * hh; }
__device__ __forceinline__ void ssd_prompt(const Args& a, LAS unsigned char* lds, int unit) {
    const int tid0 = threadIdx.x, wid = __builtin_amdgcn_readfirstlane(tid0 >> 6);
    const int b = unit >> 5, h = (unit >> 1) & 15, ph = unit & 1, g = h >> 3;
    const float A_h = -__expf(a.in[I_ALOG][h]), dtb = a.in[I_DTB][h], Dh = a.in[I_DSKIP][h];
    bf16* proj = (bf16*)(a.ws + WS_PROJ); const float* dtbuf = (const float*)(a.ws + WS_SMALL + SM_DT); float* ssgp = (float*)(a.ws + WS_SSGP);
    LAS bf16* Cl = (LAS bf16*)(lds + CL_OFF); LAS bf16* Bl = (LAS bf16*)(lds + BL_OFF); LAS bf16* BT = (LAS bf16*)(lds + BT_OFF);
    LAS bf16* XDT = (LAS bf16*)(lds + XDT_OFF); LAS bf16* XDD = (LAS bf16*)(lds + XDD_OFF); LAS bf16* SENT = (LAS bf16*)(lds + SENT_OFF); LAS bf16* XS = (LAS bf16*)(lds + XS_OFF);
    LAS float* acum2 = (LAS float*)(lds + ACUM_OFF); LAS float* dtv2 = (LAS float*)(lds + DTV_OFF); LAS float* eac2 = (LAS float*)(lds + WBC_OFF); LAS float* WX = (LAS float*)(lds + WX_OFF);
    for (int i = tid0; i < 32 * LDP / 2; i += NTHR) ((LAS unsigned*)SENT)[i] = 0u;
    {
        const float* cw = a.in[I_CW]; const float* cb = a.in[I_CB];
        if (tid0 < 160) { const int k = tid0 >> 5, ch = h * 64 + 32 * ph + (tid0 & 31); WX[tid0] = k < 4 ? cw[k * CONVD + ch] : cb[ch]; }
    }
    const bf16* BCB = (const bf16*)(a.ws + WS_BCB);
    f32x16 st;
#pragma unroll
    for (int i = 0; i < 16; ++i) st[i] = 0.f;
    v4u nraw[8], nxraw[4]; float ndt0 = 0.f, ndt1 = 0.f;
    {
        const int tcol = tid0 & 15, tg = tid0 >> 4, xl = (tid0 & 15) | ((tid0 >> 6) << 4), xc = (tid0 >> 4) & 3;
        const bf16* src = BCB + (size_t)(b * SEQ + 4 * tg) * 256 + g * 128 + 8 * tcol;
#pragma unroll
        for (int rr = 0; rr < 4; ++rr) { nraw[rr] = *(const v4u*)(src + (size_t)rr * 256); nraw[4 + rr] = *(const v4u*)(src + BC_CDELTA + (size_t)rr * 256); }
        const bf16* srx = proj + (size_t)(b * SEQ + xl - 3) * LDPJ + PC_XBC + h * 64 + 32 * ph + 8 * xc;
#pragma unroll
        for (int rr = 0; rr < 4; ++rr) nxraw[rr] = (xl - 3 + rr >= 0) ? *(const v4u*)(srx + (size_t)rr * LDPJ) : (v4u){0u, 0u, 0u, 0u};
        if (wid == 4) { const int l0 = 2 * (tid0 & 63); ndt0 = dtbuf[(size_t)(b * SEQ + l0) * 16 + h]; ndt1 = dtbuf[(size_t)(b * SEQ + l0 + 1) * 16 + h]; }
    }
#define SSD_STAGE_D(buf) do { const int ln_ = tid0 & 63, l0_ = 2 * ln_; const float d0_ = softplus_fast(ndt0 + dtb), d1_ = softplus_fast(ndt1 + dtb), a0_ = d0_ * A_h, a1_ = d1_ * A_h, s_ = a0_ + a1_; float incl_ = s_; \
        _Pragma("unroll") for (int o_ = 1; o_ < 64; o_ <<= 1) { const float t_ = __shfl_up(incl_, o_); if (ln_ >= o_) incl_ += t_; } \
        const float c0_ = (incl_ - s_ + a0_) * 1.44269504f, c1_ = incl_ * 1.44269504f; acum2[(buf) * 128 + l0_] = c0_; acum2[(buf) * 128 + l0_ + 1] = c1_; eac2[(buf) * 128 + l0_] = __builtin_amdgcn_exp2f(c0_); eac2[(buf) * 128 + l0_ + 1] = __builtin_amdgcn_exp2f(c1_); dtv2[(buf) * 128 + l0_] = d0_; dtv2[(buf) * 128 + l0_ + 1] = d1_; } while (0)
    if (wid == 4) SSD_STAGE_D(0);
    __syncthreads();
    const bf16* p_bc; const bf16* p_x; bf16* p_z; const float* p_dt; float* p_sq;
    {   const int tcol = tid0 & 15, tg = tid0 >> 4, xl = (tid0 & 15) | ((tid0 >> 6) << 4), xc = (tid0 >> 4) & 3;
        p_bc = BCB + (size_t)(b * SEQ + 128 + 4 * tg) * 256 + g * 128 + 8 * tcol;
        p_x = proj + (size_t)(b * SEQ + 128 + xl - 3) * LDPJ + PC_XBC + h * 64 + 32 * ph + 8 * xc;
        p_z = proj + (size_t)(b * SEQ + xl) * LDPJ + PC_Z + h * 64 + 32 * ph + 8 * xc;
        p_dt = dtbuf + (size_t)(b * SEQ + 128 + 2 * (tid0 & 63)) * 16 + h;
        p_sq = ssgp + ((size_t)(b * SEQ + xl) * 2 + g) * 16 + (h & 7) * 2 + ph; }
#define SSD_BAR() do { asm volatile("s_waitcnt lgkmcnt(0)" ::: "memory"); __builtin_amdgcn_s_barrier(); asm volatile("" ::: "memory"); } while (0)
#pragma unroll 1
    for (int c = 0; c < 16; ++c) {
        int tid = tid0; asm volatile("" : "+v"(tid));
        const int lane = tid & 63, r = lane & 31, hh = lane >> 5;
        const int tcol = tid & 15, tg = tid >> 4;
        const int xl = (tid & 15) | ((tid >> 6) << 4), xc = (tid >> 4) & 3;
        const int tok0 = b * SEQ + c * 128;
        LAS float* acum = acum2 + (c & 1) * 128; LAS float* dtv = dtv2 + (c & 1) * 128; LAS float* eac = eac2 + (c & 1) * 128;
        {
#pragma unroll
            for (int t = 0; t < 4; ++t) { *(LAS v4u*)(Bl + (4 * tg + t) * LDP + 8 * tcol) = nraw[t]; *(LAS v4u*)(Cl + (4 * tg + t) * LDP + 8 * tcol) = nraw[4 + t]; }
            const int boff = 8 * ((tg >> 1) ^ tcol) + 4 * (tg & 1);
#pragma unroll
            for (int i = 0; i < 4; ++i) { v2u lo, hi;
#pragma unroll
                for (int u = 0; u < 2; ++u) { const unsigned e0 = nraw[2 * u][i], e1 = nraw[2 * u + 1][i]; lo[u] = (e0 & 0xffffu) | (e1 << 16); hi[u] = (e0 >> 16) | (e1 & 0xffff0000u); }
                *(LAS v2u*)(BT + (8 * tcol + 2 * i) * LDP + boff) = lo; *(LAS v2u*)(BT + (8 * tcol + 2 * i + 1) * LDP + boff) = hi; }
        }
        {
            float x0[8], x1[8], x2[8], x3[8]; unpack8(nxraw[0], x0); unpack8(nxraw[1], x1); unpack8(nxraw[2], x2); unpack8(nxraw[3], x3);
            float xo[8];
#pragma unroll
            for (int hf = 0; hf < 2; ++hf) { const f32x4 w0 = *(const LAS f32x4*)(WX + 0 * 32 + 8 * xc + 4 * hf), w1 = *(const LAS f32x4*)(WX + 1 * 32 + 8 * xc + 4 * hf), w2 = *(const LAS f32x4*)(WX + 2 * 32 + 8 * xc + 4 * hf),
                                                     w3 = *(const LAS f32x4*)(WX + 3 * 32 + 8 * xc + 4 * hf), bb = *(const LAS f32x4*)(WX + 4 * 32 + 8 * xc + 4 * hf);
#pragma unroll
                for (int e = 0; e < 4; ++e) { const int j = 4 * hf + e; xo[j] = silu(bb[e] + w0[e] * x0[j] + w1[e] * x1[j] + w2[e] * x2[j] + w3[e] * x3[j]); } }
            const float dl = dtv[xl], de = dl * __builtin_amdgcn_exp2f(acum[127] - acum[xl]);
            { v4u p; p.x = pk2(xo[0], xo[1]); p.y = pk2(xo[2], xo[3]); p.z = pk2(xo[4], xo[5]); p.w = pk2(xo[6], xo[7]); *(LAS v4u*)(XS + xl * 32 + 8 * xc) = p; }
#pragma unroll
            for (int j = 0; j < 8; ++j) { const unsigned pk = pk2(xo[j] * dl, xo[j] * de); XDT[(8 * xc + j) * LDP + xl] = (unsigned short)pk; XDD[(8 * xc + j) * LDP + xl] = (unsigned short)(pk >> 16); }
        }
        SSD_BAR();
        if (c < 15) {
#pragma unroll
            for (int rr = 0; rr < 4; ++rr) { nraw[rr] = *(const v4u*)(p_bc + (size_t)rr * 256); nraw[4 + rr] = *(const v4u*)(p_bc + BC_CDELTA + (size_t)rr * 256); }
#pragma unroll
            for (int rr = 0; rr < 4; ++rr) nxraw[rr] = *(const v4u*)(p_x + (size_t)rr * LDPJ);
            if (wid == 4) { ndt0 = p_dt[0]; ndt1 = p_dt[16]; }
        }
        const v4u zraw = *(const v4u*)p_z;
        const int lb = wid >> 1, sh = wid & 1;
        f32x16 sacc[2];
        {
            bf16x8 cf[8];
#pragma unroll
            for (int ks = 0; ks < 8; ++ks) cf[ks] = *(const LAS bf16x8*)(Cl + (32 * lb + r) * LDP + 16 * ks + 8 * hh);
#pragma unroll
            for (int tt = 0; tt < 2; ++tt) { const int sb = 2 * sh + tt;
#pragma unroll
                for (int i = 0; i < 16; ++i) sacc[tt][i] = 0.f;
                if (sb <= lb) {
#pragma unroll
                    for (int ks = 0; ks < 8; ++ks) { const bf16x8 af = *(const LAS bf16x8*)(Bl + (32 * sb + r) * LDP + 16 * ks + 8 * hh); sacc[tt] = MFMA32(af, cf[ks], sacc[tt]); } } }
        }
        SSD_BAR();
        {
            LAS bf16* P = Bl; const int l = 32 * lb + r; const float al = acum[l];
#pragma unroll
            for (int tt = 0; tt < 2; ++tt) { const int sb = 2 * sh + tt;
                if (sb < lb) {
#pragma unroll
                    for (int gq = 0; gq < 4; ++gq) { const int s0 = 32 * sb + 8 * gq + 4 * hh; const f32x4 as4 = *(const LAS f32x4*)(acum + s0); float v[4];
#pragma unroll
                        for (int e = 0; e < 4; ++e) v[e] = sacc[tt][4 * gq + e] * __builtin_amdgcn_exp2f(al - as4[e]);
                        v2u p; p.x = pk2(v[0], v[1]); p.y = pk2(v[2], v[3]); *(LAS v2u*)(P + l * LDP + s0) = p; }
                } else if (sb == lb) {
#pragma unroll
                    for (int gq = 0; gq < 4; ++gq) { const int s0 = 32 * sb + 8 * gq + 4 * hh; const f32x4 as4 = *(const LAS f32x4*)(acum + s0); float v[4];
#pragma unroll
                        for (int e = 0; e < 4; ++e) v[e] = (s0 + e <= l) ? sacc[tt][4 * gq + e] * __builtin_amdgcn_exp2f(al - as4[e]) : 0.f;
                        v2u p; p.x = pk2(v[0], v[1]); p.y = pk2(v[2], v[3]); *(LAS v2u*)(P + l * LDP + s0) = p; } } }
        }
        SSD_BAR();
        asm volatile("" : "+v"(nraw[0]), "+v"(nraw[1]), "+v"(nraw[2]), "+v"(nraw[3]), "+v"(nraw[4]), "+v"(nraw[5]), "+v"(nraw[6]), "+v"(nraw[7]), "+v"(nxraw[0]), "+v"(nxraw[1]), "+v"(nxraw[2]), "+v"(nxraw[3]), "+v"(ndt0), "+v"(ndt1));
        if (wid < 4) {
            const int lb2 = wid; const LAS bf16* P = Bl;
            f32x16 yd, yo;
#pragma unroll
            for (int i = 0; i < 16; ++i) { yd[i] = 0.f; yo[i] = 0.f; }
            for (int sb = 0; sb <= lb2; ++sb) {
                const bf16x8 af0 = *(const LAS bf16x8*)(P + (32 * lb2 + r) * LDP + 32 * sb + 8 * hh), bf0 = *(const LAS bf16x8*)(XDT + r * LDP + 32 * sb + 8 * hh),
                             af1 = *(const LAS bf16x8*)(P + (32 * lb2 + r) * LDP + 32 * sb + 16 + 8 * hh), bf1 = *(const LAS bf16x8*)(XDT + r * LDP + 32 * sb + 16 + 8 * hh);
                yd = MFMA32(af0, bf0, yd); yd = MFMA32(af1, bf1, yd); }
#pragma unroll
            for (int ks = 0; ks < 8; ++ks) { const bf16x8 af = *(const LAS bf16x8*)(Cl + (32 * lb2 + r) * LDP + 16 * ks + 8 * hh), bfv = *(const LAS bf16x8*)(SENT + r * LDP + 16 * ks + 8 * hh); yo = MFMA32(af, bfv, yo); }
#pragma unroll
            for (int g4 = 0; g4 < 4; ++g4) { const f32x4 ea = *(const LAS f32x4*)(eac + 32 * lb2 + 8 * g4 + 4 * hh);
#pragma unroll
                for (int e = 0; e < 4; ++e) { const int i = 4 * g4 + e, l = 32 * lb2 + 8 * g4 + 4 * hh + e;
                    XS[l * 32 + r] = f2bf1(yd[i] + ea[e] * yo[i] + Dh * bf2f(XS[l * 32 + r])); } }
        } else {
            const int nb = wid - 4; const float cd = eac[127];
#pragma unroll
            for (int i = 0; i < 16; ++i) st[i] *= cd;
#pragma unroll
            for (int ks = 0; ks < 8; ++ks) { const bf16x8 af = *(const LAS bf16x8*)(BT + (32 * nb + r) * LDP + 8 * ((2 * ks + hh) ^ ((4 * nb + (r >> 3)) & 15))), bfv = *(const LAS bf16x8*)(XDD + r * LDP + 16 * ks + 8 * hh); st = MFMA32(af, bfv, st); }
            if (wid == 4 && c < 15) SSD_STAGE_D((c + 1) & 1);
        }
        SSD_BAR();
        if (wid >= 4) { const int nb = wid - 4;
#pragma unroll
            for (int gq = 0; gq < 4; ++gq) { v2u p; p.x = pk2(st[4 * gq], st[4 * gq + 1]); p.y = pk2(st[4 * gq + 2], st[4 * gq + 3]); *(LAS v2u*)(SENT + r * LDP + 32 * nb + 8 * gq + 4 * hh) = p; } }
        {
            float yv[8], zf[8]; unpack8(*(const LAS v4u*)(XS + xl * 32 + 8 * xc), yv); unpack8(zraw, zf);
            float sq = 0.f;
#pragma unroll
            for (int j = 0; j < 8; ++j) { yv[j] *= zf[j]; sq += yv[j] * yv[j]; }
            v4u o; o.x = pk2(yv[0], yv[1]); o.y = pk2(yv[2], yv[3]); o.z = pk2(yv[4], yv[5]); o.w = pk2(yv[6], yv[7]);
            *(v4u*)p_z = o;
            sq += __shfl_xor(sq, 16); sq += __shfl_xor(sq, 32);
            if (xc == 0) *p_sq = sq;
        }
        p_bc += 128 * 256; p_x += (size_t)128 * LDPJ; p_z += (size_t)128 * LDPJ; p_dt += 128 * 16; p_sq += 128 * 2 * 16;
    }
#undef SSD_STAGE_D
#undef SSD_BAR
    const int r = tid0 & 31, hh = (tid0 >> 5) & 1;
    if (wid >= 4) { const int nb = wid - 4; float* o = a.out + O_SSMP + ((size_t)(b * 16 + h) * 64 + 32 * ph + r) * 128 + 32 * nb + 4 * hh;
#pragma unroll
        for (int gq = 0; gq < 4; ++gq) *(f32x4*)(o + 8 * gq) = (f32x4){st[4 * gq], st[4 * gq + 1], st[4 * gq + 2], st[4 * gq + 3]}; }
    __syncthreads();
}
constexpr int SMP_SCR = 11264;
__device__ __forceinline__ void ssd_sample(const Args& a, LAS float* scr, int wu, int lane) {
    const int j = wu >> 4, h = wu & 15, g = h >> 3; const size_t row = (size_t)(MP + j);
    bf16* prow = (bf16*)(a.ws + WS_PROJ) + row * LDPJ; const float* dtbuf = (const float*)(a.ws + WS_SMALL + SM_DT); float* ssgp = (float*)(a.ws + WS_SSGP);
    const float* cw = a.in[I_CW]; const float* cb = a.in[I_CB]; const float* cst = a.in[I_SCONV0] + (size_t)j * 3 * CONVD;
    const float A_h = -__expf(a.in[I_ALOG][h]), Dh = a.in[I_DSKIP][h];
    const float dt = softplus(dtbuf[row * 16 + h] + a.in[I_DTB][h]), dA = __expf(dt * A_h);
    LAS float* sx = scr; LAS float* sxs = scr + 64; LAS float* sB = scr + 128; LAS float* sC = scr + 256; LAS float* sp = scr + 384;
#pragma unroll
    for (int t = 0; t < 5; ++t) {
        const int ch = t == 0 ? (h * 64 + lane) : (t < 3 ? (1024 + g * 128 + lane + 64 * (t - 1)) : (1280 + g * 128 + lane + 64 * (t - 3)));
        float v = cb[ch] + cw[0 * CONVD + ch] * cst[0 * CONVD + ch] + cw[1 * CONVD + ch] * cst[1 * CONVD + ch] + cw[2 * CONVD + ch] * cst[2 * CONVD + ch] + cw[3 * CONVD + ch] * bf2f(prow[PC_XBC + ch]);
        v = silu(v);
        if (t == 0) { sx[lane] = v * dt; sxs[lane] = v; } else if (t < 3) sB[lane + 64 * (t - 1)] = v; else sC[lane + 64 * (t - 3)] = v;
    }
    const float zf = bf2f(prow[PC_Z + h * 64 + lane]);
    LDS_WAIT();
    const int rs = lane >> 5, n4 = lane & 31;
    const f32x4 Br = *(const LAS f32x4*)(sB + 4 * n4), Cr = *(const LAS f32x4*)(sC + 4 * n4);
    const f32x4* __restrict__ S0 = (const f32x4*)(a.in[I_SSM] + ((size_t)(j * 16 + h) * 64) * 128) + lane; f32x4* __restrict__ S1 = (f32x4*)(a.out + O_SSMS + ((size_t)(j * 16 + h) * 64) * 128) + lane;
#pragma unroll 1
    for (int it0 = 0; it0 < 32; it0 += 16) {
        f32x4 s4[16];
#pragma unroll
        for (int k = 0; k < 16; ++k) s4[k] = __builtin_nontemporal_load(S0 + 64 * (it0 + k));
#pragma unroll
        for (int k = 0; k < 16; ++k) { const int p = 2 * (it0 + k) + rs; const float xd = sx[p];
            const f32x4 nv = s4[k] * dA + Br * xd; __builtin_nontemporal_store(nv, S1 + 64 * (it0 + k));
            sp[p * 36 + n4] = (nv[0] * Cr[0] + nv[1] * Cr[1]) + (nv[2] * Cr[2] + nv[3] * Cr[3]); }
    }
    LDS_WAIT();
    float y = 0.f;
#pragma unroll
    for (int k = 0; k < 8; ++k) { const f32x4 v = *(const LAS f32x4*)(sp + lane * 36 + 4 * k); y += (v[0] + v[1]) + (v[2] + v[3]); }
    y = (y + Dh * sxs[lane]) * zf;
    prow[PC_Z + h * 64 + lane] = f2bf1(y);
    const float sq = wave_sum(y * y);
    if (lane < 2) ssgp[(row * 2 + g) * 16 + (h & 7) * 2 + lane] = lane == 0 ? sq : 0.f;
    LDS_WAIT();
}

__device__ __forceinline__ void p5_fix(const Args& a, int gw, int NGW, int lane) {
    bf16* proj = (bf16*)(a.ws + WS_PROJ); const float* ssgp = (const float*)(a.ws + WS_SSGP);
    const float* snw = a.in[I_SNW]; const float* scw = a.in[I_SCW];
    for (int u = gw; u < 2048 + 256; u += NGW) {
        const bool smp = u >= 2048; const int uu = smp ? u - 2048 : u, tgp = uu >> 1, kind = 2 + (uu & 1);
        const size_t row0 = smp ? (size_t)(MP + tgp) : (size_t)tgp * 16;
        if (kind < 2) continue;
        if (false) {
            const int ch = 512 * kind + 8 * lane; const f32x4 w0 = *(const f32x4*)(snw + ch), w1 = *(const f32x4*)(snw + ch + 4);
            if (smp) {
                const f32x4* pp = (const f32x4*)(ssgp + (row0 * 2 + kind) * 16); const f32x4 q4 = (pp[0] + pp[1]) + (pp[2] + pp[3]); const float rs = rsqrtf(((q4[0] + q4[1]) + (q4[2] + q4[3])) * (1.f / 512.f) + EPS);
                v4u* p = (v4u*)(proj + row0 * LDPJ + PC_Z + ch); float f[8]; unpack8(*p, f);
                v4u o; o.x = pk2(f[0] * rs * w0[0], f[1] * rs * w0[1]); o.y = pk2(f[2] * rs * w0[2], f[3] * rs * w0[3]); o.z = pk2(f[4] * rs * w1[0], f[5] * rs * w1[1]); o.w = pk2(f[6] * rs * w1[2], f[7] * rs * w1[3]); *p = o;
            } else {
                v4u raw[16]; float qs[16];
#pragma unroll
                for (int t = 0; t < 16; ++t) raw[t] = *(const v4u*)(proj + (row0 + t) * LDPJ + PC_Z + ch);
#pragma unroll
                for (int t = 0; t < 16; ++t) { const f32x4* pp = (const f32x4*)(ssgp + ((row0 + t) * 2 + kind) * 16); const f32x4 q4 = (pp[0] + pp[1]) + (pp[2] + pp[3]); qs[t] = (q4[0] + q4[1]) + (q4[2] + q4[3]); }
#pragma unroll
                for (int t = 0; t < 16; ++t) { const float rs = rsqrtf(qs[t] * (1.f / 512.f) + EPS); float f[8]; unpack8(raw[t], f);
                    v4u o; o.x = pk2(f[0] * rs * w0[0], f[1] * rs * w0[1]); o.y = pk2(f[2] * rs * w0[2], f[3] * rs * w0[3]); o.z = pk2(f[4] * rs * w1[0], f[5] * rs * w1[1]); o.w = pk2(f[6] * rs * w1[2], f[7] * rs * w1[3]);
                    *(v4u*)(proj + (row0 + t) * LDPJ + PC_Z + ch) = o; }
            }
        } else {
            const int ch = 512 * (kind - 2) + 8 * lane; float w[3][8];
#pragma unroll
            for (int k = 0; k < 3; ++k) { const f32x4 a0 = *(const f32x4*)(scw + k * 1024 + ch), a1 = *(const f32x4*)(scw + k * 1024 + ch + 4);
                w[k][0] = a0[0]; w[k][1] = a0[1]; w[k][2] = a0[2]; w[k][3] = a0[3]; w[k][4] = a1[0]; w[k][5] = a1[1]; w[k][6] = a1[2]; w[k][7] = a1[3]; }
            float u2[8], u1[8];
            if (smp) { const float* sp_ = a.in[I_SSCONV] + (size_t)tgp * 2 * 1024 + ch; float cc[8], hv[8], bb[8], uc[8], y[8];
#pragma unroll
                for (int e = 0; e < 8; ++e) { u2[e] = sp_[e]; u1[e] = sp_[1024 + e]; }
                unpack8(*(const v4u*)(proj + row0 * LDPJ + PC_SCC + ch), cc); v4u* pb = (v4u*)(proj + row0 * LDPJ + PC_SCB + ch); unpack8(*pb, bb); (void)hv;
#pragma unroll
                for (int e = 0; e < 8; ++e) { uc[e] = cc[e]; y[e] = bb[e] * (w[0][e] * u2[e] + w[1][e] * u1[e] + w[2][e] * uc[e]); }
                v4u o; o.x = pk2(y[0], y[1]); o.y = pk2(y[2], y[3]); o.z = pk2(y[4], y[5]); o.w = pk2(y[6], y[7]); *pb = o;
                float* d = a.out + O_SCS + (size_t)tgp * 2 * 1024 + ch;
#pragma unroll
                for (int e = 0; e < 8; ++e) { d[e] = u1[e]; d[1024 + e] = uc[e]; }
            } else {
                const int l0 = (tgp & 127) * 16;
                v4u hc[2];
#pragma unroll
                for (int q = 0; q < 2; ++q) { const bool ok = l0 > 0; hc[q] = ok ? *(const v4u*)(proj + (row0 - 2 + q) * LDPJ + PC_SCC + ch) : (v4u){0u, 0u, 0u, 0u}; }
                unpack8(hc[0], u2); unpack8(hc[1], u1);
#pragma unroll
                for (int half = 0; half < 2; ++half) {
                    v4u rc[8], rb[8];
#pragma unroll
                    for (int t = 0; t < 8; ++t) { const size_t row = row0 + 8 * half + t; rc[t] = *(const v4u*)(proj + row * LDPJ + PC_SCC + ch); rb[t] = *(const v4u*)(proj + row * LDPJ + PC_SCB + ch); }
#pragma unroll
                    for (int t = 0; t < 8; ++t) { const size_t row = row0 + 8 * half + t; float bb[8], uc[8], y[8]; unpack8(rc[t], uc); unpack8(rb[t], bb);
#pragma unroll
                        for (int e = 0; e < 8; ++e) { y[e] = bb[e] * (w[0][e] * u2[e] + w[1][e] * u1[e] + w[2][e] * uc[e]); }
                        v4u o; o.x = pk2(y[0], y[1]); o.y = pk2(y[2], y[3]); o.z = pk2(y[4], y[5]); o.w = pk2(y[6], y[7]); *(v4u*)(proj + row * LDPJ + PC_SCB + ch) = o;
                        const int l = l0 + 8 * half + t;
                        if (l >= SEQ - 2) { float* d = a.out + O_SCP + ((size_t)(tgp >> 7) * 2 + (l - (SEQ - 2))) * 1024 + ch;
#pragma unroll
                            for (int e = 0; e < 8; ++e) d[e] = uc[e]; }
#pragma unroll
                        for (int e = 0; e < 8; ++e) { u2[e] = u1[e]; u1[e] = uc[e]; } }
                }
            }
        }
    }
    const int gt = gw * 64 + lane, NT = NGW * 64;
    for (int i4 = gt; i4 < NBATCH * 3 * CONVD / 4; i4 += NT) { const int i = 4 * i4, c = i % CONVD, k = (i / CONVD) % 3, b = i / (3 * CONVD);
        const v2u r2 = *(const v2u*)(proj + (size_t)(b * SEQ + SEQ - 3 + k) * LDPJ + PC_XBC + c);
        *(f32x4*)(a.out + O_CONVP + i) = (f32x4){__uint_as_float(r2.x << 16), __uint_as_float(r2.x & 0xffff0000u), __uint_as_float(r2.y << 16), __uint_as_float(r2.y & 0xffff0000u)}; }
    for (int i4 = gt; i4 < NS * 3 * CONVD / 4; i4 += NT) { const int i = 4 * i4, c = i % CONVD, k = (i / CONVD) % 3, j = i / (3 * CONVD);
        f32x4 o;
        if (k < 2) o = *(const f32x4*)(a.in[I_SCONV0] + (size_t)j * 3 * CONVD + (k + 1) * CONVD + c);
        else { const v2u r2 = *(const v2u*)(proj + (size_t)(MP + j) * LDPJ + PC_XBC + c); o = (f32x4){__uint_as_float(r2.x << 16), __uint_as_float(r2.x & 0xffff0000u), __uint_as_float(r2.y << 16), __uint_as_float(r2.y & 0xffff0000u)}; }
        *(f32x4*)(a.out + O_CONVS + i) = o; }
}

#define XB_TMO      128
#define XB_XCNT(j)  (256  + 64 * (j))
#define XB_XSUB(j)  (1280 + 64 * (j))
#define XB_XGEN(j)  (2304 + 64 * (j))
#define XB_TOP      3328
#define XB_TOPGEN   3392
#define XCD_BAR_WORDS 3456
#define XB_SPIN_CAP (1u << 18)

__device__ __forceinline__ unsigned xb_ld(unsigned* p)              { return __hip_atomic_load(p, __ATOMIC_RELAXED, __HIP_MEMORY_SCOPE_AGENT); }
__device__ __forceinline__ unsigned xb_add(unsigned* p, unsigned v) { return __hip_atomic_fetch_add(p, v, __ATOMIC_RELAXED, __HIP_MEMORY_SCOPE_AGENT); }
__device__ __forceinline__ unsigned xb_xcc_id() { return (unsigned)__builtin_amdgcn_s_getreg((3 << 11) | 20) & 0xFu; }
#define XB_SPIN(cond, bar) do { unsigned _sp = 0; while (cond) { __builtin_amdgcn_s_sleep(1); \
    if ((++_sp & 255u) == 0u) { if (xb_ld(&(bar)[XB_TMO])) break; if (_sp > XB_SPIN_CAP) { atomicAdd(&(bar)[XB_TMO], 1u); break; } } } } while (0)

struct XcdBarrier {
    unsigned* bar; unsigned x;
    volatile LAS unsigned* st;
};

__device__ __forceinline__ XcdBarrier xcd_barrier_post(unsigned* bar, volatile LAS unsigned* st) {
    XcdBarrier b; b.bar = bar; b.x = xb_xcc_id(); b.st = st;
    if (threadIdx.x == 0) (void)xb_add(&bar[XB_XCNT(b.x)], 1u);
    return b;
}
__device__ __forceinline__ void xcd_barrier_complete(unsigned* bar, unsigned x, unsigned& nloc, unsigned& nx) {
    const unsigned G = gridDim.x * gridDim.y * gridDim.z;
    unsigned sum, cnt, mine, sp = 0u;
    for (;;) {
        sum = 0u; cnt = 0u; mine = 0u;
#pragma unroll
        for (unsigned j = 0; j < 16; ++j) { const unsigned c = xb_ld(&bar[XB_XCNT(j)]); sum += c; cnt += (c > 0u) ? 1u : 0u; mine = (j == x) ? c : mine; }
        if (sum == G) break;
        __builtin_amdgcn_s_sleep(1);
        if ((++sp & 255u) == 0u) { if (xb_ld(&bar[XB_TMO])) break; if (sp > XB_SPIN_CAP) { atomicAdd(&bar[XB_TMO], 1u); break; } }
    }
    nloc = mine > 0u ? mine : 1u; nx = cnt > 0u ? cnt : 1u;
}

__device__ __forceinline__ void xcd_barrier(const XcdBarrier& b) {
    asm volatile("s_waitcnt vmcnt(0)" ::: "memory");
    __syncthreads();
    if (threadIdx.x == 0) {
        unsigned* bar = b.bar;
        __builtin_amdgcn_s_waitcnt(0);
        unsigned nloc = b.st[0], nx = b.st[1];
        if (nloc == 0u) { xcd_barrier_complete(bar, b.x, nloc, nx); b.st[0] = nloc; b.st[1] = nx; }
        const unsigned old = xb_add(&bar[XB_XSUB(b.x)], 1u);
        const unsigned gen = old / nloc;
        if (old + 1u == (gen + 1u) * nloc) {
            __builtin_amdgcn_fence(__ATOMIC_RELEASE, "agent");
            asm volatile("s_waitcnt vmcnt(0)" ::: "memory");
            const unsigned og = xb_add(&bar[XB_TOP], 1u);
            const unsigned tg = og / nx;
            if (og + 1u == (tg + 1u) * nx) xb_add(&bar[XB_TOPGEN], 1u);
            else XB_SPIN(xb_ld(&bar[XB_TOPGEN]) == tg, bar);
            __builtin_amdgcn_fence(__ATOMIC_ACQUIRE, "agent");
            xb_add(&bar[XB_XGEN(b.x)], 1u);
            asm volatile("s_waitcnt vmcnt(0)" ::: "memory");
        } else {
            XB_SPIN(xb_ld(&bar[XB_XGEN(b.x)]) == gen, bar);
            __builtin_amdgcn_fence(__ATOMIC_ACQUIRE, "agent");
            asm volatile("s_waitcnt vmcnt(0)" ::: "memory");
        }
    }
    __syncthreads();
}

__global__ void __launch_bounds__(NTHR, 2) hymba_fwd(Args a) {
    extern __shared__ __attribute__((aligned(16))) unsigned char lds_raw[];
    cg::grid_group grid = cg::this_grid();
    LAS unsigned char* lds = (LAS unsigned char*)lds_raw;
    const int tid = threadIdx.x, lane = tid & 63, wave = __builtin_amdgcn_readfirstlane(tid >> 6);
    const int G = gridDim.x, gw = blockIdx.x * NWAVES + wave, NGW = G * NWAVES;
    unsigned char* ws = a.ws;
    bf16* XW = (bf16*)(ws + WS_XW); bf16* H = (bf16*)(ws + WS_H); bf16* PROJ = (bf16*)(ws + WS_PROJ);
    float* ss2 = (float*)(ws + WS_SMALL + SM_SS2); float* ss3 = (float*)(ws + WS_SMALL + SM_SS3); float* dtbuf = (float*)(ws + WS_SMALL + SM_DT);
    float* xres = a.out + O_Y;
    volatile LAS unsigned* MISC = (volatile LAS unsigned*)(lds + LDS_BYTES - 64);
    if (tid < 16) MISC[tid] = 0u;
    __syncthreads();
    XcdBarrier bar = xcd_barrier_post((unsigned*)(ws + WS_BAR), MISC);
    const int lo = a.ph_lo, hi = a.ph_hi;
#ifndef PH_MASK
#define PH_MASK 0x7ff
#endif
#define IN(k) (((PH_MASK >> (k)) & 1) && lo <= (k) && (k) < hi)
#define SEAM(k) do { if (IN(k) && IN((k) + 1)) xcd_barrier(bar); } while (0)
    if (a.ph_hi > 1000) grid.sync();
    if (IN(0)) p0_prologue(a, lds, gw, NGW, wave, lane);
    SEAM(0);
    if (IN(1)) {
        pg8::Gemm g{XW, (const bf16*)(ws + WS_W1GU), MPAD, NGU, DM, DM}; pg8::StaticOrder S; S.init(MPAD, NGU, G, (int)blockIdx.x);
        pg8::EpiSwiGLU<false> E{H, DFF, nullptr};
        pg8::gemm_phase<pg8::EpiSwiGLU<false>, pg8::StaticOrder, true, true>(lds, g, S, E);
    }
    SEAM(1);
    if (IN(2)) {
        pg8::Gemm g{H, (const bf16*)(ws + WS_W1D), MP, DM, DFF, DFF}; pg8::StaticOrder S; S.init(MP, DM, G, (int)blockIdx.x);
        pg8::EpiRes E{a.in[I_XP], nullptr, 0.5f, XW, a.in[I_NMW], ss2, nullptr, nullptr, nullptr};
        pg8::gemm_phase<pg8::EpiRes, pg8::StaticOrder, true, true>(lds, g, S, E);
        if (!(a.flags & 4)) small_gemm(lds, H + (size_t)MP * DFF, DFF, (const bf16*)(ws + WS_W1D), DFF, a.in[I_XS], nullptr, 0.5f, XW + (size_t)MP * DM, a.in[I_NMW], ss2 + MP);
    }
    SEAM(2);
    if (IN(3)) {
        pg8::Gemm g{XW, (const bf16*)(ws + WS_WIN), MPAD, NINP, DM, DM}; pg8::StaticOrder S; S.init(MPAD, NINP, G, (int)blockIdx.x);
        pg8::EpiProj E{PROJ, LDPJ, ss2, dtbuf, LDPJ / 256, a.flags & 8, PC_SCC / 256};
        pg8::gemm_phase<pg8::EpiProj, pg8::StaticOrder, true, true>(lds, g, S, E);
    }
    SEAM(3);
    if (IN(4)) { bc_conv_prepass(a, gw, NGW, lane); p5_fix(a, gw, NGW, lane); p0_late_weights(a, lds, gw, NGW, wave, lane); }
    SEAM(4);
    if (IN(5)) {
        if (!(a.flags & 2)) for (int u = blockIdx.x; u < NBATCH * 32; u += G) ssd_prompt(a, lds, (G == NBATCH * 32) ? ((u & 7) * 32 + (u >> 3)) : u);
        if (!(a.flags & 1)) for (int wu = gw; wu < NS * 16; wu += NGW) ssd_sample(a, (LAS float*)(lds + wave * SMP_SCR), wu, lane);
    }
    do { if (IN(5) && IN(7)) xcd_barrier(bar); } while (0);
    if (IN(7)) {
        pg8::Gemm g{PROJ, (const bf16*)(ws + WS_WOUT), MP, DM, DMIX, LDPJ}; pg8::StaticOrder S; S.init(MP, DM, G, (int)blockIdx.x);
        pg8::EpiResT<true> E{nullptr, nullptr, 1.0f, XW, a.in[I_N2W], ss3, (const float*)(ws + WS_SSGP), XW, a.in[I_NMW]};
        pg8::gemm_phase<pg8::EpiResT<true>, pg8::StaticOrder, true, true>(lds, g, S, E);
        if (!(a.flags & 4)) small_gemm(lds, PROJ + (size_t)MP * LDPJ, LDPJ, (const bf16*)(ws + WS_WOUT), DMIX, nullptr, nullptr, 1.0f, XW + (size_t)MP * DM, a.in[I_N2W], ss3 + MP, (const float*)(ws + WS_SSGP) + (size_t)MP * 2 * 16, XW + (size_t)MP * DM, a.in[I_NMW]);
    }
    SEAM(7);
    if (IN(8)) {
        pg8::Gemm g{XW, (const bf16*)(ws + WS_W2GU), MPAD, NGU, DM, DM}; pg8::StaticOrder S; S.init(MPAD, NGU, G, (int)blockIdx.x);
        pg8::EpiSwiGLU<true> E{H, DFF, ss3};
        pg8::gemm_phase<pg8::EpiSwiGLU<true>, pg8::StaticOrder, true, true>(lds, g, S, E);
    }
    SEAM(8);
    if (IN(9)) {
        pg8::Gemm g{H, (const bf16*)(ws + WS_W2D), MP, DM, DFF, DFF}; pg8::StaticOrder S; S.init(MP, DM, G, (int)blockIdx.x);
        pg8::EpiRes E{nullptr, nullptr, 0.5f, XW, nullptr, nullptr, nullptr, XW, a.in[I_N2W]};
        pg8::gemm_phase<pg8::EpiRes, pg8::StaticOrder, true, true>(lds, g, S, E);
        if (!(a.flags & 4)) small_gemm(lds, H + (size_t)MP * DFF, DFF, (const bf16*)(ws + WS_W2D), DFF, nullptr, nullptr, 0.5f, XW + (size_t)MP * DM, nullptr, nullptr, nullptr, XW + (size_t)MP * DM, a.in[I_N2W]);
    }
    SEAM(9);
    if (IN(10)) {
        const f32x4* wr = (const f32x4*)a.in[I_FNW] + lane;
        f32x4 w4[4];
#pragma unroll
        for (int j = 0; j < 4; ++j) w4[j] = wr[64 * j];
        for (int m = gw; m < MT; m += 2 * NGW) { const int m2 = m + NGW; const bool two = m2 < MT;
            const unsigned long long* xb = (const unsigned long long*)(XW + (size_t)m * DM) + lane; const unsigned long long* xb2 = (const unsigned long long*)(XW + (size_t)(two ? m2 : m) * DM) + lane;
            f32x4* xr = (f32x4*)(xres + (size_t)m * DM) + lane; f32x4* xr2 = (f32x4*)(xres + (size_t)(two ? m2 : m) * DM) + lane; unsigned long long r[4], r2[4]; f32x4 v[4], v2[4]; float s = 0.f, s2 = 0.f;
#pragma unroll
            for (int j = 0; j < 4; ++j) { r[j] = __builtin_nontemporal_load(xb + 64 * j); r2[j] = __builtin_nontemporal_load(xb2 + 64 * j); }
#pragma unroll
            for (int j = 0; j < 4; ++j) { const unsigned lo = (unsigned)r[j], hi = (unsigned)(r[j] >> 32), lo2 = (unsigned)r2[j], hi2 = (unsigned)(r2[j] >> 32);
                v[j] = (f32x4){__uint_as_float(lo << 16), __uint_as_float(lo & 0xffff0000u), __uint_as_float(hi << 16), __uint_as_float(hi & 0xffff0000u)};
                v2[j] = (f32x4){__uint_as_float(lo2 << 16), __uint_as_float(lo2 & 0xffff0000u), __uint_as_float(hi2 << 16), __uint_as_float(hi2 & 0xffff0000u)}; }
#pragma unroll
            for (int j = 0; j < 4; ++j) { s += (v[j].x * v[j].x + v[j].y * v[j].y) + (v[j].z * v[j].z + v[j].w * v[j].w); s2 += (v2[j].x * v2[j].x + v2[j].y * v2[j].y) + (v2[j].z * v2[j].z + v2[j].w * v2[j].w); }
            const float rstd = rsqrtf(wave_sum(s) * (1.f / DM) + EPS), rstd2 = rsqrtf(wave_sum(s2) * (1.f / DM) + EPS);
#pragma unroll
            for (int j = 0; j < 4; ++j) __builtin_nontemporal_store(v[j] * rstd * w4[j], xr + 64 * j);
            if (two) {
#pragma unroll
                for (int j = 0; j < 4; ++j) __builtin_nontemporal_store(v2[j] * rstd2 * w4[j], xr2 + 64 * j); } }
    }
#ifdef EXTRA_SYNCS
    for (int i = 0; i < EXTRA_SYNCS; ++i) grid.sync();
#endif
#undef IN
#undef SEAM
}

extern "C" void kernel_launch(void* const* d_in, const int* in_sizes, int n_in, void* d_out, int out_size, void* d_ws, size_t ws_size, hipStream_t stream) {
    static int grid = 0;
    if (grid == 0) {
        if (n_in != 24 || (size_t)out_size != O_END || ws_size < WS_END3) { fprintf(stderr, "kernel_launch: unexpected sizes: n_in %d out %d (want %zu) ws %zu (need %zu)\n", n_in, out_size, (size_t)O_END, ws_size, (size_t)WS_END3); grid = -1; return; }
        int dev = 0, cus = 0, per_cu = 0;
        hipGetDevice(&dev); hipDeviceGetAttribute(&cus, hipDeviceAttributeMultiprocessorCount, dev);
        if (hipFuncSetAttribute((const void*)hymba_fwd, hipFuncAttributeMaxDynamicSharedMemorySize, LDS_BYTES) != hipSuccess) { fprintf(stderr, "kernel_launch: hipFuncSetAttribute failed\n"); grid = -1; return; }
        if (hipOccupancyMaxActiveBlocksPerMultiprocessor(&per_cu, (const void*)hymba_fwd, NTHR, LDS_BYTES) != hipSuccess || per_cu < 1) { fprintf(stderr, "kernel_launch: occupancy query says %d blocks per CU\n", per_cu); grid = -1; (void)hipGetLastError(); return; }
        grid = cus * per_cu;
    }
    if (grid < 0) return;
    if (hipMemsetAsync((unsigned char*)d_ws + WS_BAR, 0, 16384, stream) != hipSuccess) { fprintf(stderr, "kernel_launch: memset of the barrier words failed\n"); return; }
    Args a{};
    for (int i = 0; i < 24; ++i) a.in[i] = (const float*)d_in[i];
    a.out = (float*)d_out; a.ws = (unsigned char*)d_ws; a.ph_lo = 0; a.ph_hi = 11;
    void* args[] = {&a};
#ifndef PRE_PASS
#define PRE_PASS 0
#endif
#ifndef PRE_FLAGS
#define PRE_FLAGS 0
#endif
    if (PRE_PASS > 0) {
        a.ph_hi = PRE_PASS; a.flags = PRE_FLAGS; (void)hipLaunchCooperativeKernel((const void*)hymba_fwd, dim3(grid), dim3(NTHR), args, LDS_BYTES, stream); a.ph_hi = 11; a.flags = 0; (void)hipMemsetAsync((unsigned char*)d_ws + WS_BAR, 0, 16384, stream); }
    hipError_t e = hipLaunchCooperativeKernel((const void*)hymba_fwd, dim3(grid), dim3(NTHR), args, LDS_BYTES, stream);
    if (e != hipSuccess) fprintf(stderr, "kernel_launch: cooperative launch failed: %s (grid %d)\n", hipGetErrorString(e), grid);
}
```

```cpp
#include <hip/hip_runtime.h>
#include <hip/hip_cooperative_groups.h>
#include <cstdio>
#include <cstdint>
namespace cg = cooperative_groups;
namespace pg8 {
#define PG8_LAS __attribute__((address_space(3)))
typedef unsigned short bf16_t;
typedef short bf16x8 __attribute__((ext_vector_type(8)));
typedef float f32x4 __attribute__((ext_vector_type(4)));
typedef unsigned u32x4 __attribute__((ext_vector_type(4)));
constexpr int BM = 256, BK = 64, HALF = 128, HTB = HALF * BK * 2  , STAGE_BYTES = 8 * HTB, NXCD = 8, WGM = 8;

__host__ __device__ __forceinline__ int lds_byte(int r, int c) { const int st = (r >> 4) * 2 + (c >> 5), rr = r & 15, cc = c & 31, ob = rr * 64 + cc * 2; return st * 1024 + (ob ^ (((ob >> 9) & 1) << 5)); }
__host__ __device__ __forceinline__ void stage_rc(int b, int& R, int& C) { const int st = b / 1024, sb = b % 1024, swz = sb ^ (((sb >> 9) & 1) << 5); R = (st >> 1) * 16 + swz / 64; C = (st & 1) * 32 + (swz % 64) / 2; }
__host__ __device__ __forceinline__ int perm32(int rho) { const int n = rho >> 4, i = rho & 15; return 8 * (i >> 2) + 4 * n + (i & 3); }

struct Unit { int pm, pn; };
struct Gemm { const bf16_t* A; const bf16_t* Bt; int M, N, K, lda; };

struct StaticOrder {
    int nM, nN, nwg, G, c;
    __host__ __device__ void init(int M, int N, int G_, int c_) { nM = M / BM; nN = N / BM; nwg = nM * nN; G = G_; c = c_; }
    __host__ __device__ bool next(int i, Unit& u) const {
        const long L = (long)i * G + c; if (L >= nwg) return false;
        int wgid = (int)L; { const int q = nwg / NXCD, r = nwg % NXCD, xcd = wgid % NXCD, off = wgid / NXCD; wgid = (xcd < r ? xcd * (q + 1) : r * (q + 1) + (xcd - r) * q) + off; }
        const int nig = WGM * nN, gid = wgid / nig, fm = gid * WGM, gsz = (nM - fm) < WGM ? (nM - fm) : WGM;
        u.pm = fm + ((wgid % nig) % gsz); u.pn = (wgid % nig) / gsz; return true;
    }
    __device__ __forceinline__ void a_ready(const Unit&) const {}
    __device__ __forceinline__ void done(const Unit&) const {}
};


__device__ __forceinline__ unsigned cvt_pk_bf16(float lo, float hi) { unsigned r; asm volatile("v_cvt_pk_bf16_f32 %0, %1, %2" : "=v"(r) : "v"(lo), "v"(hi)); return r; }
__device__ __forceinline__ float silu_f(float v) { return v * __builtin_amdgcn_rcpf(1.0f + __expf(-v)); }
typedef unsigned u32x2 __attribute__((ext_vector_type(2)));

typedef float f32x2 __attribute__((ext_vector_type(2)));
__device__ __forceinline__ f32x2 swiglu_pk(f32x2 g, f32x2 u) {
    const f32x2 t = g * (-1.44269504f); f32x2 e; e.x = __builtin_amdgcn_exp2f(t.x); e.y = __builtin_amdgcn_exp2f(t.y);
    const f32x2 d = e + 1.0f; f32x2 r; r.x = __builtin_amdgcn_rcpf(d.x); r.y = __builtin_amdgcn_rcpf(d.y);
    return (g * u) * r;
}
template <bool SCALE> struct EpiSwiGLU {
    static constexpr bool PERM = true, AFTER_DRAIN = false, KSCALE = false;
    bf16_t* H; int ldh; const float* ss;
    __device__ __forceinline__ void prefetch(const Unit& u, int wr, int fr, float (&rsv)[8]) const {
        const int row0 = u.pm * BM + wr * 64 + fr;
#pragma unroll
        for (int q = 0; q < 8; ++q) rsv[q] = SCALE ? ss[row0 + (q >> 2) * HALF + (q & 3) * 16] : 0.f;
    }
    __device__ __forceinline__ void operator()(const f32x4 (&acc)[2][2][4][2], const Unit& u, int wr, int wc, int fr, int fq, const float (&rsv)[8]) const {
        const int row0 = u.pm * BM + wr * 64 + fr, col0 = u.pn * HALF + wc * 32 + 8 * fq;
#pragma unroll
        for (int ai = 0; ai < 2; ++ai)
#pragma unroll
            for (int m = 0; m < 4; ++m) {
                const int row = row0 + ai * HALF + m * 16;
                f32x4 g0 = acc[ai][0][m][0], g1 = acc[ai][0][m][1], u0 = acc[ai][1][m][0], u1 = acc[ai][1][m][1];
                if (SCALE) { const float rs = rsqrtf(rsv[ai * 4 + m] * (1.0f / 1024.0f) + 1e-6f); g0 = g0 * rs; g1 = g1 * rs; u0 = u0 * rs; u1 = u1 * rs; }
                const f32x2 h0 = swiglu_pk((f32x2){g0[0], g0[1]}, (f32x2){u0[0], u0[1]}), h1 = swiglu_pk((f32x2){g0[2], g0[3]}, (f32x2){u0[2], u0[3]}),
                            h2 = swiglu_pk((f32x2){g1[0], g1[1]}, (f32x2){u1[0], u1[1]}), h3 = swiglu_pk((f32x2){g1[2], g1[3]}, (f32x2){u1[2], u1[3]});
                u32x4 w; w.x = cvt_pk_bf16(h0.x, h0.y); w.y = cvt_pk_bf16(h1.x, h1.y); w.z = cvt_pk_bf16(h2.x, h2.y); w.w = cvt_pk_bf16(h3.x, h3.y);
                *(u32x4*)(H + (size_t)row * ldh + col0) = w;
            }
    }
};
struct EpiProj {
    static constexpr bool PERM = true, AFTER_DRAIN = false, KSCALE = false;
    bf16_t* P; int ldp; const float* ss; float* dtb; int npn; int skip; int pn_u0;
    __device__ __forceinline__ void prefetch(const Unit& u, int wr, int fr, float (&rsv)[8]) const {
        const int row0 = u.pm * BM + wr * 64 + fr;
#pragma unroll
        for (int q = 0; q < 8; ++q) rsv[q] = ss[row0 + (q >> 2) * HALF + (q & 3) * 16];
    }
    __device__ __forceinline__ void operator()(const f32x4 (&acc)[2][2][4][2], const Unit& u, int wr, int wc, int fr, int fq, const float (&rsv)[8]) const {
        if (skip) return;
        const int row0 = u.pm * BM + wr * 64 + fr, col0 = u.pn * BM + wc * 32 + 8 * fq;
#pragma unroll
        for (int ai = 0; ai < 2; ++ai)
#pragma unroll
            for (int m = 0; m < 4; ++m) {
                const int row = row0 + ai * HALF + m * 16;
                const float rs = rsqrtf(rsv[ai * 4 + m] * (1.0f / 1024.0f) + 1e-6f);
                if (u.pn >= pn_u0 && u.pn < npn) {
                    const f32x4 c0 = acc[ai][0][m][0] * rs, c1 = acc[ai][0][m][1] * rs, h0 = acc[ai][1][m][0] * rs, h1 = acc[ai][1][m][1] * rs; u32x4 w;
                    w.x = cvt_pk_bf16(c0[0] * h0[0], c0[1] * h0[1]); w.y = cvt_pk_bf16(c0[2] * h0[2], c0[3] * h0[3]); w.z = cvt_pk_bf16(c1[0] * h1[0], c1[1] * h1[1]); w.w = cvt_pk_bf16(c1[2] * h1[2], c1[3] * h1[3]);
                    *(u32x4*)(P + (size_t)row * ldp + pn_u0 * BM + (u.pn - pn_u0) * HALF + wc * 32 + 8 * fq) = w;
                } else if (u.pn < npn) {
#pragma unroll
                    for (int bj = 0; bj < 2; ++bj) { f32x4 v0 = acc[ai][bj][m][0] * rs, v1 = acc[ai][bj][m][1] * rs; u32x4 w;
                        if (u.pn < 4) {
#pragma unroll
                            for (int e = 0; e < 4; ++e) { v0[e] = silu_f(v0[e]); v1[e] = silu_f(v1[e]); } }
                        w.x = cvt_pk_bf16(v0[0], v0[1]); w.y = cvt_pk_bf16(v0[2], v0[3]); w.z = cvt_pk_bf16(v1[0], v1[1]); w.w = cvt_pk_bf16(v1[2], v1[3]);
                        *(u32x4*)(P + (size_t)row * ldp + col0 + bj * HALF) = w; }
                } else if (wc == 0 && fq < 2) {
                    *(f32x4*)(dtb + (size_t)row * 16 + 8 * fq) = acc[ai][0][m][0] * rs; *(f32x4*)(dtb + (size_t)row * 16 + 8 * fq + 4) = acc[ai][0][m][1] * rs;
                }
            }
    }
};
template <bool KS> struct EpiResT {
    static constexpr bool PERM = false, AFTER_DRAIN = false, KSCALE = KS;
    const float* base; float* out; float scale; bf16_t* xw; const float* wn; float* ss; const float* ssgp; const bf16_t* bbase; const float* bw;
    __device__ __forceinline__ void unit_begin(const Unit& u, PG8_LAS unsigned char* lds) const {
        PG8_LAS float* R = (PG8_LAS float*)(lds + STAGE_BYTES); const int t = threadIdx.x, row = t >> 1, g = t & 1;
        const f32x4* pp = (const f32x4*)(ssgp + ((size_t)(u.pm * BM + row) * 2 + g) * 16); const f32x4 q4 = (pp[0] + pp[1]) + (pp[2] + pp[3]);
        R[row * 2 + g] = rsqrtf(((q4[0] + q4[1]) + (q4[2] + q4[3])) * (1.0f / 512.0f) + 1e-6f);
    }
    __device__ __forceinline__ void kscale(int t, f32x4 (&acc)[2][2][4][2], int wr, int fr, PG8_LAS unsigned char* lds) const {
        const PG8_LAS float* R = (const PG8_LAS float*)(lds + STAGE_BYTES);
#pragma unroll
        for (int ai = 0; ai < 2; ++ai)
#pragma unroll
            for (int m = 0; m < 4; ++m) { const int r = ai * HALF + wr * 64 + m * 16 + fr; const float r0 = R[r * 2], r1 = R[r * 2 + 1]; const float f = (t == 8) ? r0 * __builtin_amdgcn_rcpf(r1) : r1;
#pragma unroll
                for (int bj = 0; bj < 2; ++bj)
#pragma unroll
                    for (int n = 0; n < 2; ++n) acc[ai][bj][m][n] = acc[ai][bj][m][n] * f; }
    }
    __device__ __forceinline__ void prefetch(const Unit&, int, int, float (&rsv)[8]) const {
#pragma unroll
        for (int q = 0; q < 8; ++q) rsv[q] = 0.f;
    }
    __device__ __forceinline__ void operator()(const f32x4 (&acc)[2][2][4][2], const Unit& u, int wr, int wc, int fr, int fq, const float (&)[8]) const {
        const int row0 = u.pm * BM + wr * 64 + fr, col0 = u.pn * BM + wc * 32 + 4 * fq;
        f32x4 w4[2][2];
#pragma unroll
        for (int bj = 0; bj < 2; ++bj)
#pragma unroll
            for (int n = 0; n < 2; ++n) w4[bj][n] = (xw && wn) ? *(const f32x4*)(wn + col0 + bj * HALF + n * 16) : (f32x4){1.f, 1.f, 1.f, 1.f};
        f32x4 winv[2][2];
#pragma unroll
        for (int bj = 0; bj < 2; ++bj)
#pragma unroll
            for (int n = 0; n < 2; ++n) { f32x4 t_ = {1.f, 1.f, 1.f, 1.f}; if (bbase) { const f32x4 q_ = *(const f32x4*)(bw + col0 + bj * HALF + n * 16); t_ = (f32x4){1.f / q_[0], 1.f / q_[1], 1.f / q_[2], 1.f / q_[3]}; } winv[bj][n] = t_; }
#pragma unroll
        for (int ai = 0; ai < 2; ++ai)
#pragma unroll
        for (int mh = 0; mh < 2; ++mh) {
            f32x4 bv[2][2][2];
#pragma unroll
            for (int mm = 0; mm < 2; ++mm)
#pragma unroll
                for (int bj = 0; bj < 2; ++bj)
#pragma unroll
                    for (int n = 0; n < 2; ++n) { const size_t o_ = (size_t)(row0 + ai * HALF + (2 * mh + mm) * 16) * 1024 + col0 + bj * HALF + n * 16;
                        if (bbase) { const u32x2 r_ = *(const u32x2*)(bbase + o_); bv[mm][bj][n] = (f32x4){__uint_as_float(r_.x << 16), __uint_as_float(r_.x & 0xffff0000u), __uint_as_float(r_.y << 16), __uint_as_float(r_.y & 0xffff0000u)} * winv[bj][n]; }
                        else bv[mm][bj][n] = *(const f32x4*)(base + o_); }
#pragma unroll
            for (int mm = 0; mm < 2; ++mm) {
                const int m = 2 * mh + mm, row = row0 + ai * HALF + m * 16; float s = 0.f;
#pragma unroll
                for (int bj = 0; bj < 2; ++bj)
#pragma unroll
                    for (int n = 0; n < 2; ++n) { const int col = col0 + bj * HALF + n * 16; const size_t off = (size_t)row * 1024 + col;
                        const f32x4 v = bv[mm][bj][n] + acc[ai][bj][m][n] * scale; if (out) *(f32x4*)(out + off) = v;
                        s += (v[0] * v[0] + v[1] * v[1]) + (v[2] * v[2] + v[3] * v[3]);
                        if (xw) { const f32x4 ww = w4[bj][n]; u32x2 p; p.x = cvt_pk_bf16(v[0] * ww[0], v[1] * ww[1]); p.y = cvt_pk_bf16(v[2] * ww[2], v[3] * ww[3]); *(u32x2*)(xw + off) = p; } }
                if (ss) { s += __shfl_xor(s, 16); s += __shfl_xor(s, 32); if (fq == 0) atomicAdd(ss + row, s); }
            }
        }
    }
};
typedef EpiResT<false> EpiRes;

template <class Epi, class Sched, bool ALIGN_EPI = false, bool SP2 = false>
__device__ __forceinline__ void gemm_phase(PG8_LAS unsigned char* lds, const Gemm g, const Sched& S, const Epi& E) {
    const int tid = threadIdx.x, wid = __builtin_amdgcn_readfirstlane(tid >> 6), lane = tid & 63, wr = wid >> 2, wc = wid & 3, fr = lane & 15, fq = lane >> 4;
    const int K = g.K, nt = K / BK;
    unsigned voffA[2], voffB[2];
#pragma unroll
    for (int i = 0; i < 2; ++i) { int R, C; stage_rc(tid * 16 + i * 8192, R, C); const int Rb = Epi::PERM ? ((R & ~31) + perm32(R & 31)) : R;
        voffA[i] = (unsigned)(R * g.lda + C) * 2u; voffB[i] = (unsigned)(Rb * K + C) * 2u; }
    const size_t kstep = (size_t)(BK * 2);
    const size_t hstepA = (size_t)HALF * g.lda * 2, hstepB = (size_t)HALF * K * 2;
    const size_t tstepA = 2 * hstepA, tstepB = 2 * hstepB;
    const unsigned ldsw = (unsigned)wid * 1024u;
    const int aoff = lds_byte(wr * 64 + fr, fq * 8), boff = lds_byte(wc * 32 + fr, fq * 8);
#define PG8_SA(b, h) (((b) * 2 + (h)) * HTB)
#define PG8_SB(b, h) ((4 + (b) * 2 + (h)) * HTB)
#define PG8_STAGE(bufoff, gbase, voff) do { _Pragma("unroll") for (int _i = 0; _i < 2; ++_i) \
        __builtin_amdgcn_global_load_lds((const unsigned*)((const char*)(gbase) + (voff)[_i]), (PG8_LAS unsigned*)(lds + (bufoff) + ldsw + _i * 8192), 16, 0, 0); } while (0)
#define PG8_LDA(dst, b, h) do { _Pragma("unroll") for (int m = 0; m < 4; ++m) _Pragma("unroll") for (int k = 0; k < 2; ++k) dst[m][k] = *(const PG8_LAS bf16x8*)(lds + PG8_SA(b, h) + aoff + m * 2048 + k * 1024); } while (0)
#define PG8_LDB(dst, b, h) do { _Pragma("unroll") for (int n = 0; n < 2; ++n) _Pragma("unroll") for (int k = 0; k < 2; ++k) dst[n][k] = *(const PG8_LAS bf16x8*)(lds + PG8_SB(b, h) + boff + n * 2048 + k * 1024); } while (0)
#define PG8_MMA(ai, bj, At, Bt) do { __builtin_amdgcn_s_setprio(1); _Pragma("unroll") for (int m = 0; m < 4; ++m) _Pragma("unroll") for (int n = 0; n < 2; ++n) _Pragma("unroll") for (int k = 0; k < 2; ++k) \
        acc[ai][bj][m][n] = __builtin_amdgcn_mfma_f32_16x16x32_bf16(Bt[n][k], At[m][k], acc[ai][bj][m][n], 0, 0, 0); __builtin_amdgcn_s_setprio(0); } while (0)
#define PG8_WAIT_V(n) asm volatile("s_waitcnt vmcnt(" #n ")" ::: "memory")
#define PG8_WAIT_L(n) asm volatile("s_waitcnt lgkmcnt(" #n ")" ::: "memory")
#define PG8_BAR __builtin_amdgcn_s_barrier()
#define PG8_SCHED __builtin_amdgcn_sched_barrier(0)
    Unit cur, nxt; int ui = 0;
    if (!S.next(0, cur)) return;
    f32x4 acc[2][2][4][2];
#pragma unroll
    for (int a = 0; a < 2; ++a)
#pragma unroll
        for (int b = 0; b < 2; ++b)
#pragma unroll
            for (int m = 0; m < 4; ++m)
#pragma unroll
                for (int n = 0; n < 2; ++n) acc[a][b][m][n] = (f32x4){0.f, 0.f, 0.f, 0.f};
    bf16x8 At[4][2], B0[2][2], B1[2][2];
    const char* cA = (const char*)g.A + (size_t)cur.pm * tstepA; const char* cB = (const char*)g.Bt + (size_t)cur.pn * tstepB;
    S.a_ready(cur);
    if constexpr (SP2) {
        PG8_STAGE(PG8_SB(0, 0), cB, voffB); PG8_STAGE(PG8_SB(0, 1), cB + hstepB, voffB); PG8_STAGE(PG8_SA(0, 0), cA, voffA); PG8_STAGE(PG8_SA(0, 1), cA + hstepA, voffA);
        if (wr == 1) PG8_BAR;
        PG8_WAIT_V(2); PG8_BAR;
        PG8_STAGE(PG8_SB(1, 0), cB + kstep, voffB); PG8_STAGE(PG8_SA(1, 0), cA + kstep, voffA); PG8_STAGE(PG8_SB(1, 1), cB + hstepB + kstep, voffB);
        PG8_WAIT_V(6); PG8_BAR;
    } else {
        PG8_STAGE(PG8_SB(0, 0), cB, voffB); PG8_STAGE(PG8_SA(0, 0), cA, voffA); PG8_STAGE(PG8_SB(0, 1), cB + hstepB, voffB); PG8_STAGE(PG8_SA(0, 1), cA + hstepA, voffA);
        if (wr == 1) PG8_BAR;
        PG8_WAIT_V(4); PG8_BAR;
        PG8_STAGE(PG8_SB(1, 0), cB + kstep, voffB); PG8_STAGE(PG8_SA(1, 0), cA + kstep, voffA); PG8_STAGE(PG8_SB(1, 1), cB + hstepB + kstep, voffB);
        PG8_WAIT_V(6); PG8_BAR;
    }
    for (;;) {
        const bool has_next = S.next(ui + 1, nxt);
        const char* nA = has_next ? (const char*)g.A + (size_t)nxt.pm * tstepA : cA; const char* nB = has_next ? (const char*)g.Bt + (size_t)nxt.pn * tstepB : cB;
        float rsv[8]; E.prefetch(cur, wr, fr, rsv);
        if constexpr (Epi::KSCALE) E.unit_begin(cur, lds);
        for (int t = 0; t < nt; t += 2) {
            if constexpr (Epi::KSCALE) { if (t == 8 || t == 16) E.kscale(t, acc, wr, fr, lds); }
            const bool last = (t == nt - 2);
            const char* a1 = cA + (size_t)(t + 1) * kstep;
            const char* a2 = last ? nA : cA + (size_t)(t + 2) * kstep; const char* b2 = last ? nB : cB + (size_t)(t + 2) * kstep;
            const char* a3 = a2 + kstep; const char* b3 = b2 + kstep;
            if (last && has_next) S.a_ready(nxt);
            if constexpr (SP2) {
            PG8_LDB(B0, 0, 0); PG8_LDB(B1, 0, 1); PG8_SCHED; PG8_LDA(At, 0, 0); PG8_STAGE(PG8_SA(1, 1), a1 + hstepA, voffA);
            PG8_WAIT_V(8); PG8_WAIT_L(0); PG8_BAR; PG8_MMA(0, 0, At, B0); PG8_MMA(0, 1, At, B1); PG8_BAR; PG8_SCHED;
            PG8_LDA(At, 0, 1); PG8_STAGE(PG8_SB(0, 0), b2, voffB); PG8_STAGE(PG8_SB(0, 1), b2 + hstepB, voffB); PG8_STAGE(PG8_SA(0, 0), a2, voffA);
            PG8_WAIT_V(8); PG8_WAIT_L(0); PG8_BAR; PG8_MMA(1, 0, At, B0); PG8_MMA(1, 1, At, B1); PG8_BAR; PG8_SCHED;
            PG8_LDB(B0, 1, 0); PG8_LDB(B1, 1, 1); PG8_SCHED; PG8_LDA(At, 1, 0); PG8_STAGE(PG8_SA(0, 1), a2 + hstepA, voffA);
            PG8_WAIT_V(8); PG8_WAIT_L(0); PG8_BAR; PG8_MMA(0, 0, At, B0); PG8_MMA(0, 1, At, B1); PG8_BAR; PG8_SCHED;
            PG8_LDA(At, 1, 1); PG8_STAGE(PG8_SB(1, 0), b3, voffB); PG8_STAGE(PG8_SB(1, 1), b3 + hstepB, voffB); PG8_STAGE(PG8_SA(1, 0), a3, voffA);
            PG8_WAIT_V(8); PG8_WAIT_L(0); PG8_BAR; PG8_MMA(1, 0, At, B0); PG8_MMA(1, 1, At, B1); PG8_BAR; PG8_SCHED;
            } else {
            PG8_LDB(B0, 0, 0); PG8_SCHED; PG8_LDA(At, 0, 0); PG8_STAGE(PG8_SA(1, 1), a1 + hstepA, voffA);
            PG8_WAIT_L(8); PG8_BAR; PG8_WAIT_L(0); PG8_MMA(0, 0, At, B0); PG8_BAR; PG8_SCHED;
            PG8_LDB(B1, 0, 1); PG8_STAGE(PG8_SB(0, 0), b2, voffB);
            PG8_BAR; PG8_WAIT_L(0); PG8_MMA(0, 1, At, B1); PG8_BAR;
            PG8_LDA(At, 0, 1); PG8_STAGE(PG8_SA(0, 0), a2, voffA);
            PG8_BAR; PG8_WAIT_L(0); PG8_MMA(1, 0, At, B0); PG8_BAR; PG8_SCHED;
            PG8_STAGE(PG8_SB(0, 1), b2 + hstepB, voffB);
            PG8_WAIT_V(6); PG8_BAR; PG8_MMA(1, 1, At, B1); PG8_BAR;
            PG8_LDB(B0, 1, 0); PG8_SCHED; PG8_LDA(At, 1, 0); PG8_STAGE(PG8_SA(0, 1), a2 + hstepA, voffA);
            PG8_WAIT_L(8); PG8_BAR; PG8_WAIT_L(0); PG8_MMA(0, 0, At, B0); PG8_BAR; PG8_SCHED;
            PG8_LDB(B1, 1, 1); PG8_STAGE(PG8_SB(1, 0), b3, voffB);
            PG8_BAR; PG8_WAIT_L(0); PG8_MMA(0, 1, At, B1); PG8_BAR;
            PG8_LDA(At, 1, 1); PG8_STAGE(PG8_SA(1, 0), a3, voffA);
            PG8_BAR; PG8_WAIT_L(0); PG8_MMA(1, 0, At, B0); PG8_BAR; PG8_SCHED;
            PG8_STAGE(PG8_SB(1, 1), b3 + hstepB, voffB);
            PG8_WAIT_V(6); PG8_BAR; PG8_MMA(1, 1, At, B1); PG8_BAR;
            }
        }
        if constexpr (ALIGN_EPI) { if (wr == 0) PG8_BAR; }
        if constexpr (!Epi::AFTER_DRAIN) { E(acc, cur, wr, wc, fr, fq, rsv); S.done(cur); }
        if (!has_next) break;
#pragma unroll
        for (int a = 0; a < 2; ++a)
#pragma unroll
            for (int b = 0; b < 2; ++b)
#pragma unroll
                for (int m = 0; m < 4; ++m)
#pragma unroll
                    for (int n = 0; n < 2; ++n) acc[a][b][m][n] = (f32x4){0.f, 0.f, 0.f, 0.f};
        cur = nxt; cA = nA; cB = nB; ++ui;
        if constexpr (ALIGN_EPI) { if (wr == 1) PG8_BAR; }
    }
    PG8_WAIT_V(0);
    if constexpr (!ALIGN_EPI) { if (wr == 0) PG8_BAR; }
    PG8_BAR;
    if constexpr (Epi::AFTER_DRAIN) { E.fused(acc, cur, wr, wc, fr, fq, lds, wid, lane); S.done(cur); }
#undef PG8_SA
#undef PG8_SB
#undef PG8_STAGE
#undef PG8_LDA
#undef PG8_LDB
#undef PG8_MMA
#undef PG8_WAIT_V
#undef PG8_WAIT_L
#undef PG8_BAR
#undef PG8_SCHED
}
}
#define LAS __attribute__((address_space(3)))
typedef unsigned short bf16;
typedef short bf16x8 __attribute__((ext_vector_type(8)));
typedef float f32x4 __attribute__((ext_vector_type(4)));
typedef float f32x16 __attribute__((ext_vector_type(16)));
typedef unsigned v4u __attribute__((ext_vector_type(4)));
typedef unsigned v2u __attribute__((ext_vector_type(2)));
constexpr int NWAVES = 8, NTHR = 512;
constexpr int DM = 1024, NBATCH = 8, SEQ = 2048, MP = NBATCH * SEQ, NS = 128, MT = MP + NS, MPAD = 16640;
constexpr int DFF = 2816, NGU = 2 * DFF, DMIX = 2048, NINP = 5888, LDPJ = 5632, DINP = 5648, CONVD = 1536;
constexpr int PC_Z = 0, PC_SCB = 1024, PC_XBC = 2048, PC_SCC = 3584, PC_SCH = 4608;
constexpr float EPS = 1e-6f;
constexpr size_t MiB = 1u << 20;
constexpr size_t WS_W2GU = 0, WS_W2D = 11 * MiB, WS_WOUT = WS_W2D + 5632 * 1024, WS_WIN = WS_WOUT + 4 * MiB, WS_XW = 32 * MiB;
constexpr size_t WS_SMALL = WS_XW + (size_t)MPAD * DM * 2;
constexpr size_t SM_SS2 = 0, SM_SS3 = 128 * 1024, SM_SSG = 256 * 1024, SM_DT = 512 * 1024;
constexpr size_t WS_PROJ = WS_SMALL + 2 * MiB;
constexpr size_t WS_W1GU = WS_PROJ, WS_W1D = WS_W1GU + 11 * MiB, WS_H = WS_W1D + 5632 * 1024;
constexpr size_t WS_END = WS_PROJ + (size_t)MPAD * LDPJ * 2;
constexpr size_t WS_BAR = WS_END, WS_SSGP = WS_BAR + 64 * 1024, WS_END2 = WS_SSGP + (size_t)MPAD * 2 * 16 * 4;
constexpr size_t WS_BCB = WS_WIN, WS_BCC = WS_END2, WS_END3 = WS_BCC + (size_t)MP * 256 * 2;
constexpr long BC_CDELTA = (long)((WS_BCC - WS_BCB) / 2);
static_assert(WS_END3 <= 256 * MiB && (size_t)MP * 256 * 2 <= (size_t)NINP * DM * 2, "d_ws map 2");
static_assert(WS_WIN + (size_t)NINP * DM * 2 <= WS_XW && WS_H + (size_t)MPAD * DFF * 2 <= WS_END && SM_DT + (size_t)MPAD * 16 * 4 <= 2 * MiB && WS_END <= 256 * MiB, "d_ws map");
constexpr size_t O_Y = 0, O_SSMP = (size_t)MT * DM, O_CONVP = O_SSMP + (size_t)NBATCH * 16 * 64 * 128, O_SCP = O_CONVP + (size_t)NBATCH * 3 * CONVD,
                 O_SSMS = O_SCP + (size_t)NBATCH * 2 * 1024, O_CONVS = O_SSMS + (size_t)NS * 16 * 64 * 128, O_SCS = O_CONVS + (size_t)NS * 3 * CONVD, O_END = O_SCS + (size_t)NS * 2 * 1024;
constexpr int LDS_BYTES = 147456;
constexpr int LDP = 136;
constexpr int CL_OFF = 0, BL_OFF = 128 * LDP * 2, BT_OFF = 2 * BL_OFF, XDT_OFF = 3 * BL_OFF, XDD_OFF = XDT_OFF + 32 * LDP * 2, SENT_OFF = XDD_OFF + 32 * LDP * 2,
              XS_OFF = SENT_OFF + 32 * LDP * 2, ACUM_OFF = XS_OFF + 128 * 32 * 2, DTV_OFF = ACUM_OFF + 1024, WBC_OFF = DTV_OFF + 1024, WX_OFF = WBC_OFF + 5 * 256 * 4, SSD_LDS_END = WX_OFF + 5 * 32 * 4;
static_assert(SSD_LDS_END <= LDS_BYTES, "LDS map");

struct Args { const float* in[24]; float* out; unsigned char* ws; int ph_lo, ph_hi, flags, pad; };
enum { I_XP = 0, I_XS, I_SSM, I_SCONV0, I_SSCONV, I_N1W, I_F1G, I_F1U, I_F1D, I_NMW, I_WIN, I_CW, I_CB, I_DTB, I_ALOG, I_DSKIP, I_SNW, I_SCW, I_WOUT, I_N2W, I_F2G, I_F2U, I_F2D, I_FNW };

__device__ __forceinline__ float bf2f(unsigned short b) { return __uint_as_float((unsigned)b << 16); }
__device__ __forceinline__ unsigned pk2(float lo, float hi) { return pg8::cvt_pk_bf16(lo, hi); }
__device__ __forceinline__ unsigned short f2bf1(float f) { return (unsigned short)(pg8::cvt_pk_bf16(f, 0.f) & 0xffffu); }
__device__ __forceinline__ float silu(float v) { return pg8::silu_f(v); }
__device__ __forceinline__ float softplus(float x) { return x > 20.f ? x : log1pf(__expf(x)); }
__device__ __forceinline__ float softplus_fast(float x) { const float e = __expf(x); return x > 20.f ? x : (e < 0.03125f ? e * (1.f + e * (-0.5f + e * (0.33333333f - 0.25f * e))) : __logf(1.f + e)); }
__device__ __forceinline__ float wave_sum(float v) {
#pragma unroll
    for (int o = 1; o < 64; o <<= 1) v += __shfl_xor(v, o);
    return v;
}
__device__ __forceinline__ void unpack8(const v4u r, float (&f)[8]) {
#pragma unroll
    for (int i = 0; i < 4; ++i) { f[2 * i] = __uint_as_float(r[i] << 16); f[2 * i + 1] = __uint_as_float(r[i] & 0xffff0000u); }
}
#define LDS_WAIT() asm volatile("s_waitcnt lgkmcnt(0)" ::: "memory")
#define MFMA32(a, b, c) __builtin_amdgcn_mfma_f32_32x32x16_bf16((a), (b), (c), 0, 0, 0)

__device__ __forceinline__ void p0_item(const float* W, int K, int Nsrc, int src_col0, int nvalid, bf16* WT, int dst_row0, int kb, LAS float* scr, int lane, const float* rscale = nullptr) {
    const int k0 = 64 * kb, nl = lane & 31; const bool ok = nl < nvalid;
#pragma unroll
    for (int i = 0; i < 32; ++i) { const int kk = 2 * i + (lane >> 5); float v = ok ? __builtin_nontemporal_load(W + (size_t)(k0 + kk) * Nsrc + src_col0 + nl) : 0.f;   if (rscale && k0 + kk < 1024) v *= rscale[k0 + kk]; scr[kk * 33 + nl] = v; }
    LDS_WAIT();
    const int c = lane & 7;
#pragma unroll
    for (int j = 0; j < 4; ++j) { const int n = (lane >> 3) + 8 * j; const LAS float* s = scr + (8 * c) * 33 + n;
        v4u o; o.x = pk2(s[0 * 33], s[1 * 33]); o.y = pk2(s[2 * 33], s[3 * 33]); o.z = pk2(s[4 * 33], s[5 * 33]); o.w = pk2(s[6 * 33], s[7 * 33]);
        *(v4u*)(WT + (size_t)(dst_row0 + n) * K + k0 + 8 * c) = o; }
    LDS_WAIT();
}
constexpr int P0_I_GU = 176 * 16, P0_I_D = 32 * 44, P0_I_IN = 184 * 16, P0_I_O = 32 * 32, P0_NITEMS = 2 * P0_I_GU + 2 * P0_I_D + P0_I_IN + P0_I_O;
__device__ __forceinline__ void p0_do_item(const Args& a, int it, LAS float* scr, int lane) {
    unsigned char* ws = a.ws; int r = it;
    if (r < 2 * P0_I_GU) {
        const int which = r >= P0_I_GU; r -= which * P0_I_GU; const int kb = r / 176, nb = r % 176, tile = nb >> 3, sub = nb & 7, bj = sub >> 2, c0 = (sub & 3) * 32;
        const float* W = which ? (bj ? a.in[I_F2U] : a.in[I_F2G]) : (bj ? a.in[I_F1U] : a.in[I_F1G]);
        p0_item(W, DM, DFF, tile * 128 + c0, 32, (bf16*)(ws + (which ? WS_W2GU : WS_W1GU)), nb * 32, kb, scr, lane); return; }
    r -= 2 * P0_I_GU;
    if (r < 2 * P0_I_D) { const int which = r >= P0_I_D; r -= which * P0_I_D; const int kb = r / 32, nb = r % 32;
        p0_item(which ? a.in[I_F2D] : a.in[I_F1D], DFF, DM, nb * 32, 32, (bf16*)(ws + (which ? WS_W2D : WS_W1D)), nb * 32, kb, scr, lane); return; }
    r -= 2 * P0_I_D;
    if (r < P0_I_IN) { const int kb = r / 184, nb = r % 184, n = nb * 32; int src, nv = 32;
        if (n < 1024) src = n; else if (n < 2048) src = 2576 + (n - 1024); else if (n < 3584) src = 1024 + (n - 2048); else if (n < 5632) { const int tl_ = (n - 3584) >> 8, w_ = (n - 3584) & 255; src = w_ < 128 ? 3600 + 128 * tl_ + w_ : 4624 + 128 * tl_ + (w_ - 128); }
        else if (n == 5632) { src = 2560; nv = 16; } else { src = 0; nv = 0; }
        p0_item(a.in[I_WIN], DM, DINP, src, nv, (bf16*)(ws + WS_WIN), n, kb, scr, lane); return; }
    r -= P0_I_IN;
    { const int kb = r / 32, nb = r % 32; p0_item(a.in[I_WOUT], DMIX, DM, nb * 32, 32, (bf16*)(ws + WS_WOUT), nb * 32, kb, scr, lane, a.in[I_SNW]); }
}
__device__ __forceinline__ void p0_late_weights(const Args& a, LAS unsigned char* lds, int gw, int NGW, int wave, int lane) {
    LAS float* scr = (LAS float*)(lds + wave * 16384);
    constexpr int NL = P0_I_GU + P0_I_D + P0_I_O;
    for (int i = gw; i < NL; i += NGW) {
        const int it = i < P0_I_GU ? P0_I_GU + i : (i < P0_I_GU + P0_I_D ? 2 * P0_I_GU + P0_I_D + (i - P0_I_GU) : 2 * P0_I_GU + 2 * P0_I_D + P0_I_IN + (i - P0_I_GU - P0_I_D));
        p0_do_item(a, it, scr, lane); }
}
__device__ __forceinline__ void p0_prologue(const Args& a, LAS unsigned char* lds, int gw, int NGW, int wave, int lane) {
    LAS float* scr = (LAS float*)(lds + wave * 16384);
    unsigned char* ws = a.ws;
    constexpr int NE = P0_I_GU + P0_I_D + P0_I_IN;
    for (int i = gw; i < NE; i += NGW) {
        const int it = i < P0_I_GU ? i : (i < P0_I_GU + P0_I_D ? 2 * P0_I_GU + (i - P0_I_GU) : 2 * P0_I_GU + 2 * P0_I_D + (i - P0_I_GU - P0_I_D));
        p0_do_item(a, it, scr, lane); }
    bf16* XW = (bf16*)(ws + WS_XW);
    for (int m0 = gw; m0 < MPAD; m0 += 2 * NGW) {
        f32x4 v[2][4]; float sq[2] = {0.f, 0.f};
#pragma unroll
        for (int q = 0; q < 2; ++q) { const int m = m0 + q * NGW, mc = m < MT ? m : MT - 1;
            const float* xrow = mc < MP ? a.in[I_XP] + (size_t)mc * DM : a.in[I_XS] + (size_t)(mc - MP) * DM; const f32x4* xr = (const f32x4*)xrow + lane;
#pragma unroll
            for (int j = 0; j < 4; ++j) v[q][j] = __builtin_nontemporal_load(xr + 64 * j); }
#pragma unroll
        for (int q = 0; q < 2; ++q) { const float keep = (m0 + q * NGW < MT) ? 1.f : 0.f;
#pragma unroll
            for (int j = 0; j < 4; ++j) v[q][j] = v[q][j] * keep; }
        const f32x4* wr = (const f32x4*)a.in[I_N1W] + lane;
#pragma unroll
        for (int q = 0; q < 2; ++q)
#pragma unroll
            for (int j = 0; j < 4; ++j) sq[q] += (v[q][j].x * v[q][j].x + v[q][j].y * v[q][j].y) + (v[q][j].z * v[q][j].z + v[q][j].w * v[q][j].w);
#pragma unroll
        for (int q = 0; q < 2; ++q) { const int m = m0 + q * NGW; if (m >= MPAD) continue;
            const float rstd = rsqrtf(wave_sum(sq[q]) * (1.f / DM) + EPS);
            unsigned long long* o8 = (unsigned long long*)(XW + (size_t)m * DM) + lane;
#pragma unroll
            for (int j = 0; j < 4; ++j) { const f32x4 w4 = wr[64 * j]; o8[64 * j] = (unsigned long long)pk2(v[q][j].x * rstd * w4.x, v[q][j].y * rstd * w4.y) | ((unsigned long long)pk2(v[q][j].z * rstd * w4.z, v[q][j].w * rstd * w4.w) << 32); } }
    }
    { f32x4* z = (f32x4*)(ws + WS_SMALL); const int n16 = (int)(SM_DT / 16); for (int i = gw * 64 + lane; i < n16; i += NGW * 64) z[i] = (f32x4){0.f, 0.f, 0.f, 0.f}; }
}

__device__ __forceinline__ void small_gemm(LAS unsigned char* lds, const bf16* A, int lda, const bf16* Bt, int K,
                                           const float* base, float* out, float scale, bf16* xw, const float* wn, float* ss, const float* ssgp_rows = nullptr, const bf16* bbase = nullptr, const float* bw = nullptr) {
    const int tid = threadIdx.x, wid = __builtin_amdgcn_readfirstlane(tid >> 6), lane = tid & 63, i = lane & 15, q = lane >> 4, ks = wid & 3, tl = wid >> 2;
    LAS f32x4* red = (LAS f32x4*)lds;
    const int kq = K >> 2;
    for (int t0 = blockIdx.x * 2; t0 < 512; t0 += gridDim.x * 2) {
        const int t = t0 + tl, tr = t >> 6, tc = t & 63;
        f32x4 acc = {0.f, 0.f, 0.f, 0.f};
        if (t < 512) {
            const bf16* ap = A + (size_t)(tr * 16 + i) * lda + ks * kq + 8 * q; const bf16* bp = Bt + (size_t)(tc * 16 + i) * K + ks * kq + 8 * q;
#pragma unroll 4
            for (int k = 0; k < kq; k += 32) { const bf16x8 av = *(const bf16x8*)(ap + k), bv = *(const bf16x8*)(bp + k); acc = __builtin_amdgcn_mfma_f32_16x16x32_bf16(bv, av, acc, 0, 0, 0); }
        }
        if (ssgp_rows && ks < 2 && t < 512) {
            const f32x4* pp = (const f32x4*)(ssgp_rows + ((size_t)(tr * 16 + i) * 2 + ks) * 16); const f32x4 q4 = (pp[0] + pp[1]) + (pp[2] + pp[3]);
            acc = acc * rsqrtf(((q4[0] + q4[1]) + (q4[2] + q4[3])) * (1.0f / 512.0f) + 1e-6f); }
        red[(tl * 4 + ks) * 64 + lane] = acc;
        __syncthreads();
        if (ks == 0 && t < 512) {
            const f32x4 sum = (red[(tl * 4 + 0) * 64 + lane] + red[(tl * 4 + 1) * 64 + lane]) + (red[(tl * 4 + 2) * 64 + lane] + red[(tl * 4 + 3) * 64 + lane]);
            const int row = tr * 16 + i, col = tc * 16 + 4 * q; const size_t off = (size_t)row * 1024 + col;
            f32x4 bs_;
            if (bbase) { const v2u r_ = *(const v2u*)(bbase + off); const f32x4 q_ = *(const f32x4*)(bw + col);
                bs_ = (f32x4){__uint_as_float(r_.x << 16) / q_[0], __uint_as_float(r_.x & 0xffff0000u) / q_[1], __uint_as_float(r_.y << 16) / q_[2], __uint_as_float(r_.y & 0xffff0000u) / q_[3]}; }
            else bs_ = *(const f32x4*)(base + off);
            const f32x4 v = bs_ + sum * scale; if (out) *(f32x4*)(out + off) = v;
            float s = (v[0] * v[0] + v[1] * v[1]) + (v[2] * v[2] + v[3] * v[3]);
            if (xw) { const f32x4 w4 = wn ? *(const f32x4*)(wn + col) : (f32x4){1.f, 1.f, 1.f, 1.f}; v2u p; p.x = pk2(v[0] * w4[0], v[1] * w4[1]); p.y = pk2(v[2] * w4[2], v[3] * w4[3]); *(v2u*)(xw + off) = p; }
            if (ss) { s += __shfl_xor(s, 16); s += __shfl_xor(s, 32); if (q == 0) atomicAdd(ss + row, s); }
        }
        __syncthreads();
    }
}

__device__ __forceinline__ void bc_conv_prepass(const Args& a, int gw, int NGW, int lane) {
    const bf16* proj = (const bf16*)(a.ws + WS_PROJ); bf16* BCB = (bf16*)(a.ws + WS_BCB);
    const float* cw = a.in[I_CW] + 1024 + 8 * lane; const float* cb = a.in[I_CB] + 1024 + 8 * lane;
    float w[4][8], bi[8];
#pragma unroll
    for (int k = 0; k < 4; ++k) { const f32x4 w0 = *(const f32x4*)(cw + k * CONVD), w1 = *(const f32x4*)(cw + k * CONVD + 4);
        w[k][0] = w0[0]; w[k][1] = w0[1]; w[k][2] = w0[2]; w[k][3] = w0[3]; w[k][4] = w1[0]; w[k][5] = w1[1]; w[k][6] = w1[2]; w[k][7] = w1[3]; }
    { const f32x4 b0 = *(const f32x4*)(cb), b1 = *(const f32x4*)(cb + 4); bi[0] = b0[0]; bi[1] = b0[1]; bi[2] = b0[2]; bi[3] = b0[3]; bi[4] = b1[0]; bi[5] = b1[1]; bi[6] = b1[2]; bi[7] = b1[3]; }
    for (int u = gw; u < MP / 8; u += NGW) {
        const int row0 = u * 8, l0 = row0 & (SEQ - 1);
        const bf16* src = proj + (size_t)(row0 - 3) * LDPJ + PC_XBC + 1024 + 8 * lane;
        v4u raw[11];
#pragma unroll
        for (int rr = 0; rr < 11; ++rr) raw[rr] = (l0 - 3 + rr >= 0) ? *(const v4u*)(src + (size_t)rr * LDPJ) : (v4u){0u, 0u, 0u, 0u};
#pragma unroll
        for (int t = 0; t < 8; ++t) {
            float x0[8], x1[8], x2[8], x3[8], o[8]; unpack8(raw[t], x0); unpack8(raw[t + 1], x1); unpack8(raw[t + 2], x2); unpack8(raw[t + 3], x3);
#pragma unroll
            for (int j = 0; j < 8; ++j) o[j] = silu(bi[j] + w[0][j] * x0[j] + w[1][j] * x1[j] + w[2][j] * x2[j] + w[3][j] * x3[j]);
            v4u p; p.x = pk2(o[0], o[1]); p.y = pk2(o[2], o[3]); p.z = pk2(o[4], o[5]); p.w = pk2(o[6], o[7]);
            *(v4u*)(BCB + (lane < 32 ? 0 : BC_CDELTA) + (size_t)(row0 + t) * 256 + 8 * (lane & 31)) = p;
        }
    }
}

__device__ __forceinline__ int crow(int i, int hh) { return (i & 3) + 8 * (i >> 2) + 4 * hh; }
__device__ __forceinline__ void ssd_prompt(const Args& a, LAS unsigned char* lds, int unit) {
    const int tid0 = threadIdx.x, wid = __builtin_amdgcn_readfirstlane(tid0 >> 6);
    const int b = unit >> 5, h = (unit >> 1) & 15, ph = unit & 1, g = h >> 3;
    const float A_h = -__expf(a.in[I_ALOG][h]), dtb = a.in[I_DTB][h], Dh = a.in[I_DSKIP][h];
    bf16* proj = (bf16*)(a.ws + WS_PROJ); const float* dtbuf = (const float*)(a.ws + WS_SMALL + SM_DT); float* ssgp = (float*)(a.ws + WS_SSGP);
    LAS bf16* Cl = (LAS bf16*)(lds + CL_OFF); LAS bf16* Bl = (LAS bf16*)(lds + BL_OFF); LAS bf16* BT = (LAS bf16*)(lds + BT_OFF);
    LAS bf16* XDT = (LAS bf16*)(lds + XDT_OFF); LAS bf16* XDD = (LAS bf16*)(lds + XDD_OFF); LAS bf16* SENT = (LAS bf16*)(lds + SENT_OFF); LAS bf16* XS = (LAS bf16*)(lds + XS_OFF);
    LAS float* acum2 = (LAS float*)(lds + ACUM_OFF); LAS float* dtv2 = (LAS float*)(lds + DTV_OFF); LAS float* eac2 = (LAS float*)(lds + WBC_OFF); LAS float* WX = (LAS float*)(lds + WX_OFF);
    for (int i = tid0; i < 32 * LDP / 2; i += NTHR) ((LAS unsigned*)SENT)[i] = 0u;
    {
        const float* cw = a.in[I_CW]; const float* cb = a.in[I_CB];
        if (tid0 < 160) { const int k = tid0 >> 5, ch = h * 64 + 32 * ph + (tid0 & 31); WX[tid0] = k < 4 ? cw[k * CONVD + ch] : cb[ch]; }
    }
    const bf16* BCB = (const bf16*)(a.ws + WS_BCB);
    f32x16 st;
#pragma unroll
    for (int i = 0; i < 16; ++i) st[i] = 0.f;
    v4u nraw[8], nxraw[4]; float ndt0 = 0.f, ndt1 = 0.f;
    {
        const int tcol = tid0 & 15, tg = tid0 >> 4, xl = (tid0 & 15) | ((tid0 >> 6) << 4), xc = (tid0 >> 4) & 3;
        const bf16* src = BCB + (size_t)(b * SEQ + 4 * tg) * 256 + g * 128 + 8 * tcol;
#pragma unroll
        for (int rr = 0; rr < 4; ++rr) { nraw[rr] = *(const v4u*)(src + (size_t)rr * 256); nraw[4 + rr] = *(const v4u*)(src + BC_CDELTA + (size_t)rr * 256); }
        const bf16* srx = proj + (size_t)(b * SEQ + xl - 3) * LDPJ + PC_XBC + h * 64 + 32 * ph + 8 * xc;
#pragma unroll
        for (int rr = 0; rr < 4; ++rr) nxraw[rr] = (xl - 3 + rr >= 0) ? *(const v4u*)(srx + (size_t)rr * LDPJ) : (v4u){0u, 0u, 0u, 0u};
        if (wid == 4) { const int l0 = 2 * (tid0 & 63); ndt0 = dtbuf[(size_t)(b * SEQ + l0) * 16 + h]; ndt1 = dtbuf[(size_t)(b * SEQ + l0 + 1) * 16 + h]; }
    }
#define SSD_STAGE_D(buf) do { const int ln_ = tid0 & 63, l0_ = 2 * ln_; const float d0_ = softplus_fast(ndt0 + dtb), d1_ = softplus_fast(ndt1 + dtb), a0_ = d0_ * A_h, a1_ = d1_ * A_h, s_ = a0_ + a1_; float incl_ = s_; \
        _Pragma("unroll") for (int o_ = 1; o_ < 64; o_ <<= 1) { const float t_ = __shfl_up(incl_, o_); if (ln_ >= o_) incl_ += t_; } \
        const float c0_ = (incl_ - s_ + a0_) * 1.44269504f, c1_ = incl_ * 1.44269504f; acum2[(buf) * 128 + l0_] = c0_; acum2[(buf) * 128 + l0_ + 1] = c1_; eac2[(buf) * 128 + l0_] = __builtin_amdgcn_exp2f(c0_); eac2[(buf) * 128 + l0_ + 1] = __builtin_amdgcn_exp2f(c1_); dtv2[(buf) * 128 + l0_] = d0_; dtv2[(buf) * 128 + l0_ + 1] = d1_; } while (0)
    if (wid == 4) SSD_STAGE_D(0);
    __syncthreads();
    const bf16* p_bc; const bf16* p_x; bf16* p_z; const float* p_dt; float* p_sq;
    {   const int tcol = tid0 & 15, tg = tid0 >> 4, xl = (tid0 & 15) | ((tid0 >> 6) << 4), xc = (tid0 >> 4) & 3;
        p_bc = BCB + (size_t)(b * SEQ + 128 + 4 * tg) * 256 + g * 128 + 8 * tcol;
        p_x = proj + (size_t)(b * SEQ + 128 + xl - 3) * LDPJ + PC_XBC + h * 64 + 32 * ph + 8 * xc;
        p_z = proj + (size_t)(b * SEQ + xl) * LDPJ + PC_Z + h * 64 + 32 * ph + 8 * xc;
        p_dt = dtbuf + (size_t)(b * SEQ + 128 + 2 * (tid0 & 63)) * 16 + h;
        p_sq = ssgp + ((size_t)(b * SEQ + xl) * 2 + g) * 16 + (h & 7) * 2 + ph; }
#define SSD_BAR() do { asm volatile("s_waitcnt lgkmcnt(0)" ::: "memory"); __builtin_amdgcn_s_barrier(); asm volatile("" ::: "memory"); } while (0)
#pragma unroll 1
    for (int c = 0; c < 16; ++c) {
        int tid = tid0; asm volatile("" : "+v"(tid));
        const int lane = tid & 63, r = lane & 31, hh = lane >> 5;
        const int tcol = tid & 15, tg = tid >> 4;
        const int xl = (tid & 15) | ((tid >> 6) << 4), xc = (tid >> 4) & 3;
        const int tok0 = b * SEQ + c * 128;
        LAS float* acum = acum2 + (c & 1) * 128; LAS float* dtv = dtv2 + (c & 1) * 128; LAS float* eac = eac2 + (c & 1) * 128;
        {
#pragma unroll
            for (int t = 0; t < 4; ++t) { *(LAS v4u*)(Bl + (4 * tg + t) * LDP + 8 * tcol) = nraw[t]; *(LAS v4u*)(Cl + (4 * tg + t) * LDP + 8 * tcol) = nraw[4 + t]; }
            const int boff = 8 * ((tg >> 1) ^ tcol) + 4 * (tg & 1);
#pragma unroll
            for (int i = 0; i < 4; ++i) { v2u lo, hi;
#pragma unroll
                for (int u = 0; u < 2; ++u) { const unsigned e0 = nraw[2 * u][i], e1 = nraw[2 * u + 1][i]; lo[u] = (e0 & 0xffffu) | (e1 << 16); hi[u] = (e0 >> 16) | (e1 & 0xffff0000u); }
                *(LAS v2u*)(BT + (8 * tcol + 2 * i) * LDP + boff) = lo; *(LAS v2u*)(BT + (8 * tcol + 2 * i + 1) * LDP + boff) = hi; }
        }
        {
            float x0[8], x1[8], x2[8], x3[8]; unpack8(nxraw[0], x0); unpack8(nxraw[1], x1); unpack8(nxraw[2], x2); unpack8(nxraw[3], x3);
            float xo[8];
#pragma unroll
            for (int hf = 0; hf < 2; ++hf) { const f32x4 w0 = *(const LAS f32x4*)(WX + 0 * 32 + 8 * xc + 4 * hf), w1 = *(const LAS f32x4*)(WX + 1 * 32 + 8 * xc + 4 * hf), w2 = *(const LAS f32x4*)(WX + 2 * 32 + 8 * xc + 4 * hf),
                                                     w3 = *(const LAS f32x4*)(WX + 3 * 32 + 8 * xc + 4 * hf), bb = *(const LAS f32x4*)(WX + 4 * 32 + 8 * xc + 4 * hf);
#pragma unroll
                for (int e = 0; e < 4; ++e) { const int j = 4 * hf + e; xo[j] = silu(bb[e] + w0[e] * x0[j] + w1[e] * x1[j] + w2[e] * x2[j] + w3[e] * x3[j]); } }
            const float dl = dtv[xl], de = dl * __builtin_amdgcn_exp2f(acum[127] - acum[xl]);
            { v4u p; p.x = pk2(xo[0], xo[1]); p.y = pk2(xo[2], xo[3]); p.z = pk2(xo[4], xo[5]); p.w = pk2(xo[6], xo[7]); *(LAS v4u*)(XS + xl * 32 + 8 * xc) = p; }
#pragma unroll
            for (int j = 0; j < 8; ++j) { const unsigned pk = pk2(xo[j] * dl, xo[j] * de); XDT[(8 * xc + j) * LDP + xl] = (unsigned short)pk; XDD[(8 * xc + j) * LDP + xl] = (unsigned short)(pk >> 16); }
        }
        SSD_BAR();
        if (c < 15) {
#pragma unroll
            for (int rr = 0; rr < 4; ++rr) { nraw[rr] = *(const v4u*)(p_bc + (size_t)rr * 256); nraw[4 + rr] = *(const v4u*)(p_bc + BC_CDELTA + (size_t)rr * 256); }
#pragma unroll
            for (int rr = 0; rr < 4; ++rr) nxraw[rr] = *(const v4u*)(p_x + (size_t)rr * LDPJ);
            if (wid == 4) { ndt0 = p_dt[0]; ndt1 = p_dt[16]; }
        }
        const v4u zraw = *(const v4u*)p_z;
        const int lb = wid >> 1, sh = wid & 1;
        f32x16 sacc[2];
        {
            bf16x8 cf[8];
#pragma unroll
            for (int ks = 0; ks < 8; ++ks) cf[ks] = *(const LAS bf16x8*)(Cl + (32 * lb + r) * LDP + 16 * ks + 8 * hh);
#pragma unroll
            for (int tt = 0; tt < 2; ++tt) { const int sb = 2 * sh + tt;
#pragma unroll
                for (int i = 0; i < 16; ++i) sacc[tt][i] = 0.f;
                if (sb <= lb) {
#pragma unroll
                    for (int ks = 0; ks < 8; ++ks) { const bf16x8 af = *(const LAS bf16x8*)(Bl + (32 * sb + r) * LDP + 16 * ks + 8 * hh); sacc[tt] = MFMA32(af, cf[ks], sacc[tt]); } } }
        }
        SSD_BAR();
        {
            LAS bf16* P = Bl; const int l = 32 * lb + r; const float al = acum[l];
#pragma unroll
            for (int tt = 0; tt < 2; ++tt) { const int sb = 2 * sh + tt;
                if (sb < lb) {
#pragma unroll
                    for (int gq = 0; gq < 4; ++gq) { const int s0 = 32 * sb + 8 * gq + 4 * hh; const f32x4 as4 = *(const LAS f32x4*)(acum + s0); float v[4];
#pragma unroll
                        for (int e = 0; e < 4; ++e) v[e] = sacc[tt][4 * gq + e] * __builtin_amdgcn_exp2f(al - as4[e]);
                        v2u p; p.x = pk2(v[0], v[1]); p.y = pk2(v[2], v[3]); *(LAS v2u*)(P + l * LDP + s0) = p; }
                } else if (sb == lb) {
#pragma unroll
                    for (int gq = 0; gq < 4; ++gq) { const int s0 = 32 * sb + 8 * gq + 4 * hh; const f32x4 as4 = *(const LAS f32x4*)(acum + s0); float v[4];
#pragma unroll
                        for (int e = 0; e < 4; ++e) v[e] = (s0 + e <= l) ? sacc[tt][4 * gq + e] * __builtin_amdgcn_exp2f(al - as4[e]) : 0.f;
                        v2u p; p.x = pk2(v[0], v[1]); p.y = pk2(v[2], v[3]); *(LAS v2u*)(P + l * LDP + s0) = p; } } }
        }
        SSD_BAR();
        asm volatile("" : "+v"(nraw[0]), "+v"(nraw[1]), "+v"(nraw[2]), "+v"(nraw[3]), "+v"(nraw[4]), "+v"(nraw[5]), "+v"(nraw[6]), "+v"(nraw[7]), "+v"(nxraw[0]), "+v"(nxraw[1]), "+v"(nxraw[2]), "+v"(nxraw[3]), "+v"(ndt0), "+v"(ndt1));
        if (wid < 4) {
            const int lb2 = wid; const LAS bf16* P = Bl;
            f32x16 yd, yo;
#pragma unroll
            for (int i = 0; i < 16; ++i) { yd[i] = 0.f; yo[i] = 0.f; }
            for (int sb = 0; sb <= lb2; ++sb) {
                const bf16x8 af0 = *(const LAS bf16x8*)(P + (32 * lb2 + r) * LDP + 32 * sb + 8 * hh), bf0 = *(const LAS bf16x8*)(XDT + r * LDP + 32 * sb + 8 * hh),
                             af1 = *(const LAS bf16x8*)(P + (32 * lb2 + r) * LDP + 32 * sb + 16 + 8 * hh), bf1 = *(const LAS bf16x8*)(XDT + r * LDP + 32 * sb + 16 + 8 * hh);
                yd = MFMA32(af0, bf0, yd); yd = MFMA32(af1, bf1, yd); }
#pragma unroll
            for (int ks = 0; ks < 8; ++ks) { const bf16x8 af = *(const LAS bf16x8*)(Cl + (32 * lb2 + r) * LDP + 16 * ks + 8 * hh), bfv = *(const LAS bf16x8*)(SENT + r * LDP + 16 * ks + 8 * hh); yo = MFMA32(af, bfv, yo); }
#pragma unroll
            for (int g4 = 0; g4 < 4; ++g4) { const f32x4 ea = *(const LAS f32x4*)(eac + 32 * lb2 + 8 * g4 + 4 * hh);
#pragma unroll
                for (int e = 0; e < 4; ++e) { const int i = 4 * g4 + e, l = 32 * lb2 + 8 * g4 + 4 * hh + e;
                    XS[l * 32 + r] = f2bf1(yd[i] + ea[e] * yo[i] + Dh * bf2f(XS[l * 32 + r])); } }
        } else {
            const int nb = wid - 4; const float cd = eac[127];
#pragma unroll
            for (int i = 0; i < 16; ++i) st[i] *= cd;
#pragma unroll
            for (int ks = 0; ks < 8; ++ks) { const bf16x8 af = *(const LAS bf16x8*)(BT + (32 * nb + r) * LDP + 8 * ((2 * ks + hh) ^ ((4 * nb + (r >> 3)) & 15))), bfv = *(const LAS bf16x8*)(XDD + r * LDP + 16 * ks + 8 * hh); st = MFMA32(af, bfv, st); }
            if (wid == 4 && c < 15) SSD_STAGE_D((c + 1) & 1);
        }
        SSD_BAR();
        if (wid >= 4) { const int nb = wid - 4;
#pragma unroll
            for (int gq = 0; gq < 4; ++gq) { v2u p; p.x = pk2(st[4 * gq], st[4 * gq + 1]); p.y = pk2(st[4 * gq + 2], st[4 * gq + 3]); *(LAS v2u*)(SENT + r * LDP + 32 * nb + 8 * gq + 4 * hh) = p; } }
        {
            float yv[8], zf[8]; unpack8(*(const LAS v4u*)(XS + xl * 32 + 8 * xc), yv); unpack8(zraw, zf);
            float sq = 0.f;
#pragma unroll
            for (int j = 0; j < 8; ++j) { yv[j] *= zf[j]; sq += yv[j] * yv[j]; }
            v4u o; o.x = pk2(yv[0], yv[1]); o.y = pk2(yv[2], yv[3]); o.z = pk2(yv[4], yv[5]); o.w = pk2(yv[6], yv[7]);
            *(v4u*)p_z = o;
            sq += __shfl_xor(sq, 16); sq += __shfl_xor(sq, 32);
            if (xc == 0) *p_sq = sq;
        }
        p_bc += 128 * 256; p_x += (size_t)128 * LDPJ; p_z += (size_t)128 * LDPJ; p_dt += 128 * 16; p_sq += 128 * 2 * 16;
    }
#undef SSD_STAGE_D
#undef SSD_BAR
    const int r = tid0 & 31, hh = (tid0 >> 5) & 1;
    if (wid >= 4) { const int nb = wid - 4; float* o = a.out + O_SSMP + ((size_t)(b * 16 + h) * 64 + 32 * ph + r) * 128 + 32 * nb + 4 * hh;
#pragma unroll
        for (int gq = 0; gq < 4; ++gq) *(f32x4*)(o + 8 * gq) = (f32x4){st[4 * gq], st[4 * gq + 1], st[4 * gq + 2], st[4 * gq + 3]}; }
    __syncthreads();
}
constexpr int SMP_SCR = 11264;
__device__ __forceinline__ void ssd_sample(const Args& a, LAS float* scr, int wu, int lane) {
    const int j = wu >> 4, h = wu & 15, g = h >> 3; const size_t row = (size_t)(MP + j);
    bf16* prow = (bf16*)(a.ws + WS_PROJ) + row * LDPJ; const float* dtbuf = (const float*)(a.ws + WS_SMALL + SM_DT); float* ssgp = (float*)(a.ws + WS_SSGP);
    const float* cw = a.in[I_CW]; const float* cb = a.in[I_CB]; const float* cst = a.in[I_SCONV0] + (size_t)j * 3 * CONVD;
    const float A_h = -__expf(a.in[I_ALOG][h]), Dh = a.in[I_DSKIP][h];
    const float dt = softplus(dtbuf[row * 16 + h] + a.in[I_DTB][h]), dA = __expf(dt * A_h);
    LAS float* sx = scr; LAS float* sxs = scr + 64; LAS float* sB = scr + 128; LAS float* sC = scr + 256; LAS float* sp = scr + 384;
#pragma unroll
    for (int t = 0; t < 5; ++t) {
        const int ch = t == 0 ? (h * 64 + lane) : (t < 3 ? (1024 + g * 128 + lane + 64 * (t - 1)) : (1280 + g * 128 + lane + 64 * (t - 3)));
        float v = cb[ch] + cw[0 * CONVD + ch] * cst[0 * CONVD + ch] + cw[1 * CONVD + ch] * cst[1 * CONVD + ch] + cw[2 * CONVD + ch] * cst[2 * CONVD + ch] + cw[3 * CONVD + ch] * bf2f(prow[PC_XBC + ch]);
        v = silu(v);
        if (t == 0) { sx[lane] = v * dt; sxs[lane] = v; } else if (t < 3) sB[lane + 64 * (t - 1)] = v; else sC[lane + 64 * (t - 3)] = v;
    }
    const float zf = bf2f(prow[PC_Z + h * 64 + lane]);
    LDS_WAIT();
    const int rs = lane >> 5, n4 = lane & 31;
    const f32x4 Br = *(const LAS f32x4*)(sB + 4 * n4), Cr = *(const LAS f32x4*)(sC + 4 * n4);
    const f32x4* __restrict__ S0 = (const f32x4*)(a.in[I_SSM] + ((size_t)(j * 16 + h) * 64) * 128) + lane; f32x4* __restrict__ S1 = (f32x4*)(a.out + O_SSMS + ((size_t)(j * 16 + h) * 64) * 128) + lane;
#pragma unroll 1
    for (int it0 = 0; it0 < 32; it0 += 16) {
        f32x4 s4[16];
#pragma unroll
        for (int k = 0; k < 16; ++k) s4[k] = __builtin_nontemporal_load(S0 + 64 * (it0 + k));
#pragma unroll
        for (int k = 0; k < 16; ++k) { const int p = 2 * (it0 + k) + rs; const float xd = sx[p];
            const f32x4 nv = s4[k] * dA + Br * xd; __builtin_nontemporal_store(nv, S1 + 64 * (it0 + k));
            sp[p * 36 + n4] = (nv[0] * Cr[0] + nv[1] * Cr[1]) + (nv[2] * Cr[2] + nv[3] * Cr[3]); }
    }
    LDS_WAIT();
    float y = 0.f;
#pragma unroll
    for (int k = 0; k < 8; ++k) { const f32x4 v = *(const LAS f32x4*)(sp + lane * 36 + 4 * k); y += (v[0] + v[1]) + (v[2] + v[3]); }
    y = (y + Dh * sxs[lane]) * zf;
    prow[PC_Z + h * 64 + lane] = f2bf1(y);
    const float sq = wave_sum(y * y);
    if (lane < 2) ssgp[(row * 2 + g) * 16 + (h & 7) * 2 + lane] = lane == 0 ? sq : 0.f;
    LDS_WAIT();
}

__device__ __forceinline__ void p5_fix(const Args& a, int gw, int NGW, int lane) {
    bf16* proj = (bf16*)(a.ws + WS_PROJ); const float* ssgp = (const float*)(a.ws + WS_SSGP);
    const float* snw = a.in[I_SNW]; const float* scw = a.in[I_SCW];
    for (int u = gw; u < 2048 + 256; u += NGW) {
        const bool smp = u >= 2048; const int uu = smp ? u - 2048 : u, tgp = uu >> 1, kind = 2 + (uu & 1);
        const size_t row0 = smp ? (size_t)(MP + tgp) : (size_t)tgp * 16;
        if (kind < 2) continue;
        if (false) {
            const int ch = 512 * kind + 8 * lane; const f32x4 w0 = *(const f32x4*)(snw + ch), w1 = *(const f32x4*)(snw + ch + 4);
            if (smp) {
                const f32x4* pp = (const f32x4*)(ssgp + (row0 * 2 + kind) * 16); const f32x4 q4 = (pp[0] + pp[1]) + (pp[2] + pp[3]); const float rs = rsqrtf(((q4[0] + q4[1]) + (q4[2] + q4[3])) * (1.f / 512.f) + EPS);
                v4u* p = (v4u*)(proj + row0 * LDPJ + PC_Z + ch); float f[8]; unpack8(*p, f);
                v4u o; o.x = pk2(f[0] * rs * w0[0], f[1] * rs * w0[1]); o.y = pk2(f[2] * rs * w0[2], f[3] * rs * w0[3]); o.z = pk2(f[4] * rs * w1[0], f[5] * rs * w1[1]); o.w = pk2(f[6] * rs * w1[2], f[7] * rs * w1[3]); *p = o;
            } else {
                v4u raw[16]; float qs[16];
#pragma unroll
                for (int t = 0; t < 16; ++t) raw[t] = *(const v4u*)(proj + (row0 + t) * LDPJ + PC_Z + ch);
#pragma unroll
                for (int t = 0; t < 16; ++t) { const f32x4* pp = (const f32x4*)(ssgp + ((row0 + t) * 2 + kind) * 16); const f32x4 q4 = (pp[0] + pp[1]) + (pp[2] + pp[3]); qs[t] = (q4[0] + q4[1]) + (q4[2] + q4[3]); }
#pragma unroll
                for (int t = 0; t < 16; ++t) { const float rs = rsqrtf(qs[t] * (1.f / 512.f) + EPS); float f[8]; unpack8(raw[t], f);
                    v4u o; o.x = pk2(f[0] * rs * w0[0], f[1] * rs * w0[1]); o.y = pk2(f[2] * rs * w0[2], f[3] * rs * w0[3]); o.z = pk2(f[4] * rs * w1[0], f[5] * rs * w1[1]); o.w = pk2(f[6] * rs * w1[2], f[7] * rs * w1[3]);
                    *(v4u*)(proj + (row0 + t) * LDPJ + PC_Z + ch) = o; }
            }
        } else {
            const int ch = 512 * (kind - 2) + 8 * lane; float w[3][8];
#pragma unroll
            for (int k = 0; k < 3; ++k) { const f32x4 a0 = *(const f32x4*)(scw + k * 1024 + ch), a1 = *(const f32x4*)(scw + k * 1024 + ch + 4);
                w[k][0] = a0[0]; w[k][1] = a0[1]; w[k][2] = a0[2]; w[k][3] = a0[3]; w[k][4] = a1[0]; w[k][5] = a1[1]; w[k][6] = a1[2]; w[k][7] = a1[3]; }
            float u2[8], u1[8];
            if (smp) { const float* sp_ = a.in[I_SSCONV] + (size_t)tgp * 2 * 1024 + ch; float cc[8], hv[8], bb[8], uc[8], y[8];
#pragma unroll
                for (int e = 0; e < 8; ++e) { u2[e] = sp_[e]; u1[e] = sp_[1024 + e]; }
                unpack8(*(const v4u*)(proj + row0 * LDPJ + PC_SCC + ch), cc); v4u* pb = (v4u*)(proj + row0 * LDPJ + PC_SCB + ch); unpack8(*pb, bb); (void)hv;
#pragma unroll
                for (int e = 0; e < 8; ++e) { uc[e] = cc[e]; y[e] = bb[e] * (w[0][e] * u2[e] + w[1][e] * u1[e] + w[2][e] * uc[e]); }
                v4u o; o.x = pk2(y[0], y[1]); o.y = pk2(y[2], y[3]); o.z = pk2(y[4], y[5]); o.w = pk2(y[6], y[7]); *pb = o;
                float* d = a.out + O_SCS + (size_t)tgp * 2 * 1024 + ch;
#pragma unroll
                for (int e = 0; e < 8; ++e) { d[e] = u1[e]; d[1024 + e] = uc[e]; }
            } else {
                const int l0 = (tgp & 127) * 16;
                v4u hc[2];
#pragma unroll
                for (int q = 0; q < 2; ++q) { const bool ok = l0 > 0; hc[q] = ok ? *(const v4u*)(proj + (row0 - 2 + q) * LDPJ + PC_SCC + ch) : (v4u){0u, 0u, 0u, 0u}; }
                unpack8(hc[0], u2); unpack8(hc[1], u1);
#pragma unroll
                for (int half = 0; half < 2; ++half) {
                    v4u rc[8], rb[8];
#pragma unroll
                    for (int t = 0; t < 8; ++t) { const size_t row = row0 + 8 * half + t; rc[t] = *(const v4u*)(proj + row * LDPJ + PC_SCC + ch); rb[t] = *(const v4u*)(proj + row * LDPJ + PC_SCB + ch); }
#pragma unroll
                    for (int t = 0; t < 8; ++t) { const size_t row = row0 + 8 * half + t; float bb[8], uc[8], y[8]; unpack8(rc[t], uc); unpack8(rb[t], bb);
#pragma unroll
                        for (int e = 0; e < 8; ++e) { y[e] = bb[e] * (w[0][e] * u2[e] + w[1][e] * u1[e] + w[2][e] * uc[e]); }
                        v4u o; o.x = pk2(y[0], y[1]); o.y = pk2(y[2], y[3]); o.z = pk2(y[4], y[5]); o.w = pk2(y[6], y[7]); *(v4u*)(proj + row * LDPJ + PC_SCB + ch) = o;
                        const int l = l0 + 8 * half + t;
                        if (l >= SEQ - 2) { float* d = a.out + O_SCP + ((size_t)(tgp >> 7) * 2 + (l - (SEQ - 2))) * 1024 + ch;
#pragma unroll
                            for (int e = 0; e < 8; ++e) d[e] = uc[e]; }
#pragma unroll
                        for (int e = 0; e < 8; ++e) { u2[e] = u1[e]; u1[e] = uc[e]; } }
                }
            }
        }
    }
    const int gt = gw * 64 + lane, NT = NGW * 64;
    for (int i4 = gt; i4 < NBATCH * 3 * CONVD / 4; i4 += NT) { const int i = 4 * i4, c = i % CONVD, k = (i / CONVD) % 3, b = i / (3 * CONVD);
        const v2u r2 = *(const v2u*)(proj + (size_t)(b * SEQ + SEQ - 3 + k) * LDPJ + PC_XBC + c);
        *(f32x4*)(a.out + O_CONVP + i) = (f32x4){__uint_as_float(r2.x << 16), __uint_as_float(r2.x & 0xffff0000u), __uint_as_float(r2.y << 16), __uint_as_float(r2.y & 0xffff0000u)}; }
    for (int i4 = gt; i4 < NS * 3 * CONVD / 4; i4 += NT) { const int i = 4 * i4, c = i % CONVD, k = (i / CONVD) % 3, j = i / (3 * CONVD);
        f32x4 o;
        if (k < 2) o = *(const f32x4*)(a.in[I_SCONV0] + (size_t)j * 3 * CONVD + (k + 1) * CONVD + c);
        else { const v2u r2 = *(const v2u*)(proj + (size_t)(MP + j) * LDPJ + PC_XBC + c); o = (f32x4){__uint_as_float(r2.x << 16), __uint_as_float(r2.x & 0xffff0000u), __uint_as_float(r2.y << 16), __uint_as_float(r2.y & 0xffff0000u)}; }
        *(f32x4*)(a.out + O_CONVS + i) = o; }
}

#define XB_TMO      128
#define XB_XCNT(j)  (256  + 64 * (j))
#define XB_XSUB(j)  (1280 + 64 * (j))
#define XB_XGEN(j)  (2304 + 64 * (j))
#define XB_TOP      3328
#define XB_TOPGEN   3392
#define XCD_BAR_WORDS 3456
#define XB_SPIN_CAP (1u << 18)

__device__ __forceinline__ unsigned xb_ld(unsigned* p)              { return __hip_atomic_load(p, __ATOMIC_RELAXED, __HIP_MEMORY_SCOPE_AGENT); }
__device__ __forceinline__ unsigned xb_add(unsigned* p, unsigned v) { return __hip_atomic_fetch_add(p, v, __ATOMIC_RELAXED, __HIP_MEMORY_SCOPE_AGENT); }
__device__ __forceinline__ unsigned xb_xcc_id() { return (unsigned)__builtin_amdgcn_s_getreg((3 << 11) | 20) & 0xFu; }
#define XB_SPIN(cond, bar) do { unsigned _sp = 0; while (cond) { __builtin_amdgcn_s_sleep(1); \
    if ((++_sp & 255u) == 0u) { if (xb_ld(&(bar)[XB_TMO])) break; if (_sp > XB_SPIN_CAP) { atomicAdd(&(bar)[XB_TMO], 1u); break; } } } } while (0)

struct XcdBarrier {
    unsigned* bar; unsigned x;
    volatile LAS unsigned* st;
};

__device__ __forceinline__ XcdBarrier xcd_barrier_post(unsigned* bar, volatile LAS unsigned* st) {
    XcdBarrier b; b.bar = bar; b.x = xb_xcc_id(); b.st = st;
    if (threadIdx.x == 0) (void)xb_add(&bar[XB_XCNT(b.x)], 1u);
    return b;
}
__device__ __forceinline__ void xcd_barrier_complete(unsigned* bar, unsigned x, unsigned& nloc, unsigned& nx) {
    const unsigned G = gridDim.x * gridDim.y * gridDim.z;
    unsigned sum, cnt, mine, sp = 0u;
    for (;;) {
        sum = 0u; cnt = 0u; mine = 0u;
#pragma unroll
        for (unsigned j = 0; j < 16; ++j) { const unsigned c = xb_ld(&bar[XB_XCNT(j)]); sum += c; cnt += (c > 0u) ? 1u : 0u; mine = (j == x) ? c : mine; }
        if (sum == G) break;
        __builtin_amdgcn_s_sleep(1);
        if ((++sp & 255u) == 0u) { if (xb_ld(&bar[XB_TMO])) break; if (sp > XB_SPIN_CAP) { atomicAdd(&bar[XB_TMO], 1u); break; } }
    }
    nloc = mine > 0u ? mine : 1u; nx = cnt > 0u ? cnt : 1u;
}

__device__ __forceinline__ void xcd_barrier(const XcdBarrier& b) {
    asm volatile("s_waitcnt vmcnt(0)" ::: "memory");
    __syncthreads();
    if (threadIdx.x == 0) {
        unsigned* bar = b.bar;
        __builtin_amdgcn_s_waitcnt(0);
        unsigned nloc = b.st[0], nx = b.st[1];
        if (nloc == 0u) { xcd_barrier_complete(bar, b.x, nloc, nx); b.st[0] = nloc; b.st[1] = nx; }
        const unsigned old = xb_add(&bar[XB_XSUB(b.x)], 1u);
        const unsigned gen = old / nloc;
        if (old + 1u == (gen + 1u) * nloc) {
            __builtin_amdgcn_fence(__ATOMIC_RELEASE, "agent");
            asm volatile("s_waitcnt vmcnt(0)" ::: "memory");
            const unsigned og = xb_add(&bar[XB_TOP], 1u);
            const unsigned tg = og / nx;
            if (og + 1u == (tg + 1u) * nx) xb_add(&bar[XB_TOPGEN], 1u);
            else XB_SPIN(xb_ld(&bar[XB_TOPGEN]) == tg, bar);
            __builtin_amdgcn_fence(__ATOMIC_ACQUIRE, "agent");
            xb_add(&bar[XB_XGEN(b.x)], 1u);
            asm volatile("s_waitcnt vmcnt(0)" ::: "memory");
        } else {
            XB_SPIN(xb_ld(&bar[XB_XGEN(b.x)]) == gen, bar);
            __builtin_amdgcn_fence(__ATOMIC_ACQUIRE, "agent");
            asm volatile("s_waitcnt vmcnt(0)" ::: "memory");
        }
    }
    __syncthreads();
}

__global__ void __launch_bounds__(NTHR, 2) hymba_fwd(Args a) {
    extern __shared__ __attribute__((aligned(16))) unsigned char lds_raw[];
    cg::grid_group grid = cg::this_grid();
    LAS unsigned char* lds = (LAS unsigned char*)lds_raw;
    const int tid = threadIdx.x, lane = tid & 63, wave = __builtin_amdgcn_readfirstlane(tid >> 6);
    const int G = gridDim.x, gw = blockIdx.x * NWAVES + wave, NGW = G * NWAVES;
    unsigned char* ws = a.ws;
    bf16* XW = (bf16*)(ws + WS_XW); bf16* H = (bf16*)(ws + WS_H); bf16* PROJ = (bf16*)(ws + WS_PROJ);
    float* ss2 = (float*)(ws + WS_SMALL + SM_SS2); float* ss3 = (float*)(ws + WS_SMALL + SM_SS3); float* dtbuf = (float*)(ws + WS_SMALL + SM_DT);
    float* xres = a.out + O_Y;
    volatile LAS unsigned* MISC = (volatile LAS unsigned*)(lds + LDS_BYTES - 64);
    if (tid < 16) MISC[tid] = 0u;
    __syncthreads();
    XcdBarrier bar = xcd_barrier_post((unsigned*)(ws + WS_BAR), MISC);
    const int lo = a.ph_lo, hi = a.ph_hi;
#ifndef PH_MASK
#define PH_MASK 0x7ff
#endif
#define IN(k) (((PH_MASK >> (k)) & 1) && lo <= (k) && (k) < hi)
#define SEAM(k) do { if (IN(k) && IN((k) + 1)) xcd_barrier(bar); } while (0)
    if (a.ph_hi > 1000) grid.sync();
    if (IN(0)) p0_prologue(a, lds, gw, NGW, wave, lane);
    SEAM(0);
    if (IN(1)) {
        pg8::Gemm g{XW, (const bf16*)(ws + WS_W1GU), MPAD, NGU, DM, DM}; pg8::StaticOrder S; S.init(MPAD, NGU, G, (int)blockIdx.x);
        pg8::EpiSwiGLU<false> E{H, DFF, nullptr};
        pg8::gemm_phase<pg8::EpiSwiGLU<false>, pg8::StaticOrder, true, true>(lds, g, S, E);
    }
    SEAM(1);
    if (IN(2)) {
        pg8::Gemm g{H, (const bf16*)(ws + WS_W1D), MP, DM, DFF, DFF}; pg8::StaticOrder S; S.init(MP, DM, G, (int)blockIdx.x);
        pg8::EpiRes E{a.in[I_XP], nullptr, 0.5f, XW, a.in[I_NMW], ss2, nullptr, nullptr, nullptr};
        pg8::gemm_phase<pg8::EpiRes, pg8::StaticOrder, true, true>(lds, g, S, E);
        if (!(a.flags & 4)) small_gemm(lds, H + (size_t)MP * DFF, DFF, (const bf16*)(ws + WS_W1D), DFF, a.in[I_XS], nullptr, 0.5f, XW + (size_t)MP * DM, a.in[I_NMW], ss2 + MP);
    }
    SEAM(2);
    if (IN(3)) {
        pg8::Gemm g{XW, (const bf16*)(ws + WS_WIN), MPAD, NINP, DM, DM}; pg8::StaticOrder S; S.init(MPAD, NINP, G, (int)blockIdx.x);
        pg8::EpiProj E{PROJ, LDPJ, ss2, dtbuf, LDPJ / 256, a.flags & 8, PC_SCC / 256};
        pg8::gemm_phase<pg8::EpiProj, pg8::StaticOrder, true, true>(lds, g, S, E);
    }
    SEAM(3);
    if (IN(4)) { bc_conv_prepass(a, gw, NGW, lane); p5_fix(a, gw, NGW, lane); p0_late_weights(a, lds, gw, NGW, wave, lane); }
    SEAM(4);
    if (IN(5)) {
        if (!(a.flags & 2)) for (int u = blockIdx.x; u < NBATCH * 32; u += G) ssd_prompt(a, lds, (G == NBATCH * 32) ? ((u & 7) * 32 + (u >> 3)) : u);
        if (!(a.flags & 1)) for (int wu = gw; wu < NS * 16; wu += NGW) ssd_sample(a, (LAS float*)(lds + wave * SMP_SCR), wu, lane);
    }
    do { if (IN(5) && IN(7)) xcd_barrier(bar); } while (0);
    if (IN(7)) {
        pg8::Gemm g{PROJ, (const bf16*)(ws + WS_WOUT), MP, DM, DMIX, LDPJ}; pg8::StaticOrder S; S.init(MP, DM, G, (int)blockIdx.x);
        pg8::EpiResT<true> E{nullptr, nullptr, 1.0f, XW, a.in[I_N2W], ss3, (const float*)(ws + WS_SSGP), XW, a.in[I_NMW]};
        pg8::gemm_phase<pg8::EpiResT<true>, pg8::StaticOrder, true, true>(lds, g, S, E);
        if (!(a.flags & 4)) small_gemm(lds, PROJ + (size_t)MP * LDPJ, LDPJ, (const bf16*)(ws + WS_WOUT), DMIX, nullptr, nullptr, 1.0f, XW + (size_t)MP * DM, a.in[I_N2W], ss3 + MP, (const float*)(ws + WS_SSGP) + (size_t)MP * 2 * 16, XW + (size_t)MP * DM, a.in[I_NMW]);
    }
    SEAM(7);
    if (IN(8)) {
        pg8::Gemm g{XW, (const bf16*)(ws + WS_W2GU), MPAD, NGU, DM, DM}; pg8::StaticOrder S; S.init(MPAD, NGU, G, (int)blockIdx.x);
        pg8::EpiSwiGLU<true> E{H, DFF, ss3};
        pg8::gemm_phase<pg8::EpiSwiGLU<true>, pg8::StaticOrder, true, true>(lds, g, S, E);
    }
    SEAM(8);
    if (IN(9)) {
        pg8::Gemm g{H, (const bf16*)(ws + WS_W2D), MP, DM, DFF, DFF}; pg8::StaticOrder S; S.init(MP, DM, G, (int)blockIdx.x);
        pg8::EpiRes E{nullptr, nullptr, 0.5f, XW, nullptr, nullptr, nullptr, XW, a.in[I_N2W]};
        pg8::gemm_phase<pg8::EpiRes, pg8::StaticOrder, true, true>(lds, g, S, E);
        if (!(a.flags & 4)) small_gemm(lds, H + (size_t)MP * DFF, DFF, (const bf16*)(ws + WS_W2D), DFF, nullptr, nullptr, 0.5f, XW + (size_t)MP * DM, nullptr, nullptr, nullptr, XW + (size_t)MP * DM, a.in[I_N2W]);
    }
    SEAM(9);
    if (IN(10)) {
        const f32x4* wr = (const f32x4*)a.in[I_FNW] + lane;
        f32x4 w4[4];
#pragma unroll
        for (int j = 0; j < 4; ++j) w4[j] = wr[64 * j];
        for (int m = gw; m < MT; m += 2 * NGW) { const int m2 = m + NGW; const bool two = m2 < MT;
            const unsigned long long* xb = (const unsigned long long*)(XW + (size_t)m * DM) + lane; const unsigned long long* xb2 = (const unsigned long long*)(XW + (size_t)(two ? m2 : m) * DM) + lane;
            f32x4* xr = (f32x4*)(xres + (size_t)m * DM) + lane; f32x4* xr2 = (f32x4*)(xres + (size_t)(two ? m2 : m) * DM) + lane; unsigned long long r[4], r2[4]; f32x4 v[4], v2[4]; float s = 0.f, s2 = 0.f;
#pragma unroll
            for (int j = 0; j < 4; ++j) { r[j] = __builtin_nontemporal_load(xb + 64 * j); r2[j] = __builtin_nontemporal_load(xb2 + 64 * j); }
#pragma unroll
            for (int j = 0; j < 4; ++j) { const unsigned lo = (unsigned)r[j], hi = (unsigned)(r[j] >> 32), lo2 = (unsigned)r2[j], hi2 = (unsigned)(r2[j] >> 32);
                v[j] = (f32x4){__uint_as_float(lo << 16), __uint_as_float(lo & 0xffff0000u), __uint_as_float(hi << 16), __uint_as_float(hi & 0xffff0000u)};
                v2[j] = (f32x4){__uint_as_float(lo2 << 16), __uint_as_float(lo2 & 0xffff0000u), __uint_as_float(hi2 << 16), __uint_as_float(hi2 & 0xffff0000u)}; }
#pragma unroll
            for (int j = 0; j < 4; ++j) { s += (v[j].x * v[j].x + v[j].y * v[j].y) + (v[j].z * v[j].z + v[j].w * v[j].w); s2 += (v2[j].x * v2[j].x + v2[j].y * v2[j].y) + (v2[j].z * v2[j].z + v2[j].w * v2[j].w); }
            const float rstd = rsqrtf(wave_sum(s) * (1.f / DM) + EPS), rstd2 = rsqrtf(wave_sum(s2) * (1.f / DM) + EPS);
#pragma unroll
            for (int j = 0; j < 4; ++j) __builtin_nontemporal_store(v[j] * rstd * w4[j], xr + 64 * j);
            if (two) {
#pragma unroll
                for (int j = 0; j < 4; ++j) __builtin_nontemporal_store(v2[j] * rstd2 * w4[j], xr2 + 64 * j); } }
    }
#ifdef EXTRA_SYNCS
    for (int i = 0; i < EXTRA_SYNCS; ++i) grid.sync();
#endif
#undef IN
#undef SEAM
}

extern "C" void kernel_launch(void* const* d_in, const int* in_sizes, int n_in, void* d_out, int out_size, void* d_ws, size_t ws_size, hipStream_t stream) {
    static int grid = 0;
    if (grid == 0) {
        if (n_in != 24 || (size_t)out_size != O_END || ws_size < WS_END3) { fprintf(stderr, "kernel_launch: unexpected sizes: n_in %d out %d (want %zu) ws %zu (need %zu)\n", n_in, out_size, (size_t)O_END, ws_size, (size_t)WS_END3); grid = -1; return; }
        int dev = 0, cus = 0, per_cu = 0;
        hipGetDevice(&dev); hipDeviceGetAttribute(&cus, hipDeviceAttributeMultiprocessorCount, dev);
        if (hipFuncSetAttribute((const void*)hymba_fwd, hipFuncAttributeMaxDynamicSharedMemorySize, LDS_BYTES) != hipSuccess) { fprintf(stderr, "kernel_launch: hipFuncSetAttribute failed\n"); grid = -1; return; }
        if (hipOccupancyMaxActiveBlocksPerMultiprocessor(&per_cu, (const void*)hymba_fwd, NTHR, LDS_BYTES) != hipSuccess || per_cu < 1) { fprintf(stderr, "kernel_launch: occupancy query says %d blocks per CU\n", per_cu); grid = -1; (void)hipGetLastError(); return; }
        grid = cus * per_cu;
    }
    if (grid < 0) return;
    if (hipMemsetAsync((unsigned char*)d_ws + WS_BAR, 0, 16384, stream) != hipSuccess) { fprintf(stderr, "kernel_launch: memset of the barrier words failed\n"); return; }
    Args a{};
    for (int i = 0; i < 24; ++i) a.in[i] = (const float*)d_in[i];
    a.out = (float*)d_out; a.ws = (unsigned char*)d_ws; a.ph_lo = 0; a.ph_hi = 11;
    void* args[] = {&a};
#ifndef PRE_PASS
#define PRE_PASS 0
#endif
#ifndef PRE_FLAGS
#define PRE_FLAGS 0
#endif
    if (PRE_PASS > 0) {
        a.ph_hi = PRE_PASS; a.flags = PRE_FLAGS; (void)hipLaunchCooperativeKernel((const void*)hymba_fwd, dim3(grid), dim3(NTHR), args, LDS_BYTES, stream); a.ph_hi = 11; a.flags = 0; (void)hipMemsetAsync((unsigned char*)d_ws + WS_BAR, 0, 16384, stream); }
    hipError_t e = hipLaunchCooperativeKernel((const void*)hymba_fwd, dim3(grid), dim3(NTHR), args, LDS_BYTES, stream);
    if (e != hipSuccess) fprintf(stderr, "kernel_launch: cooperative launch failed: %s (grid %d)\n", hipGetErrorString(e), grid);
}
```

```cpp
#include <hip/hip_runtime.h>
#include <hip/hip_cooperative_groups.h>
#include <cstdio>
#include <cstdint>
namespace cg = cooperative_groups;
namespace pg8 {
#define PG8_LAS __attribute__((address_space(3)))
typedef unsigned short bf16_t;
typedef short bf16x8 __attribute__((ext_vector_type(8)));
typedef float f32x4 __attribute__((ext_vector_type(4)));
typedef unsigned u32x4 __attribute__((ext_vector_type(4)));
constexpr int BM = 256, BK = 64, HALF = 128, HTB = HALF * BK * 2  , STAGE_BYTES = 8 * HTB, NXCD = 8, WGM = 8;

__host__ __device__ __forceinline__ int lds_byte(int r, int c) { const int st = (r >> 4) * 2 + (c >> 5), rr = r & 15, cc = c & 31, ob = rr * 64 + cc * 2; return st * 1024 + (ob ^ (((ob >> 9) & 1) << 5)); }
__host__ __device__ __forceinline__ void stage_rc(int b, int& R, int& C) { const int st = b / 1024, sb = b % 1024, swz = sb ^ (((sb >> 9) & 1) << 5); R = (st >> 1) * 16 + swz / 64; C = (st & 1) * 32 + (swz % 64) / 2; }
__host__ __device__ __forceinline__ int perm32(int rho) { const int n = rho >> 4, i = rho & 15; return 8 * (i >> 2) + 4 * n + (i & 3); }

struct Unit { int pm, pn; };
struct Gemm { const bf16_t* A; const bf16_t* Bt; int M, N, K, lda; };

struct StaticOrder {
    int nM, nN, nwg, G, c;
    __host__ __device__ void init(int M, int N, int G_, int c_) { nM = M / BM; nN = N / BM; nwg = nM * nN; G = G_; c = c_; }
    __host__ __device__ bool next(int i, Unit& u) const {
        const long L = (long)i * G + c; if (L >= nwg) return false;
        int wgid = (int)L; { const int q = nwg / NXCD, r = nwg % NXCD, xcd = wgid % NXCD, off = wgid / NXCD; wgid = (xcd < r ? xcd * (q + 1) : r * (q + 1) + (xcd - r) * q) + off; }
        const int nig = WGM * nN, gid = wgid / nig, fm = gid * WGM, gsz = (nM - fm) < WGM ? (nM - fm) : WGM;
        u.pm = fm + ((wgid % nig) % gsz); u.pn = (wgid % nig) / gsz; return true;
    }
    __device__ __forceinline__ void a_ready(const Unit&) const {}
    __device__ __forceinline__ void done(const Unit&) const {}
};


__device__ __forceinline__ unsigned cvt_pk_bf16(float lo, float hi) { unsigned r; asm volatile("v_cvt_pk_bf16_f32 %0, %1, %2" : "=v"(r) : "v"(lo), "v"(hi)); return r; }
__device__ __forceinline__ float silu_f(float v) { return v * __builtin_amdgcn_rcpf(1.0f + __expf(-v)); }
typedef unsigned u32x2 __attribute__((ext_vector_type(2)));

typedef float f32x2 __attribute__((ext_vector_type(2)));
__device__ __forceinline__ f32x2 swiglu_pk(f32x2 g, f32x2 u) {
    const f32x2 t = g * (-1.44269504f); f32x2 e; e.x = __builtin_amdgcn_exp2f(t.x); e.y = __builtin_amdgcn_exp2f(t.y);
    const f32x2 d = e + 1.0f; f32x2 r; r.x = __builtin_amdgcn_rcpf(d.x); r.y = __builtin_amdgcn_rcpf(d.y);
    return (g * u) * r;
}
template <bool SCALE> struct EpiSwiGLU {
    static constexpr bool PERM = true, AFTER_DRAIN = false, KSCALE = false;
    bf16_t* H; int ldh; const float* ss;
    __device__ __forceinline__ void prefetch(const Unit& u, int wr, int fr, float (&rsv)[8]) const {
        const int row0 = u.pm * BM + wr * 64 + fr;
#pragma unroll
        for (int q = 0; q < 8; ++q) rsv[q] = SCALE ? ss[row0 + (q >> 2) * HALF + (q & 3) * 16] : 0.f;
    }
    __device__ __forceinline__ void operator()(const f32x4 (&acc)[2][2][4][2], const Unit& u, int wr, int wc, int fr, int fq, const float (&rsv)[8]) const {
        const int row0 = u.pm * BM + wr * 64 + fr, col0 = u.pn * HALF + wc * 32 + 8 * fq;
#pragma unroll
        for (int ai = 0; ai < 2; ++ai)
#pragma unroll
            for (int m = 0; m < 4; ++m) {
                const int row = row0 + ai * HALF + m * 16;
                f32x4 g0 = acc[ai][0][m][0], g1 = acc[ai][0][m][1], u0 = acc[ai][1][m][0], u1 = acc[ai][1][m][1];
                if (SCALE) { const float rs = rsqrtf(rsv[ai * 4 + m] * (1.0f / 1024.0f) + 1e-6f); g0 = g0 * rs; g1 = g1 * rs; u0 = u0 * rs; u1 = u1 * rs; }
                const f32x2 h0 = swiglu_pk((f32x2){g0[0], g0[1]}, (f32x2){u0[0], u0[1]}), h1 = swiglu_pk((f32x2){g0[2], g0[3]}, (f32x2){u0[2], u0[3]}),
                            h2 = swiglu_pk((f32x2){g1[0], g1[1]}, (f32x2){u1[0], u1[1]}), h3 = swiglu_pk((f32x2){g1[2], g1[3]}, (f32x2){u1[2], u1[3]});
                u32x4 w; w.x = cvt_pk_bf16(h0.x, h0.y); w.y = cvt_pk_bf16(h1.x, h1.y); w.z = cvt_pk_bf16(h2.x, h2.y); w.w = cvt_pk_bf16(h3.x, h3.y);
                *(u32x4*)(H + (size_t)row * ldh + col0) = w;
            }
    }
};
struct EpiProj {
    static constexpr bool PERM = true, AFTER_DRAIN = false, KSCALE = false;
    bf16_t* P; int ldp; const float* ss; float* dtb; int npn; int skip; int pn_u0;
    __device__ __forceinline__ void prefetch(const Unit& u, int wr, int fr, float (&rsv)[8]) const {
        const int row0 = u.pm * BM + wr * 64 + fr;
#pragma unroll
        for (int q = 0; q < 8; ++q) rsv[q] = ss[row0 + (q >> 2) * HALF + (q & 3) * 16];
    }
    __device__ __forceinline__ void operator()(const f32x4 (&acc)[2][2][4][2], const Unit& u, int wr, int wc, int fr, int fq, const float (&rsv)[8]) const {
        if (skip) return;
        const int row0 = u.pm * BM + wr * 64 + fr, col0 = u.pn * BM + wc * 32 + 8 * fq;
#pragma unroll
        for (int ai = 0; ai < 2; ++ai)
#pragma unroll
            for (int m = 0; m < 4; ++m) {
                const int row = row0 + ai * HALF + m * 16;
                const float rs = rsqrtf(rsv[ai * 4 + m] * (1.0f / 1024.0f) + 1e-6f);
                if (u.pn >= pn_u0 && u.pn < npn) {
                    const f32x4 c0 = acc[ai][0][m][0] * rs, c1 = acc[ai][0][m][1] * rs, h0 = acc[ai][1][m][0] * rs, h1 = acc[ai][1][m][1] * rs; u32x4 w;
                    w.x = cvt_pk_bf16(c0[0] * h0[0], c0[1] * h0[1]); w.y = cvt_pk_bf16(c0[2] * h0[2], c0[3] * h0[3]); w.z = cvt_pk_bf16(c1[0] * h1[0], c1[1] * h1[1]); w.w = cvt_pk_bf16(c1[2] * h1[2], c1[3] * h1[3]);
                    *(u32x4*)(P + (size_t)row * ldp + pn_u0 * BM + (u.pn - pn_u0) * HALF + wc * 32 + 8 * fq) = w;
                } else if (u.pn < npn) {
#pragma unroll
                    for (int bj = 0; bj < 2; ++bj) { f32x4 v0 = acc[ai][bj][m][0] * rs, v1 = acc[ai][bj][m][1] * rs; u32x4 w;
                        if (u.pn < 4) {
#pragma unroll
                            for (int e = 0; e < 4; ++e) { v0[e] = silu_f(v0[e]); v1[e] = silu_f(v1[e]); } }
                        w.x = cvt_pk_bf16(v0[0], v0[1]); w.y = cvt_pk_bf16(v0[2], v0[3]); w.z = cvt_pk_bf16(v1[0], v1[1]); w.w = cvt_pk_bf16(v1[2], v1[3]);
                        *(u32x4*)(P + (size_t)row * ldp + col0 + bj * HALF) = w; }
                } else if (wc == 0 && fq < 2) {
                    *(f32x4*)(dtb + (size_t)row * 16 + 8 * fq) = acc[ai][0][m][0] * rs; *(f32x4*)(dtb + (size_t)row * 16 + 8 * fq + 4) = acc[ai][0][m][1] * rs;
                }
            }
    }
};
template <bool KS> struct EpiResT {
    static constexpr bool PERM = false, AFTER_DRAIN = false, KSCALE = KS;
    const float* base; float* out; float scale; bf16_t* xw; const float* wn; float* ss; const float* ssgp; const bf16_t* bbase; const float* bw;
    __device__ __forceinline__ void unit_begin(const Unit& u, PG8_LAS unsigned char* lds) const {
        PG8_LAS float* R = (PG8_LAS float*)(lds + STAGE_BYTES); const int t = threadIdx.x, row = t >> 1, g = t & 1;
        const f32x4* pp = (const f32x4*)(ssgp + ((size_t)(u.pm * BM + row) * 2 + g) * 16); const f32x4 q4 = (pp[0] + pp[1]) + (pp[2] + pp[3]);
        R[row * 2 + g] = rsqrtf(((q4[0] + q4[1]) + (q4[2] + q4[3])) * (1.0f / 512.0f) + 1e-6f);
    }
    __device__ __forceinline__ void kscale(int t, f32x4 (&acc)[2][2][4][2], int wr, int fr, PG8_LAS unsigned char* lds) const {
        const PG8_LAS float* R = (const PG8_LAS float*)(lds + STAGE_BYTES);
#pragma unroll
        for (int ai = 0; ai < 2; ++ai)
#pragma unroll
            for (int m = 0; m < 4; ++m) { const int r = ai * HALF + wr * 64 + m * 16 + fr; const float r0 = R[r * 2], r1 = R[r * 2 + 1]; const float f = (t == 8) ? r0 * __builtin_amdgcn_rcpf(r1) : r1;
#pragma unroll
                for (int bj = 0; bj < 2; ++bj)
#pragma unroll
                    for (int n = 0; n < 2; ++n) acc[ai][bj][m][n] = acc[ai][bj][m][n] * f; }
    }
    __device__ __forceinline__ void prefetch(const Unit&, int, int, float (&rsv)[8]) const {
#pragma unroll
        for (int q = 0; q < 8; ++q) rsv[q] = 0.f;
    }
    __device__ __forceinline__ void operator()(const f32x4 (&acc)[2][2][4][2], const Unit& u, int wr, int wc, int fr, int fq, const float (&)[8]) const {
        const int row0 = u.pm * BM + wr * 64 + fr, col0 = u.pn * BM + wc * 32 + 4 * fq;
        f32x4 w4[2][2];
#pragma unroll
        for (int bj = 0; bj < 2; ++bj)
#pragma unroll
            for (int n = 0; n < 2; ++n) w4[bj][n] = (xw && wn) ? *(const f32x4*)(wn + col0 + bj * HALF + n * 16) : (f32x4){1.f, 1.f, 1.f, 1.f};
        f32x4 winv[2][2];
#pragma unroll
        for (int bj = 0; bj < 2; ++bj)
#pragma unroll
            for (int n = 0; n < 2; ++n) { f32x4 t_ = {1.f, 1.f, 1.f, 1.f}; if (bbase) { const f32x4 q_ = *(const f32x4*)(bw + col0 + bj * HALF + n * 16); t_ = (f32x4){1.f / q_[0], 1.f / q_[1], 1.f / q_[2], 1.f / q_[3]}; } winv[bj][n] = t_; }
#pragma unroll
        for (int ai = 0; ai < 2; ++ai)
#pragma unroll
        for (int mh = 0; mh < 2; ++mh) {
            f32x4 bv[2][2][2];
#pragma unroll
            for (int mm = 0; mm < 2; ++mm)
#pragma unroll
                for (int bj = 0; bj < 2; ++bj)
#pragma unroll
                    for (int n = 0; n < 2; ++n) { const size_t o_ = (size_t)(row0 + ai * HALF + (2 * mh + mm) * 16) * 1024 + col0 + bj * HALF + n * 16;
                        if (bbase) { const u32x2 r_ = *(const u32x2*)(bbase + o_); bv[mm][bj][n] = (f32x4){__uint_as_float(r_.x << 16), __uint_as_float(r_.x & 0xffff0000u), __uint_as_float(r_.y << 16), __uint_as_float(r_.y & 0xffff0000u)} * winv[bj][n]; }
                        else bv[mm][bj][n] = __builtin_nontemporal_load((const f32x4*)(base + o_)); }
#pragma unroll
            for (int mm = 0; mm < 2; ++mm) {
                const int m = 2 * mh + mm, row = row0 + ai * HALF + m * 16; float s = 0.f;
#pragma unroll
                for (int bj = 0; bj < 2; ++bj)
#pragma unroll
                    for (int n = 0; n < 2; ++n) { const int col = col0 + bj * HALF + n * 16; const size_t off = (size_t)row * 1024 + col;
                        const f32x4 v = bv[mm][bj][n] + acc[ai][bj][m][n] * scale; if (out) *(f32x4*)(out + off) = v;
                        s += (v[0] * v[0] + v[1] * v[1]) + (v[2] * v[2] + v[3] * v[3]);
                        if (xw) { const f32x4 ww = w4[bj][n]; u32x2 p; p.x = cvt_pk_bf16(v[0] * ww[0], v[1] * ww[1]); p.y = cvt_pk_bf16(v[2] * ww[2], v[3] * ww[3]); *(u32x2*)(xw + off) = p; } }
                if (ss) { s += __shfl_xor(s, 16); s += __shfl_xor(s, 32); if (fq == 0) atomicAdd(ss + row, s); }
            }
        }
    }
};
typedef EpiResT<false> EpiRes;

template <class Epi, class Sched, bool ALIGN_EPI = false, bool SP2 = false>
__device__ __forceinline__ void gemm_phase(PG8_LAS unsigned char* lds, const Gemm g, const Sched& S, const Epi& E) {
    const int tid = threadIdx.x, wid = __builtin_amdgcn_readfirstlane(tid >> 6), lane = tid & 63, wr = wid >> 2, wc = wid & 3, fr = lane & 15, fq = lane >> 4;
    const int K = g.K, nt = K / BK;
    unsigned voffA[2], voffB[2];
#pragma unroll
    for (int i = 0; i < 2; ++i) { int R, C; stage_rc(tid * 16 + i * 8192, R, C); const int Rb = Epi::PERM ? ((R & ~31) + perm32(R & 31)) : R;
        voffA[i] = (unsigned)(R * g.lda + C) * 2u; voffB[i] = (unsigned)(Rb * K + C) * 2u; }
    const size_t kstep = (size_t)(BK * 2);
    const size_t hstepA = (size_t)HALF * g.lda * 2, hstepB = (size_t)HALF * K * 2;
    const size_t tstepA = 2 * hstepA, tstepB = 2 * hstepB;
    const unsigned ldsw = (unsigned)wid * 1024u;
    const int aoff = lds_byte(wr * 64 + fr, fq * 8), boff = lds_byte(wc * 32 + fr, fq * 8);
#define PG8_SA(b, h) (((b) * 2 + (h)) * HTB)
#define PG8_SB(b, h) ((4 + (b) * 2 + (h)) * HTB)
#define PG8_STAGE(bufoff, gbase, voff) do { _Pragma("unroll") for (int _i = 0; _i < 2; ++_i) \
        __builtin_amdgcn_global_load_lds((const unsigned*)((const char*)(gbase) + (voff)[_i]), (PG8_LAS unsigned*)(lds + (bufoff) + ldsw + _i * 8192), 16, 0, 0); } while (0)
#define PG8_LDA(dst, b, h) do { _Pragma("unroll") for (int m = 0; m < 4; ++m) _Pragma("unroll") for (int k = 0; k < 2; ++k) dst[m][k] = *(const PG8_LAS bf16x8*)(lds + PG8_SA(b, h) + aoff + m * 2048 + k * 1024); } while (0)
#define PG8_LDB(dst, b, h) do { _Pragma("unroll") for (int n = 0; n < 2; ++n) _Pragma("unroll") for (int k = 0; k < 2; ++k) dst[n][k] = *(const PG8_LAS bf16x8*)(lds + PG8_SB(b, h) + boff + n * 2048 + k * 1024); } while (0)
#define PG8_MMA(ai, bj, At, Bt) do { __builtin_amdgcn_s_setprio(1); _Pragma("unroll") for (int m = 0; m < 4; ++m) _Pragma("unroll") for (int n = 0; n < 2; ++n) _Pragma("unroll") for (int k = 0; k < 2; ++k) \
        acc[ai][bj][m][n] = __builtin_amdgcn_mfma_f32_16x16x32_bf16(Bt[n][k], At[m][k], acc[ai][bj][m][n], 0, 0, 0); __builtin_amdgcn_s_setprio(0); } while (0)
#define PG8_WAIT_V(n) asm volatile("s_waitcnt vmcnt(" #n ")" ::: "memory")
#define PG8_WAIT_L(n) asm volatile("s_waitcnt lgkmcnt(" #n ")" ::: "memory")
#define PG8_BAR __builtin_amdgcn_s_barrier()
#define PG8_SCHED __builtin_amdgcn_sched_barrier(0)
    Unit cur, nxt; int ui = 0;
    if (!S.next(0, cur)) return;
    f32x4 acc[2][2][4][2];
#pragma unroll
    for (int a = 0; a < 2; ++a)
#pragma unroll
        for (int b = 0; b < 2; ++b)
#pragma unroll
            for (int m = 0; m < 4; ++m)
#pragma unroll
                for (int n = 0; n < 2; ++n) acc[a][b][m][n] = (f32x4){0.f, 0.f, 0.f, 0.f};
    bf16x8 At[4][2], B0[2][2], B1[2][2];
    const char* cA = (const char*)g.A + (size_t)cur.pm * tstepA; const char* cB = (const char*)g.Bt + (size_t)cur.pn * tstepB;
    S.a_ready(cur);
    if constexpr (SP2) {
        PG8_STAGE(PG8_SB(0, 0), cB, voffB); PG8_STAGE(PG8_SB(0, 1), cB + hstepB, voffB); PG8_STAGE(PG8_SA(0, 0), cA, voffA); PG8_STAGE(PG8_SA(0, 1), cA + hstepA, voffA);
        if (wr == 1) PG8_BAR;
        PG8_WAIT_V(2); PG8_BAR;
        PG8_STAGE(PG8_SB(1, 0), cB + kstep, voffB); PG8_STAGE(PG8_SA(1, 0), cA + kstep, voffA); PG8_STAGE(PG8_SB(1, 1), cB + hstepB + kstep, voffB);
        PG8_WAIT_V(6); PG8_BAR;
    } else {
        PG8_STAGE(PG8_SB(0, 0), cB, voffB); PG8_STAGE(PG8_SA(0, 0), cA, voffA); PG8_STAGE(PG8_SB(0, 1), cB + hstepB, voffB); PG8_STAGE(PG8_SA(0, 1), cA + hstepA, voffA);
        if (wr == 1) PG8_BAR;
        PG8_WAIT_V(4); PG8_BAR;
        PG8_STAGE(PG8_SB(1, 0), cB + kstep, voffB); PG8_STAGE(PG8_SA(1, 0), cA + kstep, voffA); PG8_STAGE(PG8_SB(1, 1), cB + hstepB + kstep, voffB);
        PG8_WAIT_V(6); PG8_BAR;
    }
    for (;;) {
        const bool has_next = S.next(ui + 1, nxt);
        const char* nA = has_next ? (const char*)g.A + (size_t)nxt.pm * tstepA : cA; const char* nB = has_next ? (const char*)g.Bt + (size_t)nxt.pn * tstepB : cB;
        float rsv[8]; E.prefetch(cur, wr, fr, rsv);
        if constexpr (Epi::KSCALE) E.unit_begin(cur, lds);
        for (int t = 0; t < nt; t += 2) {
            if constexpr (Epi::KSCALE) { if (t == 8 || t == 16) E.kscale(t, acc, wr, fr, lds); }
            const bool last = (t == nt - 2);
            const char* a1 = cA + (size_t)(t + 1) * kstep;
            const char* a2 = last ? nA : cA + (size_t)(t + 2) * kstep; const char* b2 = last ? nB : cB + (size_t)(t + 2) * kstep;
            const char* a3 = a2 + kstep; const char* b3 = b2 + kstep;
            if (last && has_next) S.a_ready(nxt);
            if constexpr (SP2) {
            PG8_LDB(B0, 0, 0); PG8_LDB(B1, 0, 1); PG8_SCHED; PG8_LDA(At, 0, 0); PG8_STAGE(PG8_SA(1, 1), a1 + hstepA, voffA);
            PG8_WAIT_V(8); PG8_WAIT_L(0); PG8_BAR; PG8_MMA(0, 0, At, B0); PG8_MMA(0, 1, At, B1); PG8_BAR; PG8_SCHED;
            PG8_LDA(At, 0, 1); PG8_STAGE(PG8_SB(0, 0), b2, voffB); PG8_STAGE(PG8_SB(0, 1), b2 + hstepB, voffB); PG8_STAGE(PG8_SA(0, 0), a2, voffA);
            PG8_WAIT_V(8); PG8_WAIT_L(0); PG8_BAR; PG8_MMA(1, 0, At, B0); PG8_MMA(1, 1, At, B1); PG8_BAR; PG8_SCHED;
            PG8_LDB(B0, 1, 0); PG8_LDB(B1, 1, 1); PG8_SCHED; PG8_LDA(At, 1, 0); PG8_STAGE(PG8_SA(0, 1), a2 + hstepA, voffA);
            PG8_WAIT_V(8); PG8_WAIT_L(0); PG8_BAR; PG8_MMA(0, 0, At, B0); PG8_MMA(0, 1, At, B1); PG8_BAR; PG8_SCHED;
            PG8_LDA(At, 1, 1); PG8_STAGE(PG8_SB(1, 0), b3, voffB); PG8_STAGE(PG8_SB(1, 1), b3 + hstepB, voffB); PG8_STAGE(PG8_SA(1, 0), a3, voffA);
            PG8_WAIT_V(8); PG8_WAIT_L(0); PG8_BAR; PG8_MMA(1, 0, At, B0); PG8_MMA(1, 1, At, B1); PG8_BAR; PG8_SCHED;
            } else {
            PG8_LDB(B0, 0, 0); PG8_SCHED; PG8_LDA(At, 0, 0); PG8_STAGE(PG8_SA(1, 1), a1 + hstepA, voffA);
            PG8_WAIT_L(8); PG8_BAR; PG8_WAIT_L(0); PG8_MMA(0, 0, At, B0); PG8_BAR; PG8_SCHED;
            PG8_LDB(B1, 0, 1); PG8_STAGE(PG8_SB(0, 0), b2, voffB);
            PG8_BAR; PG8_WAIT_L(0); PG8_MMA(0, 1, At, B1); PG8_BAR;
            PG8_LDA(At, 0, 1); PG8_STAGE(PG8_SA(0, 0), a2, voffA);
            PG8_BAR; PG8_WAIT_L(0); PG8_MMA(1, 0, At, B0); PG8_BAR; PG8_SCHED;
            PG8_STAGE(PG8_SB(0, 1), b2 + hstepB, voffB);
            PG8_WAIT_V(6); PG8_BAR; PG8_MMA(1, 1, At, B1); PG8_BAR;
            PG8_LDB(B0, 1, 0); PG8_SCHED; PG8_LDA(At, 1, 0); PG8_STAGE(PG8_SA(0, 1), a2 + hstepA, voffA);
            PG8_WAIT_L(8); PG8_BAR; PG8_WAIT_L(0); PG8_MMA(0, 0, At, B0); PG8_BAR; PG8_SCHED;
            PG8_LDB(B1, 1, 1); PG8_STAGE(PG8_SB(1, 0), b3, voffB);
            PG8_BAR; PG8_WAIT_L(0); PG8_MMA(0, 1, At, B1); PG8_BAR;
            PG8_LDA(At, 1, 1); PG8_STAGE(PG8_SA(1, 0), a3, voffA);
            PG8_BAR; PG8_WAIT_L(0); PG8_MMA(1, 0, At, B0); PG8_BAR; PG8_SCHED;
            PG8_STAGE(PG8_SB(1, 1), b3 + hstepB, voffB);
            PG8_WAIT_V(6); PG8_BAR; PG8_MMA(1, 1, At, B1); PG8_BAR;
            }
        }
        if constexpr (ALIGN_EPI) { if (wr == 0) PG8_BAR; }
        if constexpr (!Epi::AFTER_DRAIN) { E(acc, cur, wr, wc, fr, fq, rsv); S.done(cur); }
        if (!has_next) break;
#pragma unroll
        for (int a = 0; a < 2; ++a)
#pragma unroll
            for (int b = 0; b < 2; ++b)
#pragma unroll
                for (int m = 0; m < 4; ++m)
#pragma unroll
                    for (int n = 0; n < 2; ++n) acc[a][b][m][n] = (f32x4){0.f, 0.f, 0.f, 0.f};
        cur = nxt; cA = nA; cB = nB; ++ui;
        if constexpr (ALIGN_EPI) { if (wr == 1) PG8_BAR; }
    }
    PG8_WAIT_V(0);
    if constexpr (!ALIGN_EPI) { if (wr == 0) PG8_BAR; }
    PG8_BAR;
    if constexpr (Epi::AFTER_DRAIN) { E.fused(acc, cur, wr, wc, fr, fq, lds, wid, lane); S.done(cur); }
#undef PG8_SA
#undef PG8_SB
#undef PG8_STAGE
#undef PG8_LDA
#undef PG8_LDB
#undef PG8_MMA
#undef PG8_WAIT_V
#undef PG8_WAIT_L
#undef PG8_BAR
#undef PG8_SCHED
}
}
#define LAS __attribute__((address_space(3)))
typedef unsigned short bf16;
typedef short bf16x8 __attribute__((ext_vector_type(8)));
typedef float f32x4 __attribute__((ext_vector_type(4)));
typedef float f32x16 __attribute__((ext_vector_type(16)));
typedef unsigned v4u __attribute__((ext_vector_type(4)));
typedef unsigned v2u __attribute__((ext_vector_type(2)));
constexpr int NWAVES = 8, NTHR = 512;
constexpr int DM = 1024, NBATCH = 8, SEQ = 2048, MP = NBATCH * SEQ, NS = 128, MT = MP + NS, MPAD = 16640;
constexpr int DFF = 2816, NGU = 2 * DFF, DMIX = 2048, NINP = 5888, LDPJ = 5632, DINP = 5648, CONVD = 1536;
constexpr int PC_Z = 0, PC_SCB = 1024, PC_XBC = 2048, PC_SCC = 3584, PC_SCH = 4608;
constexpr float EPS = 1e-6f;
constexpr size_t MiB = 1u << 20;
constexpr size_t WS_W2GU = 0, WS_W2D = 11 * MiB, WS_WOUT = WS_W2D + 5632 * 1024, WS_WIN = WS_WOUT + 4 * MiB, WS_XW = 32 * MiB;
constexpr size_t WS_SMALL = WS_XW + (size_t)MPAD * DM * 2;
constexpr size_t SM_SS2 = 0, SM_SS3 = 128 * 1024, SM_SSG = 256 * 1024, SM_DT = 512 * 1024;
constexpr size_t WS_PROJ = WS_SMALL + 2 * MiB;
constexpr size_t WS_W1GU = WS_PROJ, WS_W1D = WS_W1GU + 11 * MiB, WS_H = WS_W1D + 5632 * 1024;
constexpr size_t WS_END = WS_PROJ + (size_t)MPAD * LDPJ * 2;
constexpr size_t WS_BAR = WS_END, WS_SSGP = WS_BAR + 64 * 1024, WS_END2 = WS_SSGP + (size_t)MPAD * 2 * 16 * 4;
constexpr size_t WS_BCB = WS_WIN, WS_BCC = WS_END2, WS_END3 = WS_BCC + (size_t)MP * 256 * 2;
constexpr long BC_CDELTA = (long)((WS_BCC - WS_BCB) / 2);
static_assert(WS_END3 <= 256 * MiB && (size_t)MP * 256 * 2 <= (size_t)NINP * DM * 2, "d_ws map 2");
static_assert(WS_WIN + (size_t)NINP * DM * 2 <= WS_XW && WS_H + (size_t)MPAD * DFF * 2 <= WS_END && SM_DT + (size_t)MPAD * 16 * 4 <= 2 * MiB && WS_END <= 256 * MiB, "d_ws map");
constexpr size_t O_Y = 0, O_SSMP = (size_t)MT * DM, O_CONVP = O_SSMP + (size_t)NBATCH * 16 * 64 * 128, O_SCP = O_CONVP + (size_t)NBATCH * 3 * CONVD,
                 O_SSMS = O_SCP + (size_t)NBATCH * 2 * 1024, O_CONVS = O_SSMS + (size_t)NS * 16 * 64 * 128, O_SCS = O_CONVS + (size_t)NS * 3 * CONVD, O_END = O_SCS + (size_t)NS * 2 * 1024;
constexpr int LDS_BYTES = 147456;
constexpr int LDP = 136;
constexpr int CL_OFF = 0, BL_OFF = 128 * LDP * 2, BT_OFF = 2 * BL_OFF, XDT_OFF = 3 * BL_OFF, XDD_OFF = XDT_OFF + 32 * LDP * 2, SENT_OFF = XDD_OFF + 32 * LDP * 2,
              XS_OFF = SENT_OFF + 32 * LDP * 2, ACUM_OFF = XS_OFF + 128 * 32 * 2, DTV_OFF = ACUM_OFF + 1024, WBC_OFF = DTV_OFF + 1024, WX_OFF = WBC_OFF + 5 * 256 * 4, SSD_LDS_END = WX_OFF + 5 * 32 * 4;
static_assert(SSD_LDS_END <= LDS_BYTES, "LDS map");

struct Args { const float* in[24]; float* out; unsigned char* ws; int ph_lo, ph_hi, flags, pad; };
enum { I_XP = 0, I_XS, I_SSM, I_SCONV0, I_SSCONV, I_N1W, I_F1G, I_F1U, I_F1D, I_NMW, I_WIN, I_CW, I_CB, I_DTB, I_ALOG, I_DSKIP, I_SNW, I_SCW, I_WOUT, I_N2W, I_F2G, I_F2U, I_F2D, I_FNW };

__device__ __forceinline__ float bf2f(unsigned short b) { return __uint_as_float((unsigned)b << 16); }
__device__ __forceinline__ unsigned pk2(float lo, float hi) { return pg8::cvt_pk_bf16(lo, hi); }
__device__ __forceinline__ unsigned short f2bf1(float f) { return (unsigned short)(pg8::cvt_pk_bf16(f, 0.f) & 0xffffu); }
__device__ __forceinline__ float silu(float v) { return pg8::silu_f(v); }
__device__ __forceinline__ float softplus(float x) { return x > 20.f ? x : log1pf(__expf(x)); }
__device__ __forceinline__ float softplus_fast(float x) { const float e = __expf(x); return x > 20.f ? x : (e < 0.03125f ? e * (1.f + e * (-0.5f + e * (0.33333333f - 0.25f * e))) : __logf(1.f + e)); }
__device__ __forceinline__ float wave_sum(float v) {
#pragma unroll
    for (int o = 1; o < 64; o <<= 1) v += __shfl_xor(v, o);
    return v;
}
__device__ __forceinline__ void unpack8(const v4u r, float (&f)[8]) {
#pragma unroll
    for (int i = 0; i < 4; ++i) { f[2 * i] = __uint_as_float(r[i] << 16); f[2 * i + 1] = __uint_as_float(r[i] & 0xffff0000u); }
}
#define LDS_WAIT() asm volatile("s_waitcnt lgkmcnt(0)" ::: "memory")
#define MFMA32(a, b, c) __builtin_amdgcn_mfma_f32_32x32x16_bf16((a), (b), (c), 0, 0, 0)

__device__ __forceinline__ void p0_item(const float* W, int K, int Nsrc, int src_col0, int nvalid, bf16* WT, int dst_row0, int kb, LAS float* scr, int lane, const float* rscale = nullptr) {
    const int k0 = 64 * kb, nl = lane & 31; const bool ok = nl < nvalid;
#pragma unroll
    for (int i = 0; i < 32; ++i) { const int kk = 2 * i + (lane >> 5); float v = ok ? __builtin_nontemporal_load(W + (size_t)(k0 + kk) * Nsrc + src_col0 + nl) : 0.f;   if (rscale && k0 + kk < 1024) v *= rscale[k0 + kk]; scr[kk * 33 + nl] = v; }
    LDS_WAIT();
    const int c = lane & 7;
#pragma unroll
    for (int j = 0; j < 4; ++j) { const int n = (lane >> 3) + 8 * j; const LAS float* s = scr + (8 * c) * 33 + n;
        v4u o; o.x = pk2(s[0 * 33], s[1 * 33]); o.y = pk2(s[2 * 33], s[3 * 33]); o.z = pk2(s[4 * 33], s[5 * 33]); o.w = pk2(s[6 * 33], s[7 * 33]);
        *(v4u*)(WT + (size_t)(dst_row0 + n) * K + k0 + 8 * c) = o; }
    LDS_WAIT();
}
constexpr int P0_I_GU = 176 * 16, P0_I_D = 32 * 44, P0_I_IN = 184 * 16, P0_I_O = 32 * 32, P0_NITEMS = 2 * P0_I_GU + 2 * P0_I_D + P0_I_IN + P0_I_O;
__device__ __forceinline__ void p0_do_item(const Args& a, int it, LAS float* scr, int lane) {
    unsigned char* ws = a.ws; int r = it;
    if (r < 2 * P0_I_GU) {
        const int which = r >= P0_I_GU; r -= which * P0_I_GU; const int kb = r / 176, nb = r % 176, tile = nb >> 3, sub = nb & 7, bj = sub >> 2, c0 = (sub & 3) * 32;
        const float* W = which ? (bj ? a.in[I_F2U] : a.in[I_F2G]) : (bj ? a.in[I_F1U] : a.in[I_F1G]);
        p0_item(W, DM, DFF, tile * 128 + c0, 32, (bf16*)(ws + (which ? WS_W2GU : WS_W1GU)), nb * 32, kb, scr, lane); return; }
    r -= 2 * P0_I_GU;
    if (r < 2 * P0_I_D) { const int which = r >= P0_I_D; r -= which * P0_I_D; const int kb = r / 32, nb = r % 32;
        p0_item(which ? a.in[I_F2D] : a.in[I_F1D], DFF, DM, nb * 32, 32, (bf16*)(ws + (which ? WS_W2D : WS_W1D)), nb * 32, kb, scr, lane); return; }
    r -= 2 * P0_I_D;
    if (r < P0_I_IN) { const int kb = r / 184, nb = r % 184, n = nb * 32; int src, nv = 32;
        if (n < 1024) src = n; else if (n < 2048) src = 2576 + (n - 1024); else if (n < 3584) src = 1024 + (n - 2048); else if (n < 5632) { const int tl_ = (n - 3584) >> 8, w_ = (n - 3584) & 255; src = w_ < 128 ? 3600 + 128 * tl_ + w_ : 4624 + 128 * tl_ + (w_ - 128); }
        else if (n == 5632) { src = 2560; nv = 16; } else { src = 0; nv = 0; }
        p0_item(a.in[I_WIN], DM, DINP, src, nv, (bf16*)(ws + WS_WIN), n, kb, scr, lane); return; }
    r -= P0_I_IN;
    { const int kb = r / 32, nb = r % 32; p0_item(a.in[I_WOUT], DMIX, DM, nb * 32, 32, (bf16*)(ws + WS_WOUT), nb * 32, kb, scr, lane, a.in[I_SNW]); }
}
__device__ __forceinline__ void p0_late_weights(const Args& a, LAS unsigned char* lds, int gw, int NGW, int wave, int lane) {
    LAS float* scr = (LAS float*)(lds + wave * 16384);
    constexpr int NL = P0_I_GU + P0_I_D + P0_I_O;
    for (int i = gw; i < NL; i += NGW) {
        const int it = i < P0_I_GU ? P0_I_GU + i : (i < P0_I_GU + P0_I_D ? 2 * P0_I_GU + P0_I_D + (i - P0_I_GU) : 2 * P0_I_GU + 2 * P0_I_D + P0_I_IN + (i - P0_I_GU - P0_I_D));
        p0_do_item(a, it, scr, lane); }
}
__device__ __forceinline__ void p0_prologue(const Args& a, LAS unsigned char* lds, int gw, int NGW, int wave, int lane) {
    LAS float* scr = (LAS float*)(lds + wave * 16384);
    unsigned char* ws = a.ws;
    constexpr int NE = P0_I_GU + P0_I_D + P0_I_IN;
    for (int i = gw; i < NE; i += NGW) {
        const int it = i < P0_I_GU ? i : (i < P0_I_GU + P0_I_D ? 2 * P0_I_GU + (i - P0_I_GU) : 2 * P0_I_GU + 2 * P0_I_D + (i - P0_I_GU - P0_I_D));
        p0_do_item(a, it, scr, lane); }
    bf16* XW = (bf16*)(ws + WS_XW);
    for (int m0 = gw; m0 < MPAD; m0 += 2 * NGW) {
        f32x4 v[2][4]; float sq[2] = {0.f, 0.f};
#pragma unroll
        for (int q = 0; q < 2; ++q) { const int m = m0 + q * NGW, mc = m < MT ? m : MT - 1;
            const float* xrow = mc < MP ? a.in[I_XP] + (size_t)mc * DM : a.in[I_XS] + (size_t)(mc - MP) * DM; const f32x4* xr = (const f32x4*)xrow + lane;
#pragma unroll
            for (int j = 0; j < 4; ++j) v[q][j] = __builtin_nontemporal_load(xr + 64 * j); }
#pragma unroll
        for (int q = 0; q < 2; ++q) { const float keep = (m0 + q * NGW < MT) ? 1.f : 0.f;
#pragma unroll
            for (int j = 0; j < 4; ++j) v[q][j] = v[q][j] * keep; }
        const f32x4* wr = (const f32x4*)a.in[I_N1W] + lane;
#pragma unroll
        for (int q = 0; q < 2; ++q)
#pragma unroll
            for (int j = 0; j < 4; ++j) sq[q] += (v[q][j].x * v[q][j].x + v[q][j].y * v[q][j].y) + (v[q][j].z * v[q][j].z + v[q][j].w * v[q][j].w);
#pragma unroll
        for (int q = 0; q < 2; ++q) { const int m = m0 + q * NGW; if (m >= MPAD) continue;
            const float rstd = rsqrtf(wave_sum(sq[q]) * (1.f / DM) + EPS);
            unsigned long long* o8 = (unsigned long long*)(XW + (size_t)m * DM) + lane;
#pragma unroll
            for (int j = 0; j < 4; ++j) { const f32x4 w4 = wr[64 * j]; o8[64 * j] = (unsigned long long)pk2(v[q][j].x * rstd * w4.x, v[q][j].y * rstd * w4.y) | ((unsigned long long)pk2(v[q][j].z * rstd * w4.z, v[q][j].w * rstd * w4.w) << 32); } }
    }
    { f32x4* z = (f32x4*)(ws + WS_SMALL); const int n16 = (int)(SM_DT / 16); for (int i = gw * 64 + lane; i < n16; i += NGW * 64) z[i] = (f32x4){0.f, 0.f, 0.f, 0.f}; }
}

__device__ __forceinline__ void small_gemm(LAS unsigned char* lds, const bf16* A, int lda, const bf16* Bt, int K,
                                           const float* base, float* out, float scale, bf16* xw, const float* wn, float* ss, const float* ssgp_rows = nullptr, const bf16* bbase = nullptr, const float* bw = nullptr) {
    const int tid = threadIdx.x, wid = __builtin_amdgcn_readfirstlane(tid >> 6), lane = tid & 63, i = lane & 15, q = lane >> 4, ks = wid & 3, tl = wid >> 2;
    LAS f32x4* red = (LAS f32x4*)lds;
    const int kq = K >> 2;
    for (int t0 = blockIdx.x * 2; t0 < 512; t0 += gridDim.x * 2) {
        const int t = t0 + tl, tr = t >> 6, tc = t & 63;
        f32x4 acc = {0.f, 0.f, 0.f, 0.f};
        if (t < 512) {
            const bf16* ap = A + (size_t)(tr * 16 + i) * lda + ks * kq + 8 * q; const bf16* bp = Bt + (size_t)(tc * 16 + i) * K + ks * kq + 8 * q;
#pragma unroll 4
            for (int k = 0; k < kq; k += 32) { const bf16x8 av = *(const bf16x8*)(ap + k), bv = *(const bf16x8*)(bp + k); acc = __builtin_amdgcn_mfma_f32_16x16x32_bf16(bv, av, acc, 0, 0, 0); }
        }
        if (ssgp_rows && ks < 2 && t < 512) {
            const f32x4* pp = (const f32x4*)(ssgp_rows + ((size_t)(tr * 16 + i) * 2 + ks) * 16); const f32x4 q4 = (pp[0] + pp[1]) + (pp[2] + pp[3]);
            acc = acc * rsqrtf(((q4[0] + q4[1]) + (q4[2] + q4[3])) * (1.0f / 512.0f) + 1e-6f); }
        red[(tl * 4 + ks) * 64 + lane] = acc;
        __syncthreads();
        if (ks == 0 && t < 512) {
            const f32x4 sum = (red[(tl * 4 + 0) * 64 + lane] + red[(tl * 4 + 1) * 64 + lane]) + (red[(tl * 4 + 2) * 64 + lane] + red[(tl * 4 + 3) * 64 + lane]);
            const int row = tr * 16 + i, col = tc * 16 + 4 * q; const size_t off = (size_t)row * 1024 + col;
            f32x4 bs_;
            if (bbase) { const v2u r_ = *(const v2u*)(bbase + off); const f32x4 q_ = *(const f32x4*)(bw + col);
                bs_ = (f32x4){__uint_as_float(r_.x << 16) / q_[0], __uint_as_float(r_.x & 0xffff0000u) / q_[1], __uint_as_float(r_.y << 16) / q_[2], __uint_as_float(r_.y & 0xffff0000u) / q_[3]}; }
            else bs_ = *(const f32x4*)(base + off);
            const f32x4 v = bs_ + sum * scale; if (out) *(f32x4*)(out + off) = v;
            float s = (v[0] * v[0] + v[1] * v[1]) + (v[2] * v[2] + v[3] * v[3]);
            if (xw) { const f32x4 w4 = wn ? *(const f32x4*)(wn + col) : (f32x4){1.f, 1.f, 1.f, 1.f}; v2u p; p.x = pk2(v[0] * w4[0], v[1] * w4[1]); p.y = pk2(v[2] * w4[2], v[3] * w4[3]); *(v2u*)(xw + off) = p; }
            if (ss) { s += __shfl_xor(s, 16); s += __shfl_xor(s, 32); if (q == 0) atomicAdd(ss + row, s); }
        }
        __syncthreads();
    }
}

__device__ __forceinline__ void bc_conv_prepass(const Args& a, int gw, int NGW, int lane) {
    const bf16* proj = (const bf16*)(a.ws + WS_PROJ); bf16* BCB = (bf16*)(a.ws + WS_BCB);
    const float* cw = a.in[I_CW] + 1024 + 8 * lane; const float* cb = a.in[I_CB] + 1024 + 8 * lane;
    float w[4][8], bi[8];
#pragma unroll
    for (int k = 0; k < 4; ++k) { const f32x4 w0 = *(const f32x4*)(cw + k * CONVD), w1 = *(const f32x4*)(cw + k * CONVD + 4);
        w[k][0] = w0[0]; w[k][1] = w0[1]; w[k][2] = w0[2]; w[k][3] = w0[3]; w[k][4] = w1[0]; w[k][5] = w1[1]; w[k][6] = w1[2]; w[k][7] = w1[3]; }
    { const f32x4 b0 = *(const f32x4*)(cb), b1 = *(const f32x4*)(cb + 4); bi[0] = b0[0]; bi[1] = b0[1]; bi[2] = b0[2]; bi[3] = b0[3]; bi[4] = b1[0]; bi[5] = b1[1]; bi[6] = b1[2]; bi[7] = b1[3]; }
    for (int u = gw; u < MP / 8; u += NGW) {
        const int row0 = u * 8, l0 = row0 & (SEQ - 1);
        const bf16* src = proj + (size_t)(row0 - 3) * LDPJ + PC_XBC + 1024 + 8 * lane;
        v4u raw[11];
#pragma unroll
        for (int rr = 0; rr < 11; ++rr) raw[rr] = (l0 - 3 + rr >= 0) ? *(const v4u*)(src + (size_t)rr * LDPJ) : (v4u){0u, 0u, 0u, 0u};
#pragma unroll
        for (int t = 0; t < 8; ++t) {
            float x0[8], x1[8], x2[8], x3[8], o[8]; unpack8(raw[t], x0); unpack8(raw[t + 1], x1); unpack8(raw[t + 2], x2); unpack8(raw[t + 3], x3);
#pragma unroll
            for (int j = 0; j < 8; ++j) o[j] = silu(bi[j] + w[0][j] * x0[j] + w[1][j] * x1[j] + w[2][j] * x2[j] + w[3][j] * x3[j]);
            v4u p; p.x = pk2(o[0], o[1]); p.y = pk2(o[2], o[3]); p.z = pk2(o[4], o[5]); p.w = pk2(o[6], o[7]);
            *(v4u*)(BCB + (lane < 32 ? 0 : BC_CDELTA) + (size_t)(row0 + t) * 256 + 8 * (lane & 31)) = p;
        }
    }
}

__device__ __forceinline__ int crow(int i, int hh) { return (i & 3) + 8 * (i >> 2) + 4 * hh; }
__device__ __forceinline__ void ssd_prompt(const Args& a, LAS unsigned char* lds, int unit) {
    const int tid0 = threadIdx.x, wid = __builtin_amdgcn_readfirstlane(tid0 >> 6);
    const int b = unit >> 5, h = (unit >> 1) & 15, ph = unit & 1, g = h >> 3;
    const float A_h = -__expf(a.in[I_ALOG][h]), dtb = a.in[I_DTB][h], Dh = a.in[I_DSKIP][h];
    bf16* proj = (bf16*)(a.ws + WS_PROJ); const float* dtbuf = (const float*)(a.ws + WS_SMALL + SM_DT); float* ssgp = (float*)(a.ws + WS_SSGP);
    LAS bf16* Cl = (LAS bf16*)(lds + CL_OFF); LAS bf16* Bl = (LAS bf16*)(lds + BL_OFF); LAS bf16* BT = (LAS bf16*)(lds + BT_OFF);
    LAS bf16* XDT = (LAS bf16*)(lds + XDT_OFF); LAS bf16* XDD = (LAS bf16*)(lds + XDD_OFF); LAS bf16* SENT = (LAS bf16*)(lds + SENT_OFF); LAS bf16* XS = (LAS bf16*)(lds + XS_OFF);
    LAS float* acum2 = (LAS float*)(lds + ACUM_OFF); LAS float* dtv2 = (LAS float*)(lds + DTV_OFF); LAS float* eac2 = (LAS float*)(lds + WBC_OFF); LAS float* WX = (LAS float*)(lds + WX_OFF);
    for (int i = tid0; i < 32 * LDP / 2; i += NTHR) ((LAS unsigned*)SENT)[i] = 0u;
    {
        const float* cw = a.in[I_CW]; const float* cb = a.in[I_CB];
        if (tid0 < 160) { const int k = tid0 >> 5, ch = h * 64 + 32 * ph + (tid0 & 31); WX[tid0] = k < 4 ? cw[k * CONVD + ch] : cb[ch]; }
    }
    const bf16* BCB = (const bf16*)(a.ws + WS_BCB);
    f32x16 st;
#pragma unroll
    for (int i = 0; i < 16; ++i) st[i] = 0.f;
    v4u nraw[8], nxraw[4]; float ndt0 = 0.f, ndt1 = 0.f;
    {
        const int tcol = tid0 & 15, tg = tid0 >> 4, xl = (tid0 & 15) | ((tid0 >> 6) << 4), xc = (tid0 >> 4) & 3;
        const bf16* src = BCB + (size_t)(b * SEQ + 4 * tg) * 256 + g * 128 + 8 * tcol;
#pragma unroll
        for (int rr = 0; rr < 4; ++rr) { nraw[rr] = *(const v4u*)(src + (size_t)rr * 256); nraw[4 + rr] = *(const v4u*)(src + BC_CDELTA + (size_t)rr * 256); }
        const bf16* srx = proj + (size_t)(b * SEQ + xl - 3) * LDPJ + PC_XBC + h * 64 + 32 * ph + 8 * xc;
#pragma unroll
        for (int rr = 0; rr < 4; ++rr) nxraw[rr] = (xl - 3 + rr >= 0) ? *(const v4u*)(srx + (size_t)rr * LDPJ) : (v4u){0u, 0u, 0u, 0u};
        if (wid == 4) { const int l0 = 2 * (tid0 & 63); ndt0 = dtbuf[(size_t)(b * SEQ + l0) * 16 + h]; ndt1 = dtbuf[(size_t)(b * SEQ + l0 + 1) * 16 + h]; }
    }
#define SSD_STAGE_D(buf) do { const int ln_ = tid0 & 63, l0_ = 2 * ln_; const float d0_ = softplus_fast(ndt0 + dtb), d1_ = softplus_fast(ndt1 + dtb), a0_ = d0_ * A_h, a1_ = d1_ * A_h, s_ = a0_ + a1_; float incl_ = s_; \
        _Pragma("unroll") for (int o_ = 1; o_ < 64; o_ <<= 1) { const float t_ = __shfl_up(incl_, o_); if (ln_ >= o_) incl_ += t_; } \
        const float c0_ = (incl_ - s_ + a0_) * 1.44269504f, c1_ = incl_ * 1.44269504f; acum2[(buf) * 128 + l0_] = c0_; acum2[(buf) * 128 + l0_ + 1] = c1_; eac2[(buf) * 128 + l0_] = __builtin_amdgcn_exp2f(c0_); eac2[(buf) * 128 + l0_ + 1] = __builtin_amdgcn_exp2f(c1_); dtv2[(buf) * 128 + l0_] = d0_; dtv2[(buf) * 128 + l0_ + 1] = d1_; } while (0)
    if (wid == 4) SSD_STAGE_D(0);
    __syncthreads();
    const bf16* p_bc; const bf16* p_x; bf16* p_z; const float* p_dt; float* p_sq;
    {   const int tcol = tid0 & 15, tg = tid0 >> 4, xl = (tid0 & 15) | ((tid0 >> 6) << 4), xc = (tid0 >> 4) & 3;
        p_bc = BCB + (size_t)(b * SEQ + 128 + 4 * tg) * 256 + g * 128 + 8 * tcol;
        p_x = proj + (size_t)(b * SEQ + 128 + xl - 3) * LDPJ + PC_XBC + h * 64 + 32 * ph + 8 * xc;
        p_z = proj + (size_t)(b * SEQ + xl) * LDPJ + PC_Z + h * 64 + 32 * ph + 8 * xc;
        p_dt = dtbuf + (size_t)(b * SEQ + 128 + 2 * (tid0 & 63)) * 16 + h;
        p_sq = ssgp + ((size_t)(b * SEQ + xl) * 2 + g) * 16 + (h & 7) * 2 + ph; }
#define SSD_BAR() do { asm volatile("s_waitcnt lgkmcnt(0)" ::: "memory"); __builtin_amdgcn_s_barrier(); asm volatile("" ::: "memory"); } while (0)
#pragma unroll 1
    for (int c = 0; c < 16; ++c) {
        int tid = tid0; asm volatile("" : "+v"(tid));
        const int lane = tid & 63, r = lane & 31, hh = lane >> 5;
        const int tcol = tid & 15, tg = tid >> 4;
        const int xl = (tid & 15) | ((tid >> 6) << 4), xc = (tid >> 4) & 3;
        const int tok0 = b * SEQ + c * 128;
        LAS float* acum = acum2 + (c & 1) * 128; LAS float* dtv = dtv2 + (c & 1) * 128; LAS float* eac = eac2 + (c & 1) * 128;
        {
#pragma unroll
            for (int t = 0; t < 4; ++t) { *(LAS v4u*)(Bl + (4 * tg + t) * LDP + 8 * tcol) = nraw[t]; *(LAS v4u*)(Cl + (4 * tg + t) * LDP + 8 * tcol) = nraw[4 + t]; }
            const int boff = 8 * ((tg >> 1) ^ tcol) + 4 * (tg & 1);
#pragma unroll
            for (int i = 0; i < 4; ++i) { v2u lo, hi;
#pragma unroll
                for (int u = 0; u < 2; ++u) { const unsigned e0 = nraw[2 * u][i], e1 = nraw[2 * u + 1][i]; lo[u] = (e0 & 0xffffu) | (e1 << 16); hi[u] = (e0 >> 16) | (e1 & 0xffff0000u); }
                *(LAS v2u*)(BT + (8 * tcol + 2 * i) * LDP + boff) = lo; *(LAS v2u*)(BT + (8 * tcol + 2 * i + 1) * LDP + boff) = hi; }
        }
        {
            float x0[8], x1[8], x2[8], x3[8]; unpack8(nxraw[0], x0); unpack8(nxraw[1], x1); unpack8(nxraw[2], x2); unpack8(nxraw[3], x3);
            float xo[8];
#pragma unroll
            for (int hf = 0; hf < 2; ++hf) { const f32x4 w0 = *(const LAS f32x4*)(WX + 0 * 32 + 8 * xc + 4 * hf), w1 = *(const LAS f32x4*)(WX + 1 * 32 + 8 * xc + 4 * hf), w2 = *(const LAS f32x4*)(WX + 2 * 32 + 8 * xc + 4 * hf),
                                                     w3 = *(const LAS f32x4*)(WX + 3 * 32 + 8 * xc + 4 * hf), bb = *(const LAS f32x4*)(WX + 4 * 32 + 8 * xc + 4 * hf);
#pragma unroll
                for (int e = 0; e < 4; ++e) { const int j = 4 * hf + e; xo[j] = silu(bb[e] + w0[e] * x0[j] + w1[e] * x1[j] + w2[e] * x2[j] + w3[e] * x3[j]); } }
            const float dl = dtv[xl], de = dl * __builtin_amdgcn_exp2f(acum[127] - acum[xl]);
            { v4u p; p.x = pk2(xo[0], xo[1]); p.y = pk2(xo[2], xo[3]); p.z = pk2(xo[4], xo[5]); p.w = pk2(xo[6], xo[7]); *(LAS v4u*)(XS + xl * 32 + 8 * xc) = p; }
#pragma unroll
            for (int j = 0; j < 8; ++j) { const unsigned pk = pk2(xo[j] * dl, xo[j] * de); XDT[(8 * xc + j) * LDP + xl] = (unsigned short)pk; XDD[(8 * xc + j) * LDP + xl] = (unsigned short)(pk >> 16); }
        }
        SSD_BAR();
        if (c < 15) {
#pragma unroll
            for (int rr = 0; rr < 4; ++rr) { nraw[rr] = *(const v4u*)(p_bc + (size_t)rr * 256); nraw[4 + rr] = *(const v4u*)(p_bc + BC_CDELTA + (size_t)rr * 256); }
#pragma unroll
            for (int rr = 0; rr < 4; ++rr) nxraw[rr] = *(const v4u*)(p_x + (size_t)rr * LDPJ);
            if (wid == 4) { ndt0 = p_dt[0]; ndt1 = p_dt[16]; }
        }
        const v4u zraw = *(const v4u*)p_z;
        const int lb = wid >> 1, sh = wid & 1;
        f32x16 sacc[2];
        {
            bf16x8 cf[8];
#pragma unroll
            for (int ks = 0; ks < 8; ++ks) cf[ks] = *(const LAS bf16x8*)(Cl + (32 * lb + r) * LDP + 16 * ks + 8 * hh);
#pragma unroll
            for (int tt = 0; tt < 2; ++tt) { const int sb = 2 * sh + tt;
#pragma unroll
                for (int i = 0; i < 16; ++i) sacc[tt][i] = 0.f;
                if (sb <= lb) {
#pragma unroll
                    for (int ks = 0; ks < 8; ++ks) { const bf16x8 af = *(const LAS bf16x8*)(Bl + (32 * sb + r) * LDP + 16 * ks + 8 * hh); sacc[tt] = MFMA32(af, cf[ks], sacc[tt]); } } }
        }
        SSD_BAR();
        {
            LAS bf16* P = Bl; const int l = 32 * lb + r; const float al = acum[l];
#pragma unroll
            for (int tt = 0; tt < 2; ++tt) { const int sb = 2 * sh + tt;
                if (sb < lb) {
#pragma unroll
                    for (int gq = 0; gq < 4; ++gq) { const int s0 = 32 * sb + 8 * gq + 4 * hh; const f32x4 as4 = *(const LAS f32x4*)(acum + s0); float v[4];
#pragma unroll
                        for (int e = 0; e < 4; ++e) v[e] = sacc[tt][4 * gq + e] * __builtin_amdgcn_exp2f(al - as4[e]);
                        v2u p; p.x = pk2(v[0], v[1]); p.y = pk2(v[2], v[3]); *(LAS v2u*)(P + l * LDP + s0) = p; }
                } else if (sb == lb) {
#pragma unroll
                    for (int gq = 0; gq < 4; ++gq) { const int s0 = 32 * sb + 8 * gq + 4 * hh; const f32x4 as4 = *(const LAS f32x4*)(acum + s0); float v[4];
#pragma unroll
                        for (int e = 0; e < 4; ++e) v[e] = (s0 + e <= l) ? sacc[tt][4 * gq + e] * __builtin_amdgcn_exp2f(al - as4[e]) : 0.f;
                        v2u p; p.x = pk2(v[0], v[1]); p.y = pk2(v[2], v[3]); *(LAS v2u*)(P + l * LDP + s0) = p; } } }
        }
        SSD_BAR();
        asm volatile("" : "+v"(nraw[0]), "+v"(nraw[1]), "+v"(nraw[2]), "+v"(nraw[3]), "+v"(nraw[4]), "+v"(nraw[5]), "+v"(nraw[6]), "+v"(nraw[7]), "+v"(nxraw[0]), "+v"(nxraw[1]), "+v"(nxraw[2]), "+v"(nxraw[3]), "+v"(ndt0), "+v"(ndt1));
        if (wid < 4) {
            const int lb2 = wid; const LAS bf16* P = Bl;
            f32x16 yd, yo;
#pragma unroll
            for (int i = 0; i < 16; ++i) { yd[i] = 0.f; yo[i] = 0.f; }
            for (int sb = 0; sb <= lb2; ++sb) {
                const bf16x8 af0 = *(const LAS bf16x8*)(P + (32 * lb2 + r) * LDP + 32 * sb + 8 * hh), bf0 = *(const LAS bf16x8*)(XDT + r * LDP + 32 * sb + 8 * hh),
                             af1 = *(const LAS bf16x8*)(P + (32 * lb2 + r) * LDP + 32 * sb + 16 + 8 * hh), bf1 = *(const LAS bf16x8*)(XDT + r * LDP + 32 * sb + 16 + 8 * hh);
                yd = MFMA32(af0, bf0, yd); yd = MFMA32(af1, bf1, yd); }
#pragma unroll
            for (int ks = 0; ks < 8; ++ks) { const bf16x8 af = *(const LAS bf16x8*)(Cl + (32 * lb2 + r) * LDP + 16 * ks + 8 * hh), bfv = *(const LAS bf16x8*)(SENT + r * LDP + 16 * ks + 8 * hh); yo = MFMA32(af, bfv, yo); }
#pragma unroll
            for (int g4 = 0; g4 < 4; ++g4) { const f32x4 ea = *(const LAS f32x4*)(eac + 32 * lb2 + 8 * g4 + 4 * hh);
#pragma unroll
                for (int e = 0; e < 4; ++e) { const int i = 4 * g4 + e, l = 32 * lb2 + 8 * g4 + 4 * hh + e;
                    XS[l * 32 + r] = f2bf1(yd[i] + ea[e] * yo[i] + Dh * bf2f(XS[l * 32 + r])); } }
        } else {
            const int nb = wid - 4; const float cd = eac[127];
#pragma unroll
            for (int i = 0; i < 16; ++i) st[i] *= cd;
#pragma unroll
            for (int ks = 0; ks < 8; ++ks) { const bf16x8 af = *(const LAS bf16x8*)(BT + (32 * nb + r) * LDP + 8 * ((2 * ks + hh) ^ ((4 * nb + (r >> 3)) & 15))), bfv = *(const LAS bf16x8*)(XDD + r * LDP + 16 * ks + 8 * hh); st = MFMA32(af, bfv, st); }
            if (wid == 4 && c < 15) SSD_STAGE_D((c + 1) & 1);
        }
        SSD_BAR();
        if (wid >= 4) { const int nb = wid - 4;
#pragma unroll
            for (int gq = 0; gq < 4; ++gq) { v2u p; p.x = pk2(st[4 * gq], st[4 * gq + 1]); p.y = pk2(st[4 * gq + 2], st[4 * gq + 3]); *(LAS v2u*)(SENT + r * LDP + 32 * nb + 8 * gq + 4 * hh) = p; } }
        {
            float yv[8], zf[8]; unpack8(*(const LAS v4u*)(XS + xl * 32 + 8 * xc), yv); unpack8(zraw, zf);
            float sq = 0.f;
#pragma unroll
            for (int j = 0; j < 8; ++j) { yv[j] *= zf[j]; sq += yv[j] * yv[j]; }
            v4u o; o.x = pk2(yv[0], yv[1]); o.y = pk2(yv[2], yv[3]); o.z = pk2(yv[4], yv[5]); o.w = pk2(yv[6], yv[7]);
            *(v4u*)p_z = o;
            sq += __shfl_xor(sq, 16); sq += __shfl_xor(sq, 32);
            if (xc == 0) *p_sq = sq;
        }
        p_bc += 128 * 256; p_x += (size_t)128 * LDPJ; p_z += (size_t)128 * LDPJ; p_dt += 128 * 16; p_sq += 128 * 2 * 16;
    }
#undef SSD_STAGE_D
#undef SSD_BAR
    const int r = tid0 & 31, hh = (tid0 >> 5) & 1;
    if (wid >= 4) { const int nb = wid - 4; float* o = a.out + O_SSMP + ((size_t)(b * 16 + h) * 64 + 32 * ph + r) * 128 + 32 * nb + 4 * hh;
#pragma unroll
        for (int gq = 0; gq < 4; ++gq) *(f32x4*)(o + 8 * gq) = (f32x4){st[4 * gq], st[4 * gq + 1], st[4 * gq + 2], st[4 * gq + 3]}; }
    __syncthreads();
}
constexpr int SMP_SCR = 11264;
__device__ __forceinline__ void ssd_sample(const Args& a, LAS float* scr, int wu, int lane) {
    const int j = wu >> 4, h = wu & 15, g = h >> 3; const size_t row = (size_t)(MP + j);
    bf16* prow = (bf16*)(a.ws + WS_PROJ) + row * LDPJ; const float* dtbuf = (const float*)(a.ws + WS_SMALL + SM_DT); float* ssgp = (float*)(a.ws + WS_SSGP);
    const float* cw = a.in[I_CW]; const float* cb = a.in[I_CB]; const float* cst = a.in[I_SCONV0] + (size_t)j * 3 * CONVD;
    const float A_h = -__expf(a.in[I_ALOG][h]), Dh = a.in[I_DSKIP][h];
    const float dt = softplus(dtbuf[row * 16 + h] + a.in[I_DTB][h]), dA = __expf(dt * A_h);
    LAS float* sx = scr; LAS float* sxs = scr + 64; LAS float* sB = scr + 128; LAS float* sC = scr + 256; LAS float* sp = scr + 384;
#pragma unroll
    for (int t = 0; t < 5; ++t) {
        const int ch = t == 0 ? (h * 64 + lane) : (t < 3 ? (1024 + g * 128 + lane + 64 * (t - 1)) : (1280 + g * 128 + lane + 64 * (t - 3)));
        float v = cb[ch] + cw[0 * CONVD + ch] * cst[0 * CONVD + ch] + cw[1 * CONVD + ch] * cst[1 * CONVD + ch] + cw[2 * CONVD + ch] * cst[2 * CONVD + ch] + cw[3 * CONVD + ch] * bf2f(prow[PC_XBC + ch]);
        v = silu(v);
        if (t == 0) { sx[lane] = v * dt; sxs[lane] = v; } else if (t < 3) sB[lane + 64 * (t - 1)] = v; else sC[lane + 64 * (t - 3)] = v;
    }
    const float zf = bf2f(prow[PC_Z + h * 64 + lane]);
    LDS_WAIT();
    const int rs = lane >> 5, n4 = lane & 31;
    const f32x4 Br = *(const LAS f32x4*)(sB + 4 * n4), Cr = *(const LAS f32x4*)(sC + 4 * n4);
    const f32x4* __restrict__ S0 = (const f32x4*)(a.in[I_SSM] + ((size_t)(j * 16 + h) * 64) * 128) + lane; f32x4* __restrict__ S1 = (f32x4*)(a.out + O_SSMS + ((size_t)(j * 16 + h) * 64) * 128) + lane;
#pragma unroll 1
    for (int it0 = 0; it0 < 32; it0 += 16) {
        f32x4 s4[16];
#pragma unroll
        for (int k = 0; k < 16; ++k) s4[k] = __builtin_nontemporal_load(S0 + 64 * (it0 + k));
#pragma unroll
        for (int k = 0; k < 16; ++k) { const int p = 2 * (it0 + k) + rs; const float xd = sx[p];
            const f32x4 nv = s4[k] * dA + Br * xd; __builtin_nontemporal_store(nv, S1 + 64 * (it0 + k));
            sp[p * 36 + n4] = (nv[0] * Cr[0] + nv[1] * Cr[1]) + (nv[2] * Cr[2] + nv[3] * Cr[3]); }
    }
    LDS_WAIT();
    float y = 0.f;
#pragma unroll
    for (int k = 0; k < 8; ++k) { const f32x4 v = *(const LAS f32x4*)(sp + lane * 36 + 4 * k); y += (v[0] + v[1]) + (v[2] + v[3]); }
    y = (y + Dh * sxs[lane]) * zf;
    prow[PC_Z + h * 64 + lane] = f2bf1(y);
    const float sq = wave_sum(y * y);
    if (lane < 2) ssgp[(row * 2 + g) * 16 + (h & 7) * 2 + lane] = lane == 0 ? sq : 0.f;
    LDS_WAIT();
}

__device__ __forceinline__ void p5_fix(const Args& a, int gw, int NGW, int lane) {
    bf16* proj = (bf16*)(a.ws + WS_PROJ); const float* ssgp = (const float*)(a.ws + WS_SSGP);
    const float* snw = a.in[I_SNW]; const float* scw = a.in[I_SCW];
    for (int u = gw; u < 2048 + 256; u += NGW) {
        const bool smp = u >= 2048; const int uu = smp ? u - 2048 : u, tgp = uu >> 1, kind = 2 + (uu & 1);
        const size_t row0 = smp ? (size_t)(MP + tgp) : (size_t)tgp * 16;
        if (kind < 2) continue;
        if (false) {
            const int ch = 512 * kind + 8 * lane; const f32x4 w0 = *(const f32x4*)(snw + ch), w1 = *(const f32x4*)(snw + ch + 4);
            if (smp) {
                const f32x4* pp = (const f32x4*)(ssgp + (row0 * 2 + kind) * 16); const f32x4 q4 = (pp[0] + pp[1]) + (pp[2] + pp[3]); const float rs = rsqrtf(((q4[0] + q4[1]) + (q4[2] + q4[3])) * (1.f / 512.f) + EPS);
                v4u* p = (v4u*)(proj + row0 * LDPJ + PC_Z + ch); float f[8]; unpack8(*p, f);
                v4u o; o.x = pk2(f[0] * rs * w0[0], f[1] * rs * w0[1]); o.y = pk2(f[2] * rs * w0[2], f[3] * rs * w0[3]); o.z = pk2(f[4] * rs * w1[0], f[5] * rs * w1[1]); o.w = pk2(f[6] * rs * w1[2], f[7] * rs * w1[3]); *p = o;
            } else {
                v4u raw[16]; float qs[16];
#pragma unroll
                for (int t = 0; t < 16; ++t) raw[t] = *(const v4u*)(proj + (row0 + t) * LDPJ + PC_Z + ch);
#pragma unroll
                for (int t = 0; t < 16; ++t) { const f32x4* pp = (const f32x4*)(ssgp + ((row0 + t) * 2 + kind) * 16); const f32x4 q4 = (pp[0] + pp[1]) + (pp[2] + pp[3]); qs[t] = (q4[0] + q4[1]) + (q4[2] + q4[3]); }
#pragma unroll
                for (int t = 0; t < 16; ++t) { const float rs = rsqrtf(qs[t] * (1.f / 512.f) + EPS); float f[8]; unpack8(raw[t], f);
                    v4u o; o.x = pk2(f[0] * rs * w0[0], f[1] * rs * w0[1]); o.y = pk2(f[2] * rs * w0[2], f[3] * rs * w0[3]); o.z = pk2(f[4] * rs * w1[0], f[5] * rs * w1[1]); o.w = pk2(f[6] * rs * w1[2], f[7] * rs * w1[3]);
                    *(v4u*)(proj + (row0 + t) * LDPJ + PC_Z + ch) = o; }
            }
        } else {
            const int ch = 512 * (kind - 2) + 8 * lane; float w[3][8];
#pragma unroll
            for (int k = 0; k < 3; ++k) { const f32x4 a0 = *(const f32x4*)(scw + k * 1024 + ch), a1 = *(const f32x4*)(scw + k * 1024 + ch + 4);
                w[k][0] = a0[0]; w[k][1] = a0[1]; w[k][2] = a0[2]; w[k][3] = a0[3]; w[k][4] = a1[0]; w[k][5] = a1[1]; w[k][6] = a1[2]; w[k][7] = a1[3]; }
            float u2[8], u1[8];
            if (smp) { const float* sp_ = a.in[I_SSCONV] + (size_t)tgp * 2 * 1024 + ch; float cc[8], hv[8], bb[8], uc[8], y[8];
#pragma unroll
                for (int e = 0; e < 8; ++e) { u2[e] = sp_[e]; u1[e] = sp_[1024 + e]; }
                unpack8(*(const v4u*)(proj + row0 * LDPJ + PC_SCC + ch), cc); v4u* pb = (v4u*)(proj + row0 * LDPJ + PC_SCB + ch); unpack8(*pb, bb); (void)hv;
#pragma unroll
                for (int e = 0; e < 8; ++e) { uc[e] = cc[e]; y[e] = bb[e] * (w[0][e] * u2[e] + w[1][e] * u1[e] + w[2][e] * uc[e]); }
                v4u o; o.x = pk2(y[0], y[1]); o.y = pk2(y[2], y[3]); o.z = pk2(y[4], y[5]); o.w = pk2(y[6], y[7]); *pb = o;
                float* d = a.out + O_SCS + (size_t)tgp * 2 * 1024 + ch;
#pragma unroll
                for (int e = 0; e < 8; ++e) { d[e] = u1[e]; d[1024 + e] = uc[e]; }
            } else {
                const int l0 = (tgp & 127) * 16;
                v4u hc[2];
#pragma unroll
                for (int q = 0; q < 2; ++q) { const bool ok = l0 > 0; hc[q] = ok ? *(const v4u*)(proj + (row0 - 2 + q) * LDPJ + PC_SCC + ch) : (v4u){0u, 0u, 0u, 0u}; }
                unpack8(hc[0], u2); unpack8(hc[1], u1);
#pragma unroll
                for (int half = 0; half < 2; ++half) {
                    v4u rc[8], rb[8];
#pragma unroll
                    for (int t = 0; t < 8; ++t) { const size_t row = row0 + 8 * half + t; rc[t] = __builtin_nontemporal_load((const v4u*)(proj + row * LDPJ + PC_SCC + ch)); rb[t] = __builtin_nontemporal_load((const v4u*)(proj + row * LDPJ + PC_SCB + ch)); }
#pragma unroll
                    for (int t = 0; t < 8; ++t) { const size_t row = row0 + 8 * half + t; float bb[8], uc[8], y[8]; unpack8(rc[t], uc); unpack8(rb[t], bb);
#pragma unroll
                        for (int e = 0; e < 8; ++e) { y[e] = bb[e] * (w[0][e] * u2[e] + w[1][e] * u1[e] + w[2][e] * uc[e]); }
                        v4u o; o.x = pk2(y[0], y[1]); o.y = pk2(y[2], y[3]); o.z = pk2(y[4], y[5]); o.w = pk2(y[6], y[7]); *(v4u*)(proj + row * LDPJ + PC_SCB + ch) = o;
                        const int l = l0 + 8 * half + t;
                        if (l >= SEQ - 2) { float* d = a.out + O_SCP + ((size_t)(tgp >> 7) * 2 + (l - (SEQ - 2))) * 1024 + ch;
#pragma unroll
                            for (int e = 0; e < 8; ++e) d[e] = uc[e]; }
#pragma unroll
                        for (int e = 0; e < 8; ++e) { u2[e] = u1[e]; u1[e] = uc[e]; } }
                }
            }
        }
    }
    const int gt = gw * 64 + lane, NT = NGW * 64;
    for (int i4 = gt; i4 < NBATCH * 3 * CONVD / 4; i4 += NT) { const int i = 4 * i4, c = i % CONVD, k = (i / CONVD) % 3, b = i / (3 * CONVD);
        const v2u r2 = *(const v2u*)(proj + (size_t)(b * SEQ + SEQ - 3 + k) * LDPJ + PC_XBC + c);
        *(f32x4*)(a.out + O_CONVP + i) = (f32x4){__uint_as_float(r2.x << 16), __uint_as_float(r2.x & 0xffff0000u), __uint_as_float(r2.y << 16), __uint_as_float(r2.y & 0xffff0000u)}; }
    for (int i4 = gt; i4 < NS * 3 * CONVD / 4; i4 += NT) { const int i = 4 * i4, c = i % CONVD, k = (i / CONVD) % 3, j = i / (3 * CONVD);
        f32x4 o;
        if (k < 2) o = *(const f32x4*)(a.in[I_SCONV0] + (size_t)j * 3 * CONVD + (k + 1) * CONVD + c);
        else { const v2u r2 = *(const v2u*)(proj + (size_t)(MP + j) * LDPJ + PC_XBC + c); o = (f32x4){__uint_as_float(r2.x << 16), __uint_as_float(r2.x & 0xffff0000u), __uint_as_float(r2.y << 16), __uint_as_float(r2.y & 0xffff0000u)}; }
        *(f32x4*)(a.out + O_CONVS + i) = o; }
}

#define XB_TMO      128
#define XB_XCNT(j)  (256  + 64 * (j))
#define XB_XSUB(j)  (1280 + 64 * (j))
#define XB_XGEN(j)  (2304 + 64 * (j))
#define XB_TOP      3328
#define XB_TOPGEN   3392
#define XCD_BAR_WORDS 3456
#define XB_SPIN_CAP (1u << 18)

__device__ __forceinline__ unsigned xb_ld(unsigned* p)              { return __hip_atomic_load(p, __ATOMIC_RELAXED, __HIP_MEMORY_SCOPE_AGENT); }
__device__ __forceinline__ unsigned xb_add(unsigned* p, unsigned v) { return __hip_atomic_fetch_add(p, v, __ATOMIC_RELAXED, __HIP_MEMORY_SCOPE_AGENT); }
__device__ __forceinline__ unsigned xb_xcc_id() { return (unsigned)__builtin_amdgcn_s_getreg((3 << 11) | 20) & 0xFu; }
#define XB_SPIN(cond, bar) do { unsigned _sp = 0; while (cond) { __builtin_amdgcn_s_sleep(1); \
    if ((++_sp & 255u) == 0u) { if (xb_ld(&(bar)[XB_TMO])) break; if (_sp > XB_SPIN_CAP) { atomicAdd(&(bar)[XB_TMO], 1u); break; } } } } while (0)

struct XcdBarrier {
    unsigned* bar; unsigned x;
    volatile LAS unsigned* st;
};

__device__ __forceinline__ XcdBarrier xcd_barrier_post(unsigned* bar, volatile LAS unsigned* st) {
    XcdBarrier b; b.bar = bar; b.x = xb_xcc_id(); b.st = st;
    if (threadIdx.x == 0) (void)xb_add(&bar[XB_XCNT(b.x)], 1u);
    return b;
}
__device__ __forceinline__ void xcd_barrier_complete(unsigned* bar, unsigned x, unsigned& nloc, unsigned& nx) {
    const unsigned G = gridDim.x * gridDim.y * gridDim.z;
    unsigned sum, cnt, mine, sp = 0u;
    for (;;) {
        sum = 0u; cnt = 0u; mine = 0u;
#pragma unroll
        for (unsigned j = 0; j < 16; ++j) { const unsigned c = xb_ld(&bar[XB_XCNT(j)]); sum += c; cnt += (c > 0u) ? 1u : 0u; mine = (j == x) ? c : mine; }
        if (sum == G) break;
        __builtin_amdgcn_s_sleep(1);
        if ((++sp & 255u) == 0u) { if (xb_ld(&bar[XB_TMO])) break; if (sp > XB_SPIN_CAP) { atomicAdd(&bar[XB_TMO], 1u); break; } }
    }
    nloc = mine > 0u ? mine : 1u; nx = cnt > 0u ? cnt : 1u;
}

__device__ __forceinline__ void xcd_barrier(const XcdBarrier& b) {
    asm volatile("s_waitcnt vmcnt(0)" ::: "memory");
    __syncthreads();
    if (threadIdx.x == 0) {
        unsigned* bar = b.bar;
        __builtin_amdgcn_s_waitcnt(0);
        unsigned nloc = b.st[0], nx = b.st[1];
        if (nloc == 0u) { xcd_barrier_complete(bar, b.x, nloc, nx); b.st[0] = nloc; b.st[1] = nx; }
        const unsigned old = xb_add(&bar[XB_XSUB(b.x)], 1u);
        const unsigned gen = old / nloc;
        if (old + 1u == (gen + 1u) * nloc) {
            __builtin_amdgcn_fence(__ATOMIC_RELEASE, "agent");
            asm volatile("s_waitcnt vmcnt(0)" ::: "memory");
            const unsigned og = xb_add(&bar[XB_TOP], 1u);
            const unsigned tg = og / nx;
            if (og + 1u == (tg + 1u) * nx) xb_add(&bar[XB_TOPGEN], 1u);
            else XB_SPIN(xb_ld(&bar[XB_TOPGEN]) == tg, bar);
            __builtin_amdgcn_fence(__ATOMIC_ACQUIRE, "agent");
            xb_add(&bar[XB_XGEN(b.x)], 1u);
            asm volatile("s_waitcnt vmcnt(0)" ::: "memory");
        } else {
            XB_SPIN(xb_ld(&bar[XB_XGEN(b.x)]) == gen, bar);
            __builtin_amdgcn_fence(__ATOMIC_ACQUIRE, "agent");
            asm volatile("s_waitcnt vmcnt(0)" ::: "memory");
        }
    }
    __syncthreads();
}

__global__ void __launch_bounds__(NTHR, 2) hymba_fwd(Args a) {
    extern __shared__ __attribute__((aligned(16))) unsigned char lds_raw[];
    cg::grid_group grid = cg::this_grid();
    LAS unsigned char* lds = (LAS unsigned char*)lds_raw;
    const int tid = threadIdx.x, lane = tid & 63, wave = __builtin_amdgcn_readfirstlane(tid >> 6);
    const int G = gridDim.x, gw = blockIdx.x * NWAVES + wave, NGW = G * NWAVES;
    unsigned char* ws = a.ws;
    bf16* XW = (bf16*)(ws + WS_XW); bf16* H = (bf16*)(ws + WS_H); bf16* PROJ = (bf16*)(ws + WS_PROJ);
    float* ss2 = (float*)(ws + WS_SMALL + SM_SS2); float* ss3 = (float*)(ws + WS_SMALL + SM_SS3); float* dtbuf = (float*)(ws + WS_SMALL + SM_DT);
    float* xres = a.out + O_Y;
    volatile LAS unsigned* MISC = (volatile LAS unsigned*)(lds + LDS_BYTES - 64);
    if (tid < 16) MISC[tid] = 0u;
    __syncthreads();
    XcdBarrier bar = xcd_barrier_post((unsigned*)(ws + WS_BAR), MISC);
    const int lo = a.ph_lo, hi = a.ph_hi;
#ifndef PH_MASK
#define PH_MASK 0x7ff
#endif
#define IN(k) (((PH_MASK >> (k)) & 1) && lo <= (k) && (k) < hi)
#define SEAM(k) do { if (IN(k) && IN((k) + 1)) xcd_barrier(bar); } while (0)
    if (a.ph_hi > 1000) grid.sync();
    if (IN(0)) p0_prologue(a, lds, gw, NGW, wave, lane);
    SEAM(0);
    if (IN(1)) {
        pg8::Gemm g{XW, (const bf16*)(ws + WS_W1GU), MPAD, NGU, DM, DM}; pg8::StaticOrder S; S.init(MPAD, NGU, G, (int)blockIdx.x);
        pg8::EpiSwiGLU<false> E{H, DFF, nullptr};
        pg8::gemm_phase<pg8::EpiSwiGLU<false>, pg8::StaticOrder, true, true>(lds, g, S, E);
    }
    SEAM(1);
    if (IN(2)) {
        pg8::Gemm g{H, (const bf16*)(ws + WS_W1D), MP, DM, DFF, DFF}; pg8::StaticOrder S; S.init(MP, DM, G, (int)blockIdx.x);
        pg8::EpiRes E{a.in[I_XP], nullptr, 0.5f, XW, a.in[I_NMW], ss2, nullptr, nullptr, nullptr};
        pg8::gemm_phase<pg8::EpiRes, pg8::StaticOrder, true, true>(lds, g, S, E);
        if (!(a.flags & 4)) small_gemm(lds, H + (size_t)MP * DFF, DFF, (const bf16*)(ws + WS_W1D), DFF, a.in[I_XS], nullptr, 0.5f, XW + (size_t)MP * DM, a.in[I_NMW], ss2 + MP);
    }
    SEAM(2);
    if (IN(3)) {
        pg8::Gemm g{XW, (const bf16*)(ws + WS_WIN), MPAD, NINP, DM, DM}; pg8::StaticOrder S; S.init(MPAD, NINP, G, (int)blockIdx.x);
        pg8::EpiProj E{PROJ, LDPJ, ss2, dtbuf, LDPJ / 256, a.flags & 8, PC_SCC / 256};
        pg8::gemm_phase<pg8::EpiProj, pg8::StaticOrder, true, true>(lds, g, S, E);
    }
    SEAM(3);
    if (IN(4)) { bc_conv_prepass(a, gw, NGW, lane); p5_fix(a, gw, NGW, lane); p0_late_weights(a, lds, gw, NGW, wave, lane); }
    SEAM(4);
    if (IN(5)) {
        if (!(a.flags & 2)) for (int u = blockIdx.x; u < NBATCH * 32; u += G) ssd_prompt(a, lds, (G == NBATCH * 32) ? ((u & 7) * 32 + (u >> 3)) : u);
        if (!(a.flags & 1)) for (int wu = gw; wu < NS * 16; wu += NGW) ssd_sample(a, (LAS float*)(lds + wave * SMP_SCR), wu, lane);
    }
    do { if (IN(5) && IN(7)) xcd_barrier(bar); } while (0);
    if (IN(7)) {
        pg8::Gemm g{PROJ, (const bf16*)(ws + WS_WOUT), MP, DM, DMIX, LDPJ}; pg8::StaticOrder S; S.init(MP, DM, G, (int)blockIdx.x);
        pg8::EpiResT<true> E{nullptr, nullptr, 1.0f, XW, a.in[I_N2W], ss3, (const float*)(ws + WS_SSGP), XW, a.in[I_NMW]};
        pg8::gemm_phase<pg8::EpiResT<true>, pg8::StaticOrder, true, true>(lds, g, S, E);
        if (!(a.flags & 4)) small_gemm(lds, PROJ + (size_t)MP * LDPJ, LDPJ, (const bf16*)(ws + WS_WOUT), DMIX, nullptr, nullptr, 1.0f, XW + (size_t)MP * DM, a.in[I_N2W], ss3 + MP, (const float*)(ws + WS_SSGP) + (size_t)MP * 2 * 16, XW + (size_t)MP * DM, a.in[I_NMW]);
    }
    SEAM(7);
    if (IN(8)) {
        pg8::Gemm g{XW, (const bf16*)(ws + WS_W2GU), MPAD, NGU, DM, DM}; pg8::StaticOrder S; S.init(MPAD, NGU, G, (int)blockIdx.x);
        pg8::EpiSwiGLU<true> E{H, DFF, ss3};
        pg8::gemm_phase<pg8::EpiSwiGLU<true>, pg8::StaticOrder, true, true>(lds, g, S, E);
    }
    SEAM(8);
    if (IN(9)) {
        pg8::Gemm g{H, (const bf16*)(ws + WS_W2D), MP, DM, DFF, DFF}; pg8::StaticOrder S; S.init(MP, DM, G, (int)blockIdx.x);
        pg8::EpiRes E{nullptr, nullptr, 0.5f, XW, nullptr, nullptr, nullptr, XW, a.in[I_N2W]};
        pg8::gemm_phase<pg8::EpiRes, pg8::StaticOrder, true, true>(lds, g, S, E);
        if (!(a.flags & 4)) small_gemm(lds, H + (size_t)MP * DFF, DFF, (const bf16*)(ws + WS_W2D), DFF, nullptr, nullptr, 0.5f, XW + (size_t)MP * DM, nullptr, nullptr, nullptr, XW + (size_t)MP * DM, a.in[I_N2W]);
    }
    SEAM(9);
    if (IN(10)) {
        const f32x4* wr = (const f32x4*)a.in[I_FNW] + lane;
        f32x4 w4[4];
#pragma unroll
        for (int j = 0; j < 4; ++j) w4[j] = wr[64 * j];
        for (int m = gw; m < MT; m += 2 * NGW) { const int m2 = m + NGW; const bool two = m2 < MT;
            const unsigned long long* xb = (const unsigned long long*)(XW + (size_t)m * DM) + lane; const unsigned long long* xb2 = (const unsigned long long*)(XW + (size_t)(two ? m2 : m) * DM) + lane;
            f32x4* xr = (f32x4*)(xres + (size_t)m * DM) + lane; f32x4* xr2 = (f32x4*)(xres + (size_t)(two ? m2 : m) * DM) + lane; unsigned long long r[4], r2[4]; f32x4 v[4], v2[4]; float s = 0.f, s2 = 0.f;
#pragma unroll
            for (int j = 0; j < 4; ++j) { r[j] = __builtin_nontemporal_load(xb + 64 * j); r2[j] = __builtin_nontemporal_load(xb2 + 64 * j); }
#pragma unroll
            for (int j = 0; j < 4; ++j) { const unsigned lo = (unsigned)r[j], hi = (unsigned)(r[j] >> 32), lo2 = (unsigned)r2[j], hi2 = (unsigned)(r2[j] >> 32);
                v[j] = (f32x4){__uint_as_float(lo << 16), __uint_as_float(lo & 0xffff0000u), __uint_as_float(hi << 16), __uint_as_float(hi & 0xffff0000u)};
                v2[j] = (f32x4){__uint_as_float(lo2 << 16), __uint_as_float(lo2 & 0xffff0000u), __uint_as_float(hi2 << 16), __uint_as_float(hi2 & 0xffff0000u)}; }
#pragma unroll
            for (int j = 0; j < 4; ++j) { s += (v[j].x * v[j].x + v[j].y * v[j].y) + (v[j].z * v[j].z + v[j].w * v[j].w); s2 += (v2[j].x * v2[j].x + v2[j].y * v2[j].y) + (v2[j].z * v2[j].z + v2[j].w * v2[j].w); }
            const float rstd = rsqrtf(wave_sum(s) * (1.f / DM) + EPS), rstd2 = rsqrtf(wave_sum(s2) * (1.f / DM) + EPS);
#pragma unroll
            for (int j = 0; j < 4; ++j) __builtin_nontemporal_store(v[j] * rstd * w4[j], xr + 64 * j);
            if (two) {
#pragma unroll
                for (int j = 0; j < 4; ++j) __builtin_nontemporal_store(v2[j] * rstd2 * w4[j], xr2 + 64 * j); } }
    }
#ifdef EXTRA_SYNCS
    for (int i = 0; i < EXTRA_SYNCS; ++i) grid.sync();
#endif
#undef IN
#undef SEAM
}

extern "C" void kernel_launch(void* const* d_in, const int* in_sizes, int n_in, void* d_out, int out_size, void* d_ws, size_t ws_size, hipStream_t stream) {
    static int grid = 0;
    if (grid == 0) {
        if (n_in != 24 || (size_t)out_size != O_END || ws_size < WS_END3) { fprintf(stderr, "kernel_launch: unexpected sizes: n_in %d out %d (want %zu) ws %zu (need %zu)\n", n_in, out_size, (size_t)O_END, ws_size, (size_t)WS_END3); grid = -1; return; }
        int dev = 0, cus = 0, per_cu = 0;
        hipGetDevice(&dev); hipDeviceGetAttribute(&cus, hipDeviceAttributeMultiprocessorCount, dev);
        if (hipFuncSetAttribute((const void*)hymba_fwd, hipFuncAttributeMaxDynamicSharedMemorySize, LDS_BYTES) != hipSuccess) { fprintf(stderr, "kernel_launch: hipFuncSetAttribute failed\n"); grid = -1; return; }
        if (hipOccupancyMaxActiveBlocksPerMultiprocessor(&per_cu, (const void*)hymba_fwd, NTHR, LDS_BYTES) != hipSuccess || per_cu < 1) { fprintf(stderr, "kernel_launch: occupancy query says %d blocks per CU\n", per_cu); grid = -1; (void)hipGetLastError(); return; }
        grid = cus * per_cu;
    }
    if (grid < 0) return;
    if (hipMemsetAsync((unsigned char*)d_ws + WS_BAR, 0, 16384, stream) != hipSuccess) { fprintf(stderr, "kernel_launch: memset of the barrier words failed\n"); return; }
    Args a{};
    for (int i = 0; i < 24; ++i) a.in[i] = (const float*)d_in[i];
    a.out = (float*)d_out; a.ws = (unsigned char*)d_ws; a.ph_lo = 0; a.ph_hi = 11;
    void* args[] = {&a};
#ifndef PRE_PASS
#define PRE_PASS 0
#endif
#ifndef PRE_FLAGS
#define PRE_FLAGS 0
#endif
    if (PRE_PASS > 0) {
        a.ph_hi = PRE_PASS; a.flags = PRE_FLAGS; (void)hipLaunchCooperativeKernel((const void*)hymba_fwd, dim3(grid), dim3(NTHR), args, LDS_BYTES, stream); a.ph_hi = 11; a.flags = 0; (void)hipMemsetAsync((unsigned char*)d_ws + WS_BAR, 0, 16384, stream); }
    hipError_t e = hipLaunchCooperativeKernel((const void*)hymba_fwd, dim3(grid), dim3(NTHR), args, LDS_BYTES, stream);
    if (e != hipSuccess) fprintf(stderr, "kernel_launch: cooperative launch failed: %s (grid %d)\n", hipGetErrorString(e), grid);
}
```
